# Optimizing an MI355X kernel written in HIP

```python
import jax, jax.numpy as jnp
from jax import lax
import numpy as np

D_MODEL = 1024
BATCH = 8
SEQ = 4096
DEPTH = 1

HA_HEADS = 8
HA_DK = 128
HA_DV = 128
CHUNK = 64
LRU_WIDTH = 1024
LRU_HEADS = 4
LRU_BLOCK = LRU_WIDTH // LRU_HEADS
CONV_WIDTH = 4
RG_C = 8.0
N_EXPERTS = 32
TOP_K = 4
D_FF = 1024
SWIGLU_LIMIT = 7.0
SWIGLU_ALPHA = 1.702
EPS = 1e-5

_IN_SIZES = (HA_HEADS * HA_DK, HA_HEADS * HA_DK, HA_HEADS * HA_DV, HA_HEADS * HA_DV,
             LRU_WIDTH, LRU_WIDTH, D_MODEL, D_MODEL)
IN_COLS = sum(_IN_SIZES)

kernel_name = "hgrn2_rglru_gated_merge_moe_block"


def _split_points():
    return [int(v) for v in np.cumsum(_IN_SIZES)[:-1]]


def rms_norm(x, w):
    xf = x.astype(jnp.float32)
    y = xf * lax.rsqrt(jnp.mean(xf * xf, axis=-1, keepdims=True) + EPS)
    return (y * w.astype(jnp.float32)).astype(x.dtype)


def _to_chunks(t, d):
    b, s = t.shape[:2]
    return t.reshape(b, s // CHUNK, CHUNK, HA_HEADS, d).transpose(0, 3, 1, 2, 4)


def hgrn2_branch(q, f_logit, i_v, g_out, lb, gn_w):
    b, s = q.shape[:2]
    f = lb + (1.0 - lb) * jax.nn.sigmoid(f_logit.astype(jnp.float32))
    log_f = jnp.log(f)
    k = 1.0 - f
    qs = jax.nn.silu(q.astype(jnp.float32))
    q_c, k_c, lf_c = _to_chunks(qs, HA_DK), _to_chunks(k, HA_DK), _to_chunks(log_f, HA_DK)
    v_c = _to_chunks(i_v.astype(jnp.float32), HA_DV)

    bcum = jnp.cumsum(lf_c, axis=3)
    b_last = bcum[:, :, :, -1:, :]
    q_in = q_c * jnp.exp(bcum)
    k_in = k_c * jnp.exp(-bcum)
    k_dec = k_c * jnp.exp(b_last - bcum)

    causal = jnp.tril(jnp.ones((CHUNK, CHUNK), dtype=bool))
    scores = jnp.einsum('bhnid,bhnjd->bhnij', q_in, k_in)
    scores = jnp.where(causal, scores, 0.0)
    o_intra = jnp.einsum('bhnij,bhnjv->bhniv', scores, v_c)

    def chunk_step(state, inp):
        q_n, kd_n, v_n, dec_n = inp
        o_n = jnp.einsum('bhcd,bhdv->bhcv', q_n, state)
        state = dec_n[..., None] * state + jnp.einsum('bhcd,bhcv->bhdv', kd_n, v_n)
        return state, o_n

    xs = (jnp.moveaxis(q_in, 2, 0), jnp.moveaxis(k_dec, 2, 0), jnp.moveaxis(v_c, 2, 0),
          jnp.moveaxis(jnp.exp(b_last[:, :, :, 0, :]), 2, 0))
    state0 = jnp.zeros((b, HA_HEADS, HA_DK, HA_DV), jnp.float32)
    _, o_inter = lax.scan(chunk_step, state0, xs)
    o = o_intra + jnp.moveaxis(o_inter, 0, 2)
    o = o.transpose(0, 2, 3, 1, 4).reshape(b, s, HA_HEADS, HA_DV)
    o = o * lax.rsqrt(jnp.mean(o * o, axis=-1, keepdims=True) + EPS)
    o = o * gn_w.astype(jnp.float32).reshape(HA_HEADS, HA_DV)
    g = jax.nn.silu(g_out.astype(jnp.float32)).reshape(b, s, HA_HEADS, HA_DV)
    return (o * g).reshape(b, s, HA_HEADS * HA_DV)


def _linear_recurrence(c1, c2):
    a1, u1 = c1
    a2, u2 = c2
    return a1 * a2, a2 * u1 + u2


def rglru_branch(xb, gate_b, conv_w, conv_b, w_rg_a, b_rg_a, w_rg_x, b_rg_x, lru_lambda):
    b, s = xb.shape[:2]
    xf = xb.astype(jnp.float32)
    xpad = jnp.pad(xf, ((0, 0), (CONV_WIDTH - 1, 0), (0, 0)))
    cw = conv_w.astype(jnp.float32)
    xc = conv_b.astype(jnp.float32) + sum(xpad[:, k:k + s, :] * cw[k] for k in range(CONV_WIDTH))
    xh = xc.reshape(b, s, LRU_HEADS, LRU_BLOCK)
    r = jax.nn.sigmoid(jnp.einsum('bshi,hij->bshj', xh, w_rg_a.astype(jnp.float32))
                       + b_rg_a.astype(jnp.float32).reshape(LRU_HEADS, LRU_BLOCK))
    ig = jax.nn.sigmoid(jnp.einsum('bshi,hij->bshj', xh, w_rg_x.astype(jnp.float32))
                        + b_rg_x.astype(jnp.float32).reshape(LRU_HEADS, LRU_BLOCK))
    log_a = RG_C * r * jax.nn.log_sigmoid(lru_lambda.astype(jnp.float32)).reshape(LRU_HEADS, LRU_BLOCK)
    a = jnp.exp(log_a)
    mult = jnp.sqrt(-jnp.expm1(2.0 * log_a))
    first = (jnp.arange(s) == 0)[None, :, None, None]
    mult = jnp.where(first, 1.0, mult)
    u = xh * ig * mult
    _, h = lax.associative_scan(_linear_recurrence, (a, u), axis=1)
    return h.reshape(b, s, LRU_WIDTH) * jax.nn.gelu(gate_b.astype(jnp.float32))


def moe_ffn(h, w_router, b_router, w_gu, b_gu, w_down, b_down):
    b, s, d = h.shape
    ht = h.reshape(b * s, d)
    logits = (ht @ w_router + b_router).astype(jnp.float32)
    top_val, top_idx = lax.top_k(logits, TOP_K)
    top_w = jax.nn.softmax(top_val, axis=-1)
    gate = jnp.einsum('tk,tke->te', top_w, jax.nn.one_hot(top_idx, N_EXPERTS, dtype=jnp.float32))
    out = jnp.zeros((b * s, d), jnp.float32)
    for e in range(N_EXPERTS):
        gu = (ht @ w_gu[e] + b_gu[e]).astype(jnp.float32)
        x_glu = jnp.minimum(gu[:, 0::2], SWIGLU_LIMIT)
        x_lin = jnp.clip(gu[:, 1::2], -SWIGLU_LIMIT, SWIGLU_LIMIT)
        act = x_glu * jax.nn.sigmoid(SWIGLU_ALPHA * x_glu) * (x_lin + 1.0)
        y_e = act.astype(ht.dtype) @ w_down[e] + b_down[e]
        out = out + gate[:, e:e + 1] * y_e.astype(jnp.float32)
    return out.reshape(b, s, d)


def setup_inputs(seed: int = 0) -> dict:
    key = jax.random.key(seed)
    ks = jax.random.split(key, 24)
    f32 = jnp.float32
    HK = HA_HEADS * HA_DK
    HV = HA_HEADS * HA_DV

    def nrm(k, shape, scale):
        return jax.random.normal(k, shape, f32) * scale

    a0 = jax.random.uniform(ks[11], (DEPTH, LRU_WIDTH), f32, 0.9, 0.999)
    s0 = a0 ** (1.0 / RG_C)
    lru_lambda = jnp.log(s0) - jnp.log1p(-s0)
    return {
        "x": nrm(ks[0], (BATCH, SEQ, D_MODEL), 1.0),
        "norm_mix": 1.0 + nrm(ks[1], (DEPTH, D_MODEL), 0.02),
        "w_in": nrm(ks[2], (DEPTH, D_MODEL, IN_COLS), D_MODEL ** -0.5),
        "lb_raw": nrm(ks[3], (DEPTH + 1, HK), 0.1),
        "gn_w": 1.0 + nrm(ks[4], (DEPTH, HV), 0.02),
        "conv_w": nrm(ks[5], (DEPTH, CONV_WIDTH, LRU_WIDTH), CONV_WIDTH ** -0.5),
        "conv_b": nrm(ks[6], (DEPTH, LRU_WIDTH), 0.01),
        "w_rg_a": nrm(ks[7], (DEPTH, LRU_HEADS, LRU_BLOCK, LRU_BLOCK), LRU_BLOCK ** -0.5),
        "b_rg_a": nrm(ks[8], (DEPTH, LRU_WIDTH), 0.01),
        "w_rg_x": nrm(ks[9], (DEPTH, LRU_HEADS, LRU_BLOCK, LRU_BLOCK), LRU_BLOCK ** -0.5),
        "b_rg_x": nrm(ks[10], (DEPTH, LRU_WIDTH), 0.01),
        "lru_lambda": lru_lambda,
        "w_proj_a": nrm(ks[12], (DEPTH, HV, D_MODEL), HV ** -0.5),
        "w_proj_b": nrm(ks[13], (DEPTH, LRU_WIDTH, D_MODEL), LRU_WIDTH ** -0.5),
        "w_out": nrm(ks[14], (DEPTH, D_MODEL, D_MODEL), D_MODEL ** -0.5),
        "norm_ffn": 1.0 + nrm(ks[15], (DEPTH, D_MODEL), 0.02),
        "w_router": nrm(ks[16], (DEPTH, D_MODEL, N_EXPERTS), D_MODEL ** -0.5),
        "b_router": nrm(ks[17], (DEPTH, N_EXPERTS), 0.01),
        "w_gu": nrm(ks[18], (DEPTH, N_EXPERTS, D_MODEL, 2 * D_FF), D_MODEL ** -0.5),
        "b_gu": nrm(ks[19], (DEPTH, N_EXPERTS, 2 * D_FF), 0.01),
        "w_down": nrm(ks[20], (DEPTH, N_EXPERTS, D_FF, D_MODEL), D_FF ** -0.5),
        "b_down": nrm(ks[21], (DEPTH, N_EXPERTS, D_MODEL), 0.01),
        "norm_final": 1.0 + nrm(ks[22], (D_MODEL,), 0.02),
    }


def reference(x, norm_mix, w_in, lb_raw, gn_w, conv_w, conv_b, w_rg_a, b_rg_a, w_rg_x, b_rg_x,
              lru_lambda, w_proj_a, w_proj_b, w_out, norm_ffn, w_router, b_router, w_gu, b_gu,
              w_down, b_down, norm_final):
    lower_bounds = jnp.cumsum(jax.nn.softmax(lb_raw.astype(jnp.float32), axis=0), axis=0)
    split_points = _split_points()
    for l in range(DEPTH):
        h = rms_norm(x, norm_mix[l])
        proj = h @ w_in[l]
        q, f_logit, i_v, g_out, xb, gate_b, g_a, g_b = jnp.split(proj, split_points, axis=-1)
        o_a = hgrn2_branch(q, f_logit, i_v, g_out, lower_bounds[l], gn_w[l])
        o_b = rglru_branch(xb, gate_b, conv_w[l], conv_b[l], w_rg_a[l], b_rg_a[l],
                           w_rg_x[l], b_rg_x[l], lru_lambda[l])
        y_a = o_a.astype(x.dtype) @ w_proj_a[l]
        y_b = o_b.astype(x.dtype) @ w_proj_b[l]
        merged = (jax.nn.sigmoid(g_a.astype(jnp.float32)) * y_a.astype(jnp.float32)
                  + jax.nn.sigmoid(g_b.astype(jnp.float32)) * y_b.astype(jnp.float32))
        x = x + (merged.astype(x.dtype) @ w_out[l]).astype(x.dtype)
        h = rms_norm(x, norm_ffn[l])
        x = x + moe_ffn(h, w_router[l], b_router[l], w_gu[l], b_gu[l], w_down[l], b_down[l]).astype(x.dtype)
    return rms_norm(x, norm_final)
```

```cpp
#include <hip/hip_runtime.h>
#include <cstdio>
#include <cstdint>

#ifndef MOE_FP8
#define MOE_FP8 2
#endif
#ifndef MOE_CONV_IN_P1
#define MOE_CONV_IN_P1 1
#endif
constexpr int HG_NB = 16;
typedef unsigned short bf16_t;
typedef short bf16x8 __attribute__((ext_vector_type(8)));
typedef float f32x4 __attribute__((ext_vector_type(4)));

constexpr int BATCH = 8, SEQ = 4096, D = 1024, T = BATCH * SEQ;
constexpr int NH = 8, DK = 128, DV = 128;
constexpr int LRU_H = 4, LRU_B = 256;
constexpr int NE = 32, TOPK = 4, DFF = 1024;
constexpr float EPS = 1e-5f;
constexpr size_t MiB = 1u << 20;

constexpr size_t WS_XN   = 224 * MiB;
constexpr size_t WS_SEG  = 288 * MiB;
constexpr size_t SEG_BYTES = (size_t)T * 1024 * 2;
constexpr size_t WS_X1   = 800 * MiB;
constexpr size_t WS_X1W  = 928 * MiB;
enum { SG_Q = 0, SG_F = 1, SG_V = 2, SG_G = 3, SG_XB = 4, SG_GATE = 5, SG_GA = 6, SG_GB = 7 };

__device__ __forceinline__ float bf2f(bf16_t v) { return __uint_as_float(((unsigned)v) << 16); }
__device__ __forceinline__ bf16_t f2bf(float f) { unsigned u = __float_as_uint(f); u += 0x7fffu + ((u >> 16) & 1u); return (bf16_t)(u >> 16); }
__device__ __forceinline__ float sigmoidf_(float x) { return __builtin_amdgcn_rcpf(1.0f + __expf(-x)); }
__device__ __forceinline__ float siluf_(float x) { return x * sigmoidf_(x); }
__device__ __forceinline__ float wave_sum(float v) {
#pragma unroll
    for (int o = 1; o < 64; o <<= 1) v += __shfl_xor(v, o);
    return v;
}

#define LAS __attribute__((address_space(3)))
#define GAS __attribute__((address_space(1)))
typedef unsigned u32x4 __attribute__((ext_vector_type(4)));
typedef unsigned u32x2 __attribute__((ext_vector_type(2)));
typedef GAS unsigned gu32;
#define LDS_WAIT() asm volatile("s_waitcnt lgkmcnt(0)" ::: "memory")
#define VM_WAIT() asm volatile("s_waitcnt vmcnt(0)" ::: "memory")

constexpr size_t WS_CTL = 0, CTL_ZERO_BYTES = 64 * 1024;
constexpr size_t WS_LBV = 1 * MiB;
constexpr size_t WS_LOGSIG = 1 * MiB + 8192;
constexpr size_t WS_BGUP = 1 * MiB + 65536;
constexpr size_t WS_WRT = 1 * MiB + 512 * 1024;
constexpr size_t WS_WIN_T = 2 * MiB, WS_WRG_T = 18 * MiB, WS_WPA_T = 19 * MiB, WS_WPB_T = 21 * MiB, WS_WOUT_T = 23 * MiB;
constexpr size_t WS_DEC = 25 * MiB;
constexpr size_t WS_LRUP = 27 * MiB, WS_LRUH = 29 * MiB;
constexpr size_t WS_WGU_T = 32 * MiB, WS_WDN_T = 160 * MiB;
constexpr size_t WS_XC = 224 * MiB;
constexpr size_t WS_USP = 800 * MiB;
constexpr size_t WS_UU = 928 * MiB;
constexpr int CW_TMO = 0, CW_BAR = 1024;

#define XB_TMO      128
#define XB_XCNT(j)  (256  + 64 * (j))
#define XB_XSUB(j)  (1280 + 64 * (j))
#define XB_XGEN(j)  (2304 + 64 * (j))
#define XB_TOP      3328
#define XB_TOPGEN   3392
#define XCD_BAR_WORDS 3456
#define XB_SPIN_CAP (1u << 18)
__device__ __forceinline__ unsigned xb_ld(unsigned* p)              { return __hip_atomic_load(p, __ATOMIC_RELAXED, __HIP_MEMORY_SCOPE_AGENT); }
__device__ __forceinline__ unsigned xb_add(unsigned* p, unsigned v) { return __hip_atomic_fetch_add(p, v, __ATOMIC_RELAXED, __HIP_MEMORY_SCOPE_AGENT); }
__device__ __forceinline__ unsigned xb_xcc_id() { return (unsigned)__builtin_amdgcn_s_getreg((3 << 11) | 20) & 0xFu; }
#define XB_SPIN(cond, bar) do { unsigned _sp = 0; while (cond) { __builtin_amdgcn_s_sleep(1); \
    if ((++_sp & 255u) == 0u) { if (xb_ld(&(bar)[XB_TMO])) break; if (_sp > XB_SPIN_CAP) { atomicAdd(&(bar)[XB_TMO], 1u); break; } } } } while (0)
struct XcdBarrier { unsigned* bar; unsigned x; volatile LAS unsigned* st; };
__device__ __forceinline__ XcdBarrier xcd_barrier_post(unsigned* bar, volatile LAS unsigned* st) {
    XcdBarrier b; b.bar = bar; b.x = xb_xcc_id(); b.st = st;
    if (threadIdx.x == 0) (void)xb_add(&bar[XB_XCNT(b.x)], 1u);
    return b;
}
__device__ __forceinline__ void xcd_barrier_complete(unsigned* bar, unsigned x, unsigned& nloc, unsigned& nx) {
    const unsigned G = gridDim.x * gridDim.y * gridDim.z;
    unsigned sum, cnt, mine, sp = 0u;
    for (;;) {
        sum = 0u; cnt = 0u; mine = 0u;
#pragma unroll
        for (unsigned j = 0; j < 16; ++j) { const unsigned c = xb_ld(&bar[XB_XCNT(j)]); sum += c; cnt += (c > 0u) ? 1u : 0u; mine = (j == x) ? c : mine; }
        if (sum == G) break;
        __builtin_amdgcn_s_sleep(1);
        if ((++sp & 255u) == 0u) { if (xb_ld(&bar[XB_TMO])) break; if (sp > XB_SPIN_CAP) { atomicAdd(&bar[XB_TMO], 1u); break; } }
    }
    nloc = mine > 0u ? mine : 1u; nx = cnt > 0u ? cnt : 1u;
}
__device__ __forceinline__ void xcd_barrier(const XcdBarrier& b) {
    asm volatile("s_waitcnt vmcnt(0)" ::: "memory");
    __syncthreads();
    if (threadIdx.x == 0) {
        unsigned* bar = b.bar;
        __builtin_amdgcn_s_waitcnt(0);
        unsigned nloc = b.st[0], nx = b.st[1];
        if (nloc == 0u) { xcd_barrier_complete(bar, b.x, nloc, nx); b.st[0] = nloc; b.st[1] = nx; }
        const unsigned old = xb_add(&bar[XB_XSUB(b.x)], 1u);
        const unsigned gen = old / nloc;
        if (old + 1u == (gen + 1u) * nloc) {
            __builtin_amdgcn_fence(__ATOMIC_RELEASE, "agent");
            asm volatile("s_waitcnt vmcnt(0)" ::: "memory");
            const unsigned og = xb_add(&bar[XB_TOP], 1u);
            const unsigned tg = og / nx;
            if (og + 1u == (tg + 1u) * nx) xb_add(&bar[XB_TOPGEN], 1u);
            else XB_SPIN(xb_ld(&bar[XB_TOPGEN]) == tg, bar);
            __builtin_amdgcn_fence(__ATOMIC_ACQUIRE, "agent");
            xb_add(&bar[XB_XGEN(b.x)], 1u);
            asm volatile("s_waitcnt vmcnt(0)" ::: "memory");
        } else {
            XB_SPIN(xb_ld(&bar[XB_XGEN(b.x)]) == gen, bar);
            __builtin_amdgcn_fence(__ATOMIC_ACQUIRE, "agent");
            asm volatile("s_waitcnt vmcnt(0)" ::: "memory");
        }
    }
    __syncthreads();
}

namespace pg8 {
typedef long i64x2 __attribute__((ext_vector_type(2)));
typedef int i32x4 __attribute__((ext_vector_type(4)));
typedef int i32x8 __attribute__((ext_vector_type(8)));
constexpr int BM = 256, BK = 64, HALF = 128, HTB = HALF * BK * 2, STAGE_BYTES = 8 * HTB, NXCD = 8, WGM = 4;
__host__ __device__ __forceinline__ int lds_byte(int r, int c) { const int st = (r >> 4) * 2 + (c >> 5), rr = r & 15, cc = c & 31, ob = rr * 64 + cc * 2; return st * 1024 + (ob ^ (((ob >> 9) & 1) << 5)); }
__host__ __device__ __forceinline__ void stage_rc(int b, int& R, int& C) { const int st = b / 1024, sb = b % 1024, swz = sb ^ (((sb >> 9) & 1) << 5); R = (st >> 1) * 16 + swz / 64; C = (st & 1) * 32 + (swz % 64) / 2; }
__host__ __device__ __forceinline__ int perm32(int rho) { const int n = rho >> 4, i = rho & 15; return 8 * (i >> 2) + 4 * n + (i & 3); }
__device__ __forceinline__ unsigned cvt_pk_bf16(float lo, float hi) { unsigned r; asm volatile("v_cvt_pk_bf16_f32 %0, %1, %2" : "=v"(r) : "v"(lo), "v"(hi)); return r; }

struct Unit { const char* a; const char* b; int pm, pn, e, rows; };
struct NoMid { static constexpr int KJ = 0; size_t jumpA, jumpB; template <class U> __device__ __forceinline__ void operator()(f32x4 (&)[2][2][4][2], const U&, int, int, int, int) const {} };
template <class Epi, class Sched, bool GATHER, class Mid = NoMid, bool FP8 = false>
__device__ __forceinline__ void gemm_phase(LAS unsigned char* lds, const int K, const int lda  , const Sched& S, const Epi& E, const int ldb_ = 0, const Mid MD = Mid{}) {
    const int ldb = ldb_ ? ldb_ : K;
    const int tid = threadIdx.x, wid = __builtin_amdgcn_readfirstlane(tid >> 6), lane = tid & 63, wr = wid >> 2, wc = wid & 3, fr = lane & 15, fq = lane >> 4;
    const int nt = K / BK;
    unsigned vA[2][2], voffB[2];
#pragma unroll
    for (int i = 0; i < 2; ++i) { int R, C; stage_rc(tid * 16 + i * 8192, R, C); const int Rb = Epi::PERM ? ((R & ~31) + perm32(R & 31)) : R;
        vA[0][i] = (unsigned)(R * lda + C) * 2u; vA[1][i] = (unsigned)((R + HALF) * lda + C) * 2u; voffB[i] = (unsigned)(Rb * ldb + C) * 2u; }
    const size_t kstep = (size_t)(BK * 2);
    const size_t hstepB = (size_t)HALF * ldb * 2;
    const unsigned ldsw = (unsigned)wid * 1024u;
    const int aoff = lds_byte(wr * 64 + fr, fq * 8), boff = lds_byte(wc * 32 + fr, fq * 8);
#define PG8_SA(b, h) (((b) * 2 + (h)) * HTB)
#define PG8_SB(b, h) ((4 + (b) * 2 + (h)) * HTB)
#define PG8_STAGE(bufoff, gbase, voff) do { _Pragma("unroll") for (int _i = 0; _i < 2; ++_i) \
        __builtin_amdgcn_global_load_lds((const unsigned*)((const char*)(gbase) + (voff)[_i]), (LAS unsigned*)(lds + (bufoff) + ldsw + _i * 8192), 16, 0, 0); } while (0)
#define PG8_LDA(dst, b, h) do { if constexpr (MX) { _Pragma("unroll") for (int m = 0; m < 4; ++m) dst##8[m] = __builtin_shufflevector(*(const LAS i32x4*)(lds + PG8_SA(b, h) + aoff + m * 2048), *(const LAS i32x4*)(lds + PG8_SA(b, h) + aoff + m * 2048 + 1024), 0, 1, 2, 3, 4, 5, 6, 7); } \
        else { _Pragma("unroll") for (int m = 0; m < 4; ++m) _Pragma("unroll") for (int k = 0; k < 2; ++k) dst[m][k] = *(const LAS bf16x8*)(lds + PG8_SA(b, h) + aoff + m * 2048 + k * 1024); } } while (0)
#define PG8_LDB(dst, b, h) do { if constexpr (MX) { _Pragma("unroll") for (int n = 0; n < 2; ++n) dst##8[n] = __builtin_shufflevector(*(const LAS i32x4*)(lds + PG8_SB(b, h) + boff + n * 2048), *(const LAS i32x4*)(lds + PG8_SB(b, h) + boff + n * 2048 + 1024), 0, 1, 2, 3, 4, 5, 6, 7); } \
        else { _Pragma("unroll") for (int n = 0; n < 2; ++n) _Pragma("unroll") for (int k = 0; k < 2; ++k) dst[n][k] = *(const LAS bf16x8*)(lds + PG8_SB(b, h) + boff + n * 2048 + k * 1024); } } while (0)
#define PG8_MMA(ai, bj, At, Bt) do { __builtin_amdgcn_s_setprio(1); _Pragma("unroll") for (int m = 0; m < 4; ++m) _Pragma("unroll") for (int n = 0; n < 2; ++n) { \
        if constexpr (MX) {     \
            asm volatile("v_mfma_scale_f32_16x16x128_f8f6f4 %0, %1, %2, %0, %3, %3 op_sel_hi:[0,0,0]" : "+v"(acc[ai][bj][m][n]) : "v"(Bt##8[n]), "v"(At##8[m]), "v"(mxscale)); \
        } else { _Pragma("unroll") for (int k = 0; k < 2; ++k) { \
        if constexpr (FP8) { const i64x2 _b = __builtin_bit_cast(i64x2, Bt[n][k]), _a = __builtin_bit_cast(i64x2, At[m][k]); \
            acc[ai][bj][m][n] = __builtin_amdgcn_mfma_f32_16x16x32_fp8_fp8(_b[0], _a[0], acc[ai][bj][m][n], 0, 0, 0); acc[ai][bj][m][n] = __builtin_amdgcn_mfma_f32_16x16x32_fp8_fp8(_b[1], _a[1], acc[ai][bj][m][n], 0, 0, 0); } \
        else acc[ai][bj][m][n] = __builtin_amdgcn_mfma_f32_16x16x32_bf16(Bt[n][k], At[m][k], acc[ai][bj][m][n], 0, 0, 0); } } } __builtin_amdgcn_s_setprio(0); } while (0)
#define PG8_WAIT_V(n) asm volatile("s_waitcnt vmcnt(" #n ")" ::: "memory")
#define PG8_WAIT_L(n) asm volatile("s_waitcnt lgkmcnt(" #n ")" ::: "memory")
#define PG8_BAR __builtin_amdgcn_s_barrier()
#define PG8_SCHED __builtin_amdgcn_sched_barrier(0)
    Unit cur, nxt; int ui = 0;
    if (!S.next(0, cur)) return;
    f32x4 acc[2][2][4][2];
#pragma unroll
    for (int a = 0; a < 2; ++a)
#pragma unroll
        for (int b = 0; b < 2; ++b)
#pragma unroll
            for (int m = 0; m < 4; ++m)
#pragma unroll
                for (int n = 0; n < 2; ++n) acc[a][b][m][n] = (f32x4){0.f, 0.f, 0.f, 0.f};
    constexpr bool MX = FP8 && (MOE_FP8 == 2);
    int mxscale = 0x7F7F7F7F; asm volatile("" : "+v"(mxscale));
    bf16x8 At[4][2], B0[2][2], B1[2][2]; i32x8 At8[4], B08[2], B18[2];
    const char* cA = cur.a; const char* cB = cur.b;
#define PG8_GOFF(unit, dst) do { int _tz = threadIdx.x; asm volatile("" : "+v"(_tz)); int _R0, _C0, _R1, _C1; stage_rc(_tz * 16, _R0, _C0); stage_rc(_tz * 16 + 8192, _R1, _C1); int _r[4]; S.rows(unit, _R0, _R1, _r); \
        dst[0][0] = (unsigned)(_r[0] * lda + _C0) * 2u; dst[0][1] = (unsigned)(_r[1] * lda + _C1) * 2u; dst[1][0] = (unsigned)(_r[2] * lda + _C0) * 2u; dst[1][1] = (unsigned)(_r[3] * lda + _C1) * 2u; } while (0)
    LAS u32x4* noff = (LAS u32x4*)(lds + STAGE_BYTES + 4096) + tid;
    if constexpr (GATHER) { PG8_GOFF(cur, vA); }
    PG8_STAGE(PG8_SB(0, 0), cB, voffB); PG8_STAGE(PG8_SB(0, 1), cB + hstepB, voffB); PG8_STAGE(PG8_SA(0, 0), cA, vA[0]); PG8_STAGE(PG8_SA(0, 1), cA, vA[1]);
    if (wr == 1) PG8_BAR;
    PG8_WAIT_V(2); PG8_BAR;
    PG8_STAGE(PG8_SB(1, 0), cB + kstep, voffB); PG8_STAGE(PG8_SA(1, 0), cA + kstep, vA[0]); PG8_STAGE(PG8_SB(1, 1), cB + hstepB + kstep, voffB);
    PG8_WAIT_V(6); PG8_BAR;
    for (;;) {
        const bool has_next = S.next(ui + 1, nxt);
        const char* nA = has_next ? nxt.a : cA; const char* nB = has_next ? nxt.b : cB;
#pragma unroll 1
        for (int t = 0; t < nt; t += 2) {
            const bool last = (t == nt - 2);
            const char* a1 = cA + (size_t)(t + 1) * kstep;
            const char* a2 = last ? nA : cA + (size_t)(t + 2) * kstep; const char* b2 = last ? nB : cB + (size_t)(t + 2) * kstep;
            const char* a3 = a2 + kstep; const char* b3 = b2 + kstep;
            if constexpr (Mid::KJ > 0) {
                if (t + 1 >= Mid::KJ) a1 += MD.jumpA;
                if (!last && t + 2 >= Mid::KJ) { a2 += MD.jumpA; b2 += MD.jumpB; a3 += MD.jumpA; b3 += MD.jumpB; }
                if (t == Mid::KJ) MD(acc, cur, wr, wc, fr, fq);
            }
            asm volatile("" : "+s"(a1), "+s"(a2), "+s"(a3), "+s"(b2), "+s"(b3));
            unsigned o2[2][2];
            if constexpr (GATHER) {
#pragma unroll
                for (int h = 0; h < 2; ++h)
#pragma unroll
                    for (int i = 0; i < 2; ++i) o2[h][i] = vA[h][i];
                if (last && has_next) { PG8_GOFF(nxt, o2); *noff = (u32x4){o2[0][0], o2[0][1], o2[1][0], o2[1][1]}; }
            } else {
#pragma unroll
                for (int h = 0; h < 2; ++h)
#pragma unroll
                    for (int i = 0; i < 2; ++i) o2[h][i] = vA[h][i];
            }
            PG8_LDB(B0, 0, 0); PG8_LDB(B1, 0, 1); PG8_SCHED; PG8_LDA(At, 0, 0); PG8_STAGE(PG8_SA(1, 1), a1, vA[1]);
            PG8_WAIT_V(8); PG8_WAIT_L(0); PG8_BAR; PG8_MMA(0, 0, At, B0); PG8_MMA(0, 1, At, B1); PG8_BAR; PG8_SCHED;
            PG8_LDA(At, 0, 1); PG8_STAGE(PG8_SB(0, 0), b2, voffB); PG8_STAGE(PG8_SB(0, 1), b2 + hstepB, voffB); PG8_STAGE(PG8_SA(0, 0), a2, o2[0]);
            PG8_WAIT_V(8); PG8_WAIT_L(0); PG8_BAR; PG8_MMA(1, 0, At, B0); PG8_MMA(1, 1, At, B1); PG8_BAR; PG8_SCHED;
            PG8_LDB(B0, 1, 0); PG8_LDB(B1, 1, 1); PG8_SCHED; PG8_LDA(At, 1, 0); PG8_STAGE(PG8_SA(0, 1), a2, o2[1]);
            PG8_WAIT_V(8); PG8_WAIT_L(0); PG8_BAR; PG8_MMA(0, 0, At, B0); PG8_MMA(0, 1, At, B1); PG8_BAR; PG8_SCHED;
            PG8_LDA(At, 1, 1); PG8_STAGE(PG8_SB(1, 0), b3, voffB); PG8_STAGE(PG8_SB(1, 1), b3 + hstepB, voffB); PG8_STAGE(PG8_SA(1, 0), a3, o2[0]);
            PG8_WAIT_V(8); PG8_WAIT_L(0); PG8_BAR; PG8_MMA(1, 0, At, B0); PG8_MMA(1, 1, At, B1); PG8_BAR; PG8_SCHED;
        }
        if constexpr (MX) asm volatile("s_nop 15\n\ts_nop 7" ::: "memory");
        if (wr == 0) PG8_BAR;
        E(acc, cur, wr, wc, fr, fq);
#if defined(DUP_EPI)
        if constexpr (Epi::DUPE) { asm volatile("" ::: "memory"); E(acc, cur, wr, wc, fr, fq); }
#endif
        if (!has_next) break;
#pragma unroll
        for (int a = 0; a < 2; ++a)
#pragma unroll
            for (int b = 0; b < 2; ++b)
#pragma unroll
                for (int m = 0; m < 4; ++m)
#pragma unroll
                    for (int n = 0; n < 2; ++n) acc[a][b][m][n] = (f32x4){0.f, 0.f, 0.f, 0.f};
        cur = nxt; cA = nA; cB = nB; ++ui;
        if constexpr (GATHER) { const u32x4 nv = *noff; vA[0][0] = nv.x; vA[0][1] = nv.y; vA[1][0] = nv.z; vA[1][1] = nv.w; }
        if (wr == 1) PG8_BAR;
    }
    PG8_WAIT_V(0);
    PG8_BAR;
#undef PG8_GOFF
#undef PG8_SA
#undef PG8_SB
#undef PG8_STAGE
#undef PG8_LDA
#undef PG8_LDB
#undef PG8_MMA
#undef PG8_WAIT_V
#undef PG8_WAIT_L
#undef PG8_BAR
#undef PG8_SCHED
}

struct DenseOrder {
    const char* A; const char* Bt; size_t a_tile, b_tile; int nM, nN, nwg, G, c; int i0 = 0, i1 = 1 << 30;
    __device__ __forceinline__ void init(const void* A_, size_t lda_bytes, const void* Bt_, size_t K_bytes, int M, int N, int G_, int c_) {
        A = (const char*)A_; Bt = (const char*)Bt_; a_tile = 256 * lda_bytes; b_tile = 256 * K_bytes; nM = M / BM; nN = N / BM; nwg = nM * nN; G = G_; c = c_; }
    __device__ __forceinline__ bool next(int i, Unit& u) const {
        if (i0 + i >= i1) return false;
        const long L = (long)(i0 + i) * G + c; if (L >= nwg) return false;
        int wgid = (int)L; { const int q = nwg / NXCD, r = nwg % NXCD, xcd = wgid % NXCD, off = wgid / NXCD; wgid = (xcd < r ? xcd * (q + 1) : r * (q + 1) + (xcd - r) * q) + off; }
        const int nig = WGM * nN, gid = wgid / nig, fm = gid * WGM, gsz = (nM - fm) < WGM ? (nM - fm) : WGM;
        u.pm = fm + ((wgid % nig) % gsz); u.pn = (wgid % nig) / gsz; u.e = 0; u.rows = 256;
        u.a = A + (size_t)u.pm * a_tile; u.b = Bt + (size_t)u.pn * b_tile; return true;
    }
};

struct EpiSeg {
    static constexpr bool PERM = true;
#if defined(DUP_EPI)
    static constexpr bool DUPE = ((DUP_EPI >> 0) & 1) != 0;
#endif
    bf16_t* seg0;
    __device__ __forceinline__ void operator()(const f32x4 (&acc)[2][2][4][2], const Unit& u, int wr, int wc, int fr, int fq) const {
        const int row0 = u.pm * BM + wr * 64 + fr;
        if (u.pn < 24) {
            bf16_t* base = seg0 + (size_t)(u.pn >> 2) * ((size_t)T * 1024);
            const int col0 = (u.pn & 3) * BM + wc * 32 + 8 * fq;
#pragma unroll
            for (int ai = 0; ai < 2; ++ai)
#pragma unroll
                for (int m = 0; m < 4; ++m) { bf16_t* rowp = base + (size_t)(row0 + ai * HALF + m * 16) * 1024 + col0;
#pragma unroll
                    for (int bj = 0; bj < 2; ++bj) { const f32x4 v0 = acc[ai][bj][m][0], v1 = acc[ai][bj][m][1];
                        u32x4 w; w.x = cvt_pk_bf16(v0[0], v0[1]); w.y = cvt_pk_bf16(v0[2], v0[3]); w.z = cvt_pk_bf16(v1[0], v1[1]); w.w = cvt_pk_bf16(v1[2], v1[3]);
                        *(u32x4*)(rowp + bj * HALF) = w; } }
        } else {
            bf16_t* ratio = seg0 + (size_t)6 * ((size_t)T * 1024); bf16_t* sgb = seg0 + (size_t)7 * ((size_t)T * 1024);
            const int col0 = (u.pn - 24) * HALF + wc * 32 + 8 * fq;
#pragma unroll
            for (int ai = 0; ai < 2; ++ai)
#pragma unroll
                for (int m = 0; m < 4; ++m) { const size_t e = (size_t)(row0 + ai * HALF + m * 16) * 1024 + col0; float rt[8], sb[8];
#pragma unroll
                    for (int n = 0; n < 2; ++n)
#pragma unroll
                        for (int k = 0; k < 4; ++k) { const float ea = 1.0f + __expf(-acc[ai][0][m][n][k]), eb = 1.0f + __expf(-acc[ai][1][m][n][k]); const float ib = __builtin_amdgcn_rcpf(eb);
                            sb[4 * n + k] = ib; rt[4 * n + k] = eb * __builtin_amdgcn_rcpf(ea); }
                    u32x4 w1, w2; w1.x = cvt_pk_bf16(rt[0], rt[1]); w1.y = cvt_pk_bf16(rt[2], rt[3]); w1.z = cvt_pk_bf16(rt[4], rt[5]); w1.w = cvt_pk_bf16(rt[6], rt[7]);
                    w2.x = cvt_pk_bf16(sb[0], sb[1]); w2.y = cvt_pk_bf16(sb[2], sb[3]); w2.z = cvt_pk_bf16(sb[4], sb[5]); w2.w = cvt_pk_bf16(sb[6], sb[7]);
                    *(u32x4*)(ratio + e) = w1; *(u32x4*)(sgb + e) = w2; }
        }
    }
};

struct GateOrder {
    const char* XC; const char* W; int G, c;
    __device__ __forceinline__ bool next(int i, Unit& u) const {
        const int L = i * G + c; if (L >= 128 * 8) return false;
        u.pn = L & 1; u.e = (L >> 1) & 3; u.pm = L >> 3; u.rows = 256;
        u.a = XC + (size_t)u.pm * 256 * 2048 + (size_t)u.e * 512; u.b = W + ((size_t)u.e * 512 + (size_t)u.pn * 256) * 512; return true;
    }
};
struct EpiGates {
    static constexpr bool PERM = true;
#if defined(DUP_EPI)
    static constexpr bool DUPE = ((DUP_EPI >> 1) & 1) != 0;
#endif
    const bf16_t* XC; const float* ba; const float* bxx; const float* LOGSIG; bf16_t* LA; bf16_t* UU;
    __device__ __forceinline__ void operator()(const f32x4 (&acc)[2][2][4][2], const Unit& u, int wr, int wc, int fr, int fq) const {
        const int cb = 256 * u.e + 128 * u.pn + 32 * wc + 8 * fq;
        f32x4 va[2], vx[2], ls[2];
#pragma unroll
        for (int n = 0; n < 2; ++n) { va[n] = *(const f32x4*)(ba + cb + 4 * n); vx[n] = *(const f32x4*)(bxx + cb + 4 * n); ls[n] = *(const f32x4*)(LOGSIG + cb + 4 * n); }
        u32x4 xall[2][4];
#pragma unroll
        for (int ai = 0; ai < 2; ++ai)
#pragma unroll
            for (int m = 0; m < 4; ++m) xall[ai][m] = *(const u32x4*)(XC + (size_t)(u.pm * BM + ai * HALF + wr * 64 + m * 16 + fr) * 1024 + cb);
        asm volatile("" ::: "memory");
#pragma unroll
        for (int ai = 0; ai < 2; ++ai)
#pragma unroll
            for (int m = 0; m < 4; ++m) {
                const int t = u.pm * BM + ai * HALF + wr * 64 + m * 16 + fr; const size_t e = (size_t)t * 1024 + cb;
                const u32x4 xw = xall[ai][m]; const unsigned xu[4] = {xw.x, xw.y, xw.z, xw.w};
                const bool first = (t & (SEQ - 1)) == 0;
                float la[8], uu[8];
#pragma unroll
                for (int n = 0; n < 2; ++n)
#pragma unroll
                    for (int k = 0; k < 4; ++k) {
                        const float r = sigmoidf_(acc[ai][0][m][n][k] + va[n][k]), ig = sigmoidf_(acc[ai][1][m][n][k] + vx[n][k]);
                        const float l = 8.0f * r * ls[n][k]; const float mult = first ? 1.0f : __builtin_amdgcn_sqrtf(fmaxf(1.0f - __expf(2.0f * l), 0.f));
                        const int idx = 4 * n + k; const float xc = (idx & 1) ? __uint_as_float(xu[idx >> 1] & 0xffff0000u) : __uint_as_float(xu[idx >> 1] << 16);
                        la[idx] = l; uu[idx] = xc * ig * mult;
                    }
                u32x4 o1, o2; o1.x = cvt_pk_bf16(la[0], la[1]); o1.y = cvt_pk_bf16(la[2], la[3]); o1.z = cvt_pk_bf16(la[4], la[5]); o1.w = cvt_pk_bf16(la[6], la[7]);
                o2.x = cvt_pk_bf16(uu[0], uu[1]); o2.y = cvt_pk_bf16(uu[2], uu[3]); o2.z = cvt_pk_bf16(uu[4], uu[5]); o2.w = cvt_pk_bf16(uu[6], uu[7]);
                *(u32x4*)(LA + e) = o1; *(u32x4*)(UU + e) = o2;
            }
    }
};

__device__ __forceinline__ void unpack8(const u32x4 w, float (&f)[8]) { const unsigned u[4] = {w.x, w.y, w.z, w.w};
#pragma unroll
    for (int i = 0; i < 4; ++i) { f[2 * i] = __uint_as_float(u[i] << 16); f[2 * i + 1] = __uint_as_float(u[i] & 0xffff0000u); } }
struct MidMerge {
    static constexpr int KJ = 16; size_t jumpA, jumpB; const bf16_t* RATIO;
    __device__ __forceinline__ void operator()(f32x4 (&acc)[2][2][4][2], const Unit& u, int wr, int wc, int fr, int fq) const {
        int row0 = u.pm * BM + wr * 64 + fr; const int col0 = u.pn * BM + wc * 32 + 8 * fq;
        asm volatile("" : "+v"(row0));
#pragma unroll
        for (int ai = 0; ai < 2; ++ai)
#pragma unroll
            for (int mp = 0; mp < 2; ++mp) {
                u32x4 rw[2][2];
#pragma unroll
                for (int mm = 0; mm < 2; ++mm)
#pragma unroll
                    for (int bj = 0; bj < 2; ++bj) rw[mm][bj] = *(const u32x4*)(RATIO + (size_t)(row0 + ai * HALF + (2 * mp + mm) * 16) * 1024 + col0 + bj * HALF);
#pragma unroll
                for (int mm = 0; mm < 2; ++mm)
#pragma unroll
                    for (int bj = 0; bj < 2; ++bj) { float r[8]; unpack8(rw[mm][bj], r); const int m = 2 * mp + mm;
#pragma unroll
                        for (int k = 0; k < 4; ++k) { acc[ai][bj][m][0][k] *= r[k]; acc[ai][bj][m][1][k] *= r[4 + k]; } }
                asm volatile("" ::: "memory"); }
    }
};
struct EpiMerge {
    static constexpr bool PERM = true;
    const bf16_t* SGB; bf16_t* MG;
    __device__ __forceinline__ void operator()(const f32x4 (&acc)[2][2][4][2], const Unit& u, int wr, int wc, int fr, int fq) const {
        const int row0 = u.pm * BM + wr * 64 + fr, col0 = u.pn * BM + wc * 32 + 8 * fq;
#pragma unroll
        for (int ai = 0; ai < 2; ++ai) {
            u32x4 gv[4][2];
#pragma unroll
            for (int m = 0; m < 4; ++m)
#pragma unroll
                for (int bj = 0; bj < 2; ++bj) gv[m][bj] = *(const u32x4*)(SGB + (size_t)(row0 + ai * HALF + m * 16) * 1024 + col0 + bj * HALF);
            asm volatile("" ::: "memory");
#pragma unroll
            for (int m = 0; m < 4; ++m)
#pragma unroll
                for (int bj = 0; bj < 2; ++bj) { const size_t e = (size_t)(row0 + ai * HALF + m * 16) * 1024 + col0 + bj * HALF;
                    float g[8]; unpack8(gv[m][bj], g); float v[8];
#pragma unroll
                    for (int k = 0; k < 4; ++k) { v[k] = g[k] * acc[ai][bj][m][0][k]; v[4 + k] = g[4 + k] * acc[ai][bj][m][1][k]; }
                    u32x4 w; w.x = cvt_pk_bf16(v[0], v[1]); w.y = cvt_pk_bf16(v[2], v[3]); w.z = cvt_pk_bf16(v[4], v[5]); w.w = cvt_pk_bf16(v[6], v[7]);
                    *(u32x4*)(MG + e) = w; }
            asm volatile("" ::: "memory");
        }
    }
};
__device__ __forceinline__ unsigned pk4_fp8(float a, float b, float c, float d);
struct EpiOut2 {
    static constexpr bool PERM = true;
#if defined(DUP_EPI)
    static constexpr bool DUPE = ((DUP_EPI >> 4) & 1) != 0;
#endif
    const float* X; bf16_t* X1B; unsigned char* X1F8;
    __device__ __forceinline__ void operator()(const f32x4 (&acc)[2][2][4][2], const Unit& u, int wr, int wc, int fr, int fq) const {
        const int row0 = u.pm * BM + wr * 64 + fr, col0 = u.pn * BM + wc * 32 + 8 * fq;
#pragma unroll
        for (int ai = 0; ai < 2; ++ai) {
            f32x4 xv[4][2][2];
#pragma unroll
            for (int m = 0; m < 4; ++m)
#pragma unroll
                for (int bj = 0; bj < 2; ++bj) { const size_t e = (size_t)(row0 + ai * HALF + m * 16) * 1024 + col0 + bj * HALF; xv[m][bj][0] = *(const f32x4*)(X + e); xv[m][bj][1] = *(const f32x4*)(X + e + 4); }
            asm volatile("" ::: "memory");
#pragma unroll
            for (int m = 0; m < 4; ++m)
#pragma unroll
                for (int bj = 0; bj < 2; ++bj) { const size_t e = (size_t)(row0 + ai * HALF + m * 16) * 1024 + col0 + bj * HALF;
                    const f32x4 y0 = xv[m][bj][0] + acc[ai][bj][m][0], y1 = xv[m][bj][1] + acc[ai][bj][m][1];
                    u32x4 w; w.x = cvt_pk_bf16(y0[0], y0[1]); w.y = cvt_pk_bf16(y0[2], y0[3]); w.z = cvt_pk_bf16(y1[0], y1[1]); w.w = cvt_pk_bf16(y1[2], y1[3]);
                    *(u32x4*)(X1B + e) = w;
                    if (X1F8) { u32x2 w8; w8.x = pk4_fp8(y0[0], y0[1], y0[2], y0[3]); w8.y = pk4_fp8(y1[0], y1[1], y1[2], y1[3]); *(u32x2*)(X1F8 + e) = w8; } }
            asm volatile("" ::: "memory");
        }
    }
};

struct MoeOrder {
    const LAS int* tp; const LAS int* off; const char* A; const char* W; const int* LIST;
    size_t w_expert_bytes, w_tile_bytes, a_row_bytes; int lg, G, c, gather;
    __device__ __forceinline__ bool next(int i, Unit& u) const {
#if defined(MOE_ORDER_XCD)
        const int nt_all = tp[32], per = (nt_all + 7) >> 3, x = c & 7, lu = i * (G >> 3) + (c >> 3);
        int ti, pn;
        if (lg == 3) { const int g = lu >> 6, r = lu & 63; pn = 4 * (r >> 5) + (r & 3); ti = x * per + 8 * g + ((r & 31) >> 2); if (8 * g + ((r & 31) >> 2) >= per) return false; }
        else { const int g = lu >> 5, r = lu & 31; pn = r & 3; ti = x * per + 8 * g + (r >> 2); if (8 * g + (r >> 2) >= per) return false; }
        if (ti >= nt_all) return false;
#else
        const int L = i * G + c, ti = L >> lg, pn = L & ((1 << lg) - 1);
        if (ti >= tp[32]) return false;
#endif
        int e = 0;
#pragma unroll 8
        for (int j = 1; j < 32; ++j) e += (tp[j] <= ti) ? 1 : 0;
        e = __builtin_amdgcn_readfirstlane(e);
        const int rt = ti - tp[e], cnt = off[e + 1] - off[e], row0 = off[e] + 256 * rt;
        u.e = e; u.pn = pn; u.pm = __builtin_amdgcn_readfirstlane(row0); u.rows = __builtin_amdgcn_readfirstlane(min(256, cnt - 256 * rt));
        u.a = gather ? A : A + (size_t)u.pm * a_row_bytes; u.b = W + (size_t)e * w_expert_bytes + (size_t)pn * w_tile_bytes; return true;
    }
    __device__ __forceinline__ void rows(const Unit& u, int R0, int R1, int (&r)[4]) const {
        const int* l = LIST + u.pm; const int mx = u.rows - 1;
        r[0] = l[min(R0, mx)]; r[1] = l[min(R1, mx)]; r[2] = l[min(R0 + 128, mx)]; r[3] = l[min(R1 + 128, mx)];
    }
};
struct EpiGU2 {
    static constexpr bool PERM = true;
#if defined(DUP_EPI)
    static constexpr bool DUPE = ((DUP_EPI >> 5) & 1) != 0;
#endif
    const float* RS; const float* BGUP; bf16_t* ACT;
    __device__ __forceinline__ void operator()(const f32x4 (&acc)[2][2][4][2], const Unit& u, int wr, int wc, int fr, int fq) const {
        const int cl = 32 * wc + 8 * fq; const float* bp = BGUP + (size_t)u.e * 2048 + 256 * u.pn + cl;
        f32x4 bg[2], bl[2];
#pragma unroll
        for (int n = 0; n < 2; ++n) { bg[n] = *(const f32x4*)(bp + 4 * n); bl[n] = *(const f32x4*)(bp + 128 + 4 * n); }
#pragma unroll
        for (int ai = 0; ai < 2; ++ai)
#pragma unroll
            for (int m = 0; m < 4; ++m) { const int r = ai * HALF + wr * 64 + m * 16 + fr;
                if (r < u.rows) { const size_t p = (size_t)u.pm + r; const float rs = RS[p]; float a[8];
#pragma unroll
                    for (int n = 0; n < 2; ++n)
#pragma unroll
                        for (int k = 0; k < 4; ++k) { const float g = fminf(acc[ai][0][m][n][k] * rs + bg[n][k], 7.0f), l = fminf(fmaxf(acc[ai][1][m][n][k] * rs + bl[n][k], -7.0f), 7.0f);
                            a[4 * n + k] = g * sigmoidf_(1.702f * g) * (l + 1.0f); }
                    u32x4 w; w.x = cvt_pk_bf16(a[0], a[1]); w.y = cvt_pk_bf16(a[2], a[3]); w.z = cvt_pk_bf16(a[4], a[5]); w.w = cvt_pk_bf16(a[6], a[7]);
                    *(u32x4*)(ACT + p * 1024 + 128 * u.pn + cl) = w; } }
    }
};
struct EpiDown2 {
    static constexpr bool PERM = true;
#if defined(DUP_EPI)
    static constexpr bool DUPE = ((DUP_EPI >> 6) & 1) != 0;
#endif
    const float* GW; const float* BD; unsigned char* Y;
    __device__ __forceinline__ void operator()(const f32x4 (&acc)[2][2][4][2], const Unit& u, int wr, int wc, int fr, int fq) const {
        const int col0 = u.pn * BM + 32 * wc + 8 * fq; const float* bp = BD + (size_t)u.e * 1024 + col0;
        f32x4 bv[2][2];
#pragma unroll
        for (int bj = 0; bj < 2; ++bj)
#pragma unroll
            for (int n = 0; n < 2; ++n) bv[bj][n] = *(const f32x4*)(bp + bj * HALF + 4 * n);
#pragma unroll
        for (int ai = 0; ai < 2; ++ai)
#pragma unroll
            for (int m = 0; m < 4; ++m) { const int r = ai * HALF + wr * 64 + m * 16 + fr;
                if (r < u.rows) { const size_t p = (size_t)u.pm + r; const float gw = GW[p];
#pragma unroll
                    for (int bj = 0; bj < 2; ++bj) { const f32x4 v0 = (acc[ai][bj][m][0] + bv[bj][0]) * gw, v1 = (acc[ai][bj][m][1] + bv[bj][1]) * gw;
                        u32x4 w; w.x = cvt_pk_bf16(v0[0], v0[1]); w.y = cvt_pk_bf16(v0[2], v0[3]); w.z = cvt_pk_bf16(v1[0], v1[1]); w.w = cvt_pk_bf16(v1[2], v1[3]);
                        *(u32x4*)(Y + p * 1024 + col0 + bj * HALF) = w; } } }
    }
};

constexpr float F8_SW = 32.0f, F8_SA = 4.0f, F8_SY = 16.0f;
__device__ __forceinline__ unsigned pk4_fp8(float a, float b, float c, float d) {
    a = fminf(fmaxf(a, -448.f), 448.f); b = fminf(fmaxf(b, -448.f), 448.f); c = fminf(fmaxf(c, -448.f), 448.f); d = fminf(fmaxf(d, -448.f), 448.f);
    int w = 0; w = __builtin_amdgcn_cvt_pk_fp8_f32(a, b, w, false); w = __builtin_amdgcn_cvt_pk_fp8_f32(c, d, w, true); return (unsigned)w; }
struct EpiGU8 {
    static constexpr bool PERM = true;
    const float* RS; const float* BGUP; unsigned char* ACT8;
    __device__ __forceinline__ void operator()(const f32x4 (&acc)[2][2][4][2], const Unit& u, int wr, int wc, int fr, int fq) const {
        const int cl = 32 * wc + 8 * fq; const float* bp = BGUP + (size_t)u.e * 2048 + 256 * u.pn + cl;
        f32x4 bg[2], bl[2];
#pragma unroll
        for (int n = 0; n < 2; ++n) { bg[n] = *(const f32x4*)(bp + 4 * n); bl[n] = *(const f32x4*)(bp + 128 + 4 * n); }
        float rsv[2][4];
#pragma unroll
        for (int ai = 0; ai < 2; ++ai)
#pragma unroll
            for (int m = 0; m < 4; ++m) { const int r = ai * HALF + wr * 64 + m * 16 + fr; rsv[ai][m] = RS[(size_t)u.pm + min(r, u.rows - 1)]; }
        asm volatile("" ::: "memory");
#pragma unroll
        for (int ai = 0; ai < 2; ++ai)
#pragma unroll
            for (int m = 0; m < 4; ++m) { const int r = ai * HALF + wr * 64 + m * 16 + fr;
                if (r < u.rows) { const size_t p = (size_t)u.pm + r; const float rs = rsv[ai][m] * (1.0f / F8_SW); float a[8];
#pragma unroll
                    for (int n = 0; n < 2; ++n)
#pragma unroll
                        for (int k = 0; k < 4; ++k) { const float g = fminf(acc[ai][0][m][n][k] * rs + bg[n][k], 7.0f), l = fminf(fmaxf(acc[ai][1][m][n][k] * rs + bl[n][k], -7.0f), 7.0f);
                            a[4 * n + k] = g * sigmoidf_(1.702f * g) * (l + 1.0f) * F8_SA; }
                    u32x2 w; w.x = pk4_fp8(a[0], a[1], a[2], a[3]); w.y = pk4_fp8(a[4], a[5], a[6], a[7]);
                    *(u32x2*)(ACT8 + p * 1024 + 128 * u.pn + cl) = w; } }
    }
};
struct EpiDown8 {
    static constexpr bool PERM = true;
    const float* GW; const float* BD; unsigned char* Y;
    __device__ __forceinline__ void operator()(const f32x4 (&acc)[2][2][4][2], const Unit& u, int wr, int wc, int fr, int fq) const {
        const int col0 = u.pn * BM + 32 * wc + 8 * fq; const float* bp = BD + (size_t)u.e * 1024 + col0;
        f32x4 bv[2][2];
#pragma unroll
        for (int bj = 0; bj < 2; ++bj)
#pragma unroll
            for (int n = 0; n < 2; ++n) bv[bj][n] = *(const f32x4*)(bp + bj * HALF + 4 * n);
        constexpr float inv = 1.0f / (F8_SW * F8_SA);
        float gwv[2][4];
#pragma unroll
        for (int ai = 0; ai < 2; ++ai)
#pragma unroll
            for (int m = 0; m < 4; ++m) { const int r = ai * HALF + wr * 64 + m * 16 + fr; gwv[ai][m] = GW[(size_t)u.pm + min(r, u.rows - 1)]; }
        asm volatile("" ::: "memory");
#pragma unroll
        for (int ai = 0; ai < 2; ++ai)
#pragma unroll
            for (int m = 0; m < 4; ++m) { const int r = ai * HALF + wr * 64 + m * 16 + fr;
                if (r < u.rows) { const size_t p = (size_t)u.pm + r; const float gw = gwv[ai][m];
#pragma unroll
                    for (int bj = 0; bj < 2; ++bj) { const f32x4 v0 = (acc[ai][bj][m][0] * inv + bv[bj][0]) * (gw * F8_SY), v1 = (acc[ai][bj][m][1] * inv + bv[bj][1]) * (gw * F8_SY);
                        u32x2 w; w.x = pk4_fp8(v0[0], v0[1], v0[2], v0[3]); w.y = pk4_fp8(v1[0], v1[1], v1[2], v1[3]);
                        *(u32x2*)(Y + p * 1024 + col0 + bj * HALF) = w; } } }
    }
};
}


__device__ __forceinline__ unsigned pk2(float lo, float hi) { return (unsigned)f2bf(lo) | ((unsigned)f2bf(hi) << 16); }
#define SINK_U(x) asm volatile("" :: "v"(x))
template <bool DRY>
__device__ __forceinline__ void hgrn2_pass_b(int gthread, float* UB, const float* DECB) {
    constexpr int NBH = 64 / HG_NB;
    const int bh = gthread >> 12, rem = gthread & 4095, dv = rem >> 5, dkg = rem & 31;
    f32x4 S = (f32x4){0.f, 0.f, 0.f, 0.f};
    float* p = UB + (size_t)bh * NBH * 16384 + dv * 128 + dkg * 4;
    const float* dp = DECB + (size_t)bh * NBH * 128 + dkg * 4;
    f32x4 u[NBH], d4[NBH];
#pragma unroll
    for (int k = 0; k < NBH; ++k) { u[k] = *(const f32x4*)(p + (size_t)k * 16384); d4[k] = *(const f32x4*)(dp + k * 128); }
#pragma unroll
    for (int k = 0; k < NBH; ++k) { if (!DRY) *(f32x4*)(p + (size_t)k * 16384) = S; else SINK_U(S[0]); S = d4[k] * S + u[k]; }
}

typedef short v4i16_t __attribute__((ext_vector_type(4)));
__device__ __forceinline__ u32x2 vtr64(const LAS unsigned char* p) { return __builtin_bit_cast(u32x2, __builtin_amdgcn_ds_read_tr16_b64_v4i16((LAS v4i16_t*)p)); }
template <bool DRY>
__device__ __forceinline__ void hgrn2_pass_c_phase(LAS unsigned char* lds, int bx, int G, bf16_t* QI, const bf16_t* KI, const bf16_t* Vs, const bf16_t* Gs, const float* SP, const float* gn_w, bf16_t* OA, const float* DEC) {
    constexpr int P = 272, L_Q = 0, L_K = 17408, L_V = 34816, L_G = 52224, L_S = 69632, L_SS = 104448, NCH = BATCH * NH * 64;
    const int tid = threadIdx.x, lane = tid & 63, w = __builtin_amdgcn_readfirstlane(tid >> 6);
    const int it = w >> 1, hv = w & 1, cc = lane & 15, q = lane >> 4;
    const int lrow = tid >> 4, lch = tid & 15;
    u32x4 rq[2], rk[2], rv[2], rg[2];
    f32x4 Sreg[8];
#define PC_LOAD(cid_) do { const int _bh = (cid_) >> 6, _n = (cid_) & 63, _b = _bh >> 3, _h = _bh & 7; \
        const size_t _e = ((size_t)_b * SEQ + (size_t)_n * 64 + lrow) * 1024 + _h * 128 + lch * 8; \
        _Pragma("unroll") for (int _j = 0; _j < 2; ++_j) { rq[_j] = *(const u32x4*)(QI + _e + (size_t)_j * 32 * 1024); rk[_j] = *(const u32x4*)(KI + _e + (size_t)_j * 32 * 1024); \
            rv[_j] = *(const u32x4*)(Vs + _e + (size_t)_j * 32 * 1024); rg[_j] = *(const u32x4*)(Gs + _e + (size_t)_j * 32 * 1024); } \
        } while (0)
    constexpr int NBLK = NCH / HG_NB;
#define PC_CID(li_) (HG_NB * (bx + ((li_) / HG_NB) * G) + ((li_) % HG_NB))
#define PC_OK(li_) (bx + ((li_) / HG_NB) * G < NBLK)
    int li = 0;
    if (PC_OK(0)) PC_LOAD(PC_CID(0));
    for (; PC_OK(li); ++li) {
        const int cid = PC_CID(li);
        __syncthreads();
#pragma unroll
        for (int j = 0; j < 2; ++j) { const int o = (lrow + 32 * j) * P + lch * 16;
            *(LAS u32x4*)(lds + L_Q + o) = rq[j]; *(LAS u32x4*)(lds + L_K + o) = rk[j]; *(LAS u32x4*)(lds + L_V + o) = rv[j]; *(LAS u32x4*)(lds + L_G + o) = rg[j]; }
        if (cid % HG_NB == 0) {
            const float* eb = SP + (size_t)(cid / HG_NB) * 16384;
#pragma unroll
            for (int j = 0; j < 8; ++j)
#pragma unroll
                for (int r = 0; r < 4; ++r) Sreg[j][r] = eb[(16 * w + 4 * q + r) * 128 + 16 * j + cc];
#pragma unroll
            for (int j = 0; j < 8; ++j)
#pragma unroll
                for (int r = 0; r < 4; ++r) *(LAS bf16_t*)(lds + L_S + (16 * w + 4 * q + r) * P + (16 * j + cc) * 2) = f2bf(Sreg[j][r]);
        }
        if (PC_OK(li + 1)) PC_LOAD(PC_CID(li + 1));
        __syncthreads();
        const int bh = cid >> 6, n = cid & 63, b = bh >> 3, h = bh & 7;
        const size_t t0 = (size_t)b * SEQ + (size_t)n * 64;
        bf16x8 qf[4];
#pragma unroll
        for (int ks = 0; ks < 4; ++ks) qf[ks] = *(const LAS bf16x8*)(lds + L_Q + (16 * it + cc) * P + (32 * ks + 8 * q) * 2);
        f32x4 sT[4];
#pragma unroll
        for (int jt = 0; jt < 4; ++jt) {
            sT[jt] = (f32x4){0.f, 0.f, 0.f, 0.f};
            if (jt <= it) {
#pragma unroll
                for (int ks = 0; ks < 4; ++ks) { const bf16x8 kf = *(const LAS bf16x8*)(lds + L_K + (16 * jt + cc) * P + (32 * ks + 8 * q) * 2); sT[jt] = __builtin_amdgcn_mfma_f32_16x16x32_bf16(kf, qf[ks], sT[jt], 0, 0, 0); }
                if (jt == it) {
#pragma unroll
                    for (int r = 0; r < 4; ++r) if (4 * q + r > cc) sT[jt][r] = 0.f;
                }
            }
        }
        bf16x8 pf[2];
#pragma unroll
        for (int s2 = 0; s2 < 2; ++s2) { u32x4 pw; pw.x = pk2(sT[2 * s2][0], sT[2 * s2][1]); pw.y = pk2(sT[2 * s2][2], sT[2 * s2][3]); pw.z = pk2(sT[2 * s2 + 1][0], sT[2 * s2 + 1][1]); pw.w = pk2(sT[2 * s2 + 1][2], sT[2 * s2 + 1][3]); pf[s2] = __builtin_bit_cast(bf16x8, pw); }
        f32x4 acc[4];
#pragma unroll
        for (int dt = 0; dt < 4; ++dt) acc[dt] = (f32x4){0.f, 0.f, 0.f, 0.f};
#pragma unroll
        for (int dt = 0; dt < 4; ++dt) {
            const int dvt = 4 * hv + dt, dv = 16 * dvt + cc;
#pragma unroll
            for (int s2 = 0; s2 < 2; ++s2) {
                if (2 * s2 <= it) {
                    const LAS unsigned char* vp = lds + L_V + (32 * s2 + 4 * q + (cc >> 2)) * P + (16 * dvt + 4 * (cc & 3)) * 2;
                    const u32x2 lo = vtr64(vp), hi2 = vtr64(vp + 16 * P);
                    const bf16x8 vf = __builtin_bit_cast(bf16x8, (u32x4){lo.x, lo.y, hi2.x, hi2.y});
                    acc[dt] = __builtin_amdgcn_mfma_f32_16x16x32_bf16(vf, pf[s2], acc[dt], 0, 0, 0);
                }
            }
#pragma unroll
            for (int ks = 0; ks < 4; ++ks) { const bf16x8 sf = *(const LAS bf16x8*)(lds + L_S + dv * P + (32 * ks + 8 * q) * 2); acc[dt] = __builtin_amdgcn_mfma_f32_16x16x32_bf16(sf, qf[ks], acc[dt], 0, 0, 0); }
        }
        float ss = 0.f;
#pragma unroll
        for (int dt = 0; dt < 4; ++dt) ss += (acc[dt][0] * acc[dt][0] + acc[dt][1] * acc[dt][1]) + (acc[dt][2] * acc[dt][2] + acc[dt][3] * acc[dt][3]);
        ss += __shfl_xor(ss, 16); ss += __shfl_xor(ss, 32);
        LAS float* SS = (LAS float*)(lds + L_SS);
        if (q == 0) SS[(16 * it + cc) * 2 + hv] = ss;
        __syncthreads();
        const float rstd = rsqrtf((SS[(16 * it + cc) * 2] + SS[(16 * it + cc) * 2 + 1]) * (1.0f / DV) + EPS);
#pragma unroll
        for (int dt = 0; dt < 4; ++dt) {
            const int dv0 = 16 * (4 * hv + dt) + 4 * q; const size_t e = (t0 + 16 * it + cc) * 1024 + h * 128 + dv0;
            const u32x2 gw2 = *(const LAS u32x2*)(lds + L_G + (16 * it + cc) * P + dv0 * 2); const f32x4 gn = *(const f32x4*)(gn_w + h * 128 + dv0);
            const float g0 = __uint_as_float(gw2.x << 16), g1 = __uint_as_float(gw2.x & 0xffff0000u), g2 = __uint_as_float(gw2.y << 16), g3 = __uint_as_float(gw2.y & 0xffff0000u);
            u32x2 o; o.x = pk2(acc[dt][0] * rstd * gn[0] * siluf_(g0), acc[dt][1] * rstd * gn[1] * siluf_(g1)); o.y = pk2(acc[dt][2] * rstd * gn[2] * siluf_(g2), acc[dt][3] * rstd * gn[3] * siluf_(g3));
            if (!DRY) *(u32x2*)(OA + e) = o; else { SINK_U(o.x); SINK_U(o.y); }
        }
        if (cid % HG_NB != HG_NB - 1) {
            f32x4 a2[8];
#pragma unroll
            for (int j = 0; j < 8; ++j) a2[j] = (f32x4){0.f, 0.f, 0.f, 0.f};
#pragma unroll
            for (int ks = 0; ks < 2; ++ks) {
                const LAS unsigned char* ap = lds + L_V + (32 * ks + 8 * q + (cc >> 2)) * P + (16 * w + 4 * (cc & 3)) * 2;
                const u32x2 alo = vtr64(ap), ahi = vtr64(ap + 4 * P);
                const bf16x8 av = __builtin_bit_cast(bf16x8, (u32x4){alo.x, alo.y, ahi.x, ahi.y});
#pragma unroll
                for (int j = 0; j < 8; ++j) { const LAS unsigned char* bp = lds + L_K + (32 * ks + 8 * q + (cc >> 2)) * P + (16 * j + 4 * (cc & 3)) * 2;
                    const u32x2 blo = vtr64(bp), bhi = vtr64(bp + 4 * P);
                    a2[j] = __builtin_amdgcn_mfma_f32_16x16x32_bf16(av, __builtin_bit_cast(bf16x8, (u32x4){blo.x, blo.y, bhi.x, bhi.y}), a2[j], 0, 0, 0); }
            }
            const float* dc = DEC + (size_t)cid * 128;
#pragma unroll
            for (int j = 0; j < 8; ++j) { const float dj = dc[16 * j + cc];
#pragma unroll
                for (int r = 0; r < 4; ++r) { Sreg[j][r] = dj * (Sreg[j][r] + a2[j][r]); *(LAS bf16_t*)(lds + L_S + (16 * w + 4 * q + r) * P + (16 * j + cc) * 2) = f2bf(Sreg[j][r]); } }
        }
    }
    __syncthreads();
#undef PC_LOAD
#undef PC_CID
#undef PC_OK
}

template <bool DRY>
__device__ __forceinline__ void hgrn2_pass_a_phase(LAS unsigned char* lds, int bx, int G, bf16_t* Qs, bf16_t* Fs, const bf16_t* Vs, const float* LBV, float* UB, float* DEC, float* DECB) {
    constexpr int P = 272, L_Q = 0, L_F = 17408, L_V = 34816, L_KD = 52224, L_SEG = 69632, NCH = BATCH * NH * 64;
    const int tid = threadIdx.x, lane = tid & 63, w = __builtin_amdgcn_readfirstlane(tid >> 6), d = tid & 127, sg = tid >> 7;
    const int cc = lane & 15, q = lane >> 4, lrow = tid >> 4, lch = tid & 15;
    LAS float* SEGSUM = (LAS float*)(lds + L_SEG);
    u32x4 rq[2], rf[2], rv[2];
#define PA_LOAD(cid_) do { const int _bh = (cid_) >> 6, _n = (cid_) & 63, _b = _bh >> 3, _h = _bh & 7; \
        const size_t _e = ((size_t)_b * SEQ + (size_t)_n * 64 + lrow) * 1024 + _h * 128 + lch * 8; \
        _Pragma("unroll") for (int _j = 0; _j < 2; ++_j) { rq[_j] = *(const u32x4*)(Qs + _e + (size_t)_j * 32 * 1024); rf[_j] = *(const u32x4*)(Fs + _e + (size_t)_j * 32 * 1024); rv[_j] = *(const u32x4*)(Vs + _e + (size_t)_j * 32 * 1024); } } while (0)
    constexpr int NBLK = NCH / HG_NB;
    LAS float* ETOT = (LAS float*)(lds + L_SEG + 2048);
#define PA_CID(li_) (HG_NB * (bx + ((li_) / HG_NB) * G) + ((li_) % HG_NB))
#define PA_OK(li_) (bx + ((li_) / HG_NB) * G < NBLK)
    int li = 0; float prev_etot = 1.f;
    f32x4 acc[8];
    if (PA_OK(0)) PA_LOAD(PA_CID(0));
    for (; PA_OK(li); ++li) {
        const int cid = PA_CID(li);
        __syncthreads();
#pragma unroll
        for (int j = 0; j < 2; ++j) { const int o = (lrow + 32 * j) * P + lch * 16; *(LAS u32x4*)(lds + L_Q + o) = rq[j]; *(LAS u32x4*)(lds + L_F + o) = rf[j]; *(LAS u32x4*)(lds + L_V + o) = rv[j]; }
        if (PA_OK(li + 1)) PA_LOAD(PA_CID(li + 1));
        __syncthreads();
        const int bh = cid >> 6, n = cid & 63, b = bh >> 3, h = bh & 7;
        const size_t t0 = (size_t)b * SEQ + (size_t)n * 64;
        const float lb = LBV[h * 128 + d];
        float kk[16], cum[16], qs[16]; float c = 1.f;
#pragma unroll
        for (int i = 0; i < 16; ++i) {
            const float fl = bf2f(*(const LAS bf16_t*)(lds + L_F + (16 * sg + i) * P + 2 * d)); qs[i] = siluf_(bf2f(*(const LAS bf16_t*)(lds + L_Q + (16 * sg + i) * P + 2 * d)));
            const float f = lb + (1.0f - lb) * sigmoidf_(fl);
            kk[i] = 1.0f - f; c *= f; cum[i] = c;
        }
        SEGSUM[sg * 128 + d] = c;
        __syncthreads();
        float eoffs = 1.f, etot = 1.f;
#pragma unroll
        for (int s2 = 0; s2 < 4; ++s2) { const float v = SEGSUM[s2 * 128 + d]; etot *= v; if (s2 < sg) eoffs *= v; }
#pragma unroll
        for (int i = 0; i < 16; i += 2) {
            const float ex0 = eoffs * cum[i], ex1 = eoffs * cum[i + 1];
            const float ki0 = kk[i] * __builtin_amdgcn_rcpf(ex0), ki1 = kk[i + 1] * __builtin_amdgcn_rcpf(ex1);
            const unsigned wq = pg8::cvt_pk_bf16(qs[i] * ex0, qs[i + 1] * ex1), wk = pg8::cvt_pk_bf16(ki0, ki1), wd = pg8::cvt_pk_bf16(ki0 * etot, ki1 * etot);
            *(LAS bf16_t*)(lds + L_Q + (16 * sg + i) * P + 2 * d) = (bf16_t)(wq & 0xffffu); *(LAS bf16_t*)(lds + L_Q + (16 * sg + i + 1) * P + 2 * d) = (bf16_t)(wq >> 16);
            *(LAS bf16_t*)(lds + L_F + (16 * sg + i) * P + 2 * d) = (bf16_t)(wk & 0xffffu); *(LAS bf16_t*)(lds + L_F + (16 * sg + i + 1) * P + 2 * d) = (bf16_t)(wk >> 16);
            *(LAS bf16_t*)(lds + L_KD + (16 * sg + i) * P + 2 * d) = (bf16_t)(wd & 0xffffu); *(LAS bf16_t*)(lds + L_KD + (16 * sg + i + 1) * P + 2 * d) = (bf16_t)(wd >> 16);
        }
        if (sg == 0) { ETOT[d] = etot; prev_etot = (cid % HG_NB == 0) ? etot : prev_etot * etot; if (!DRY) { DEC[(size_t)cid * 128 + d] = etot; if (cid % HG_NB == HG_NB - 1) DECB[(size_t)(cid / HG_NB) * 128 + d] = prev_etot; } }
        __syncthreads();
#pragma unroll
        for (int j = 0; j < 2; ++j) { const int o = (lrow + 32 * j) * P + lch * 16; const size_t e = (t0 + lrow + 32 * j) * 1024 + h * 128 + lch * 8;
            const u32x4 a = *(const LAS u32x4*)(lds + L_Q + o), b2 = *(const LAS u32x4*)(lds + L_F + o);
            if (!DRY) { *(u32x4*)(Qs + e) = a; *(u32x4*)(Fs + e) = b2; } else { SINK_U(a.x); SINK_U(b2.x); } }
        if (cid % HG_NB == 0) {
#pragma unroll
            for (int j = 0; j < 8; ++j) acc[j] = (f32x4){0.f, 0.f, 0.f, 0.f};
        } else { const f32x4 e4 = *(const LAS f32x4*)(ETOT + 16 * w + 4 * q);
#pragma unroll
            for (int j = 0; j < 8; ++j) acc[j] = acc[j] * e4; }
#pragma unroll
        for (int ks = 0; ks < 2; ++ks) {
            const LAS unsigned char* ap = lds + L_KD + (32 * ks + 8 * q + (cc >> 2)) * P + (16 * w + 4 * (cc & 3)) * 2;
            const u32x2 alo = vtr64(ap), ahi = vtr64(ap + 4 * P);
            const bf16x8 a = __builtin_bit_cast(bf16x8, (u32x4){alo.x, alo.y, ahi.x, ahi.y});
#pragma unroll
            for (int j = 0; j < 8; ++j) { const LAS unsigned char* bp = lds + L_V + (32 * ks + 8 * q + (cc >> 2)) * P + (16 * j + 4 * (cc & 3)) * 2;
                const u32x2 blo = vtr64(bp), bhi = vtr64(bp + 4 * P);
                acc[j] = __builtin_amdgcn_mfma_f32_16x16x32_bf16(a, __builtin_bit_cast(bf16x8, (u32x4){blo.x, blo.y, bhi.x, bhi.y}), acc[j], 0, 0, 0); }
        }
        if (cid % HG_NB == HG_NB - 1) { float* ut = UB + (size_t)(cid / HG_NB) * 16384;
#pragma unroll
            for (int j = 0; j < 8; ++j) { if (!DRY) *(f32x4*)(ut + (16 * j + cc) * 128 + 16 * w + 4 * q) = acc[j]; else { SINK_U(acc[j][0]); SINK_U(acc[j][3]); } } }
    }
    __syncthreads();
#undef PA_LOAD
#undef PA_CID
#undef PA_OK
}

__device__ __forceinline__ float gelu_fast(float x) { const float u = 0.7978845608028654f * (x + 0.044715f * x * x * x); return x * sigmoidf_(2.0f * u); }
__device__ __forceinline__ void lru_s1(int b, int n, const bf16_t* LA, const bf16_t* UU, float* LP, float* LH) {
    const int tid = threadIdx.x; const size_t e0 = ((size_t)b * SEQ + (size_t)n * 64) * 1024 + 2 * tid;
    float sl0 = 0.f, sl1 = 0.f, h0 = 0.f, h1 = 0.f;
    for (int t0 = 0; t0 < 64; t0 += 8) {
        unsigned l[8], u[8];
#pragma unroll
        for (int j = 0; j < 8; ++j) { l[j] = *(const unsigned*)(LA + e0 + (size_t)(t0 + j) * 1024); u[j] = *(const unsigned*)(UU + e0 + (size_t)(t0 + j) * 1024); }
#pragma unroll
        for (int j = 0; j < 8; ++j) {
            const float la0 = __uint_as_float(l[j] << 16), la1 = __uint_as_float(l[j] & 0xffff0000u);
            sl0 += la0; sl1 += la1;
            h0 = __expf(la0) * h0 + __uint_as_float(u[j] << 16); h1 = __expf(la1) * h1 + __uint_as_float(u[j] & 0xffff0000u);
        }
    }
    const size_t o = ((size_t)b * 64 + n) * 1024 + 2 * tid;
    *(float2*)(LP + o) = make_float2(__expf(sl0), __expf(sl1)); *(float2*)(LH + o) = make_float2(h0, h1);
}
template <bool DRY>
__device__ __forceinline__ void lru_s3(int b, int npair, const bf16_t* LA, const bf16_t* UU, const float* LP, const float* LH, bf16_t* GATE_OB) {
    const int tid = threadIdx.x, half = tid >> 8, c0 = 4 * (tid & 255); const int n = half ? 63 - npair : npair;
    const size_t e0 = ((size_t)b * SEQ + (size_t)n * 64) * 1024 + c0;
    float h[4] = {0.f, 0.f, 0.f, 0.f};
    {
        const size_t o = ((size_t)b * 64) * 1024 + c0;
        for (int m0 = 0; m0 < n; m0 += 8) {
            f32x4 p[8], hh[8];
#pragma unroll
            for (int j = 0; j < 8; ++j) { const int mm = (m0 + j < n) ? m0 + j : 0; p[j] = *(const f32x4*)(LP + o + (size_t)mm * 1024); hh[j] = *(const f32x4*)(LH + o + (size_t)mm * 1024); }
#pragma unroll
            for (int j = 0; j < 8; ++j) if (m0 + j < n) {
#pragma unroll
                for (int k = 0; k < 4; ++k) h[k] = p[j][k] * h[k] + hh[j][k]; }
        }
    }
    for (int t0 = 0; t0 < 64; t0 += 8) {
        u32x2 l[8], u[8], g[8];
#pragma unroll
        for (int j = 0; j < 8; ++j) { const size_t e = e0 + (size_t)(t0 + j) * 1024; l[j] = *(const u32x2*)(LA + e); u[j] = *(const u32x2*)(UU + e); g[j] = *(const u32x2*)(GATE_OB + e); }
#pragma unroll
        for (int j = 0; j < 8; ++j) {
            const unsigned lw[2] = {l[j].x, l[j].y}, uw[2] = {u[j].x, u[j].y}, gw[2] = {g[j].x, g[j].y}; float ov[4];
#pragma unroll
            for (int k = 0; k < 2; ++k) {
                h[2 * k] = __expf(__uint_as_float(lw[k] << 16)) * h[2 * k] + __uint_as_float(uw[k] << 16);
                h[2 * k + 1] = __expf(__uint_as_float(lw[k] & 0xffff0000u)) * h[2 * k + 1] + __uint_as_float(uw[k] & 0xffff0000u);
                ov[2 * k] = h[2 * k] * gelu_fast(__uint_as_float(gw[k] << 16)); ov[2 * k + 1] = h[2 * k + 1] * gelu_fast(__uint_as_float(gw[k] & 0xffff0000u)); }
            u32x2 o; o.x = pk2(ov[0], ov[1]); o.y = pk2(ov[2], ov[3]);
            if (!DRY) *(u32x2*)(GATE_OB + e0 + (size_t)(t0 + j) * 1024) = o; else { SINK_U(o.x); SINK_U(o.y); }
        }
    }
}

constexpr int RING_BYTES = 131072, LDSCTL_OFF = RING_BYTES, MISC_OFF = LDSCTL_OFF + 320, LDS_BYTES = 147456;
constexpr int NWAVES = 8;


constexpr size_t WS_ACT = 224 * MiB, WS_Y = 512 * MiB;
constexpr size_t WS_RSTD = 992 * MiB, WS_TOPE = 993 * MiB, WS_TOPW = 994 * MiB, WS_POS = 995 * MiB, WS_LIST = 996 * MiB, WS_GW = 997 * MiB, WS_RS = 998 * MiB, WS_WGH = 999 * MiB;
constexpr int CW_CNT = 512, CW_CUR = 576;
constexpr int MOE_TP = LDSCTL_OFF + 1024, MOE_OFF = LDSCTL_OFF + 1024 + 256, MOE_HIST = LDSCTL_OFF + 1024 + 512, MOE_BASE = LDSCTL_OFF + 1024 + 768, MOE_LCUR = LDSCTL_OFF + 2048;

typedef float f32x2v __attribute__((ext_vector_type(2)));
struct MArgs { const float* in[23]; float* out; unsigned char* ws; int ph_lo, ph_hi; };


template <class RowMap>
__device__ __forceinline__ void p0_transpose_item(const float* W, int K, int N, bf16_t* WT, const RowMap& rowmap, LAS float* scr, int item, int lane, const float* kscale = nullptr) {
    const int nblk = N / 32, kb = item / nblk, nb = item % nblk, k0 = 64 * kb, n0 = 32 * nb;
    {
        const int kr = lane >> 3, nq = lane & 7; f32x4 v[8];
#pragma unroll
        for (int i = 0; i < 8; ++i) v[i] = *(const f32x4*)(W + (size_t)(k0 + 8 * i + kr) * N + n0 + 4 * nq);
#pragma unroll
        for (int i = 0; i < 8; ++i) { LAS float* d = scr + (8 * i + kr) * 33 + 4 * nq; d[0] = v[i][0]; d[1] = v[i][1]; d[2] = v[i][2]; d[3] = v[i][3]; }
    }
    LDS_WAIT(); asm volatile("" ::: "memory");
    const int c = lane & 7;
    f32x4 k0s = (f32x4){1.f, 1.f, 1.f, 1.f}, k1s = k0s;
    if (kscale) { k0s = *(const f32x4*)(kscale + k0 + 8 * c); k1s = *(const f32x4*)(kscale + k0 + 8 * c + 4); }
#pragma unroll
    for (int j = 0; j < 4; ++j) { const int n = (lane >> 3) + 8 * j; const LAS float* s = scr + (8 * c) * 33 + n;
        u32x4 o; o.x = pk2(s[0 * 33] * k0s[0], s[1 * 33] * k0s[1]); o.y = pk2(s[2 * 33] * k0s[2], s[3 * 33] * k0s[3]); o.z = pk2(s[4 * 33] * k1s[0], s[5 * 33] * k1s[1]); o.w = pk2(s[6 * 33] * k1s[2], s[7 * 33] * k1s[3]);
        *(GAS u32x4*)(WT + (size_t)rowmap(n0 + n) * K + k0 + 8 * c) = o; }
    LDS_WAIT(); asm volatile("" ::: "memory");
}

__device__ __forceinline__ void p0_load8(const float* W, int N, int item, int lane, f32x4 (&v)[8]) {
    const int nblk = N / 32, kb = item / nblk, nb = item % nblk, k0 = 64 * kb, n0 = 32 * nb; const int kr = lane >> 3, nq = lane & 7;
#pragma unroll
    for (int i = 0; i < 8; ++i) v[i] = __builtin_nontemporal_load((const f32x4*)(W + (size_t)(k0 + 8 * i + kr) * N + n0 + 4 * nq));
}
template <class RowMap>
__device__ __forceinline__ void p0_finish8(const f32x4 (&v)[8], int K, int N, unsigned char* WT, const RowMap& rowmap, LAS float* scr, int item, int lane, float scale, const float* kscale) {
    const int nblk = N / 32, kb = item / nblk, nb = item % nblk, k0 = 64 * kb, n0 = 32 * nb; const int kr = lane >> 3, nq = lane & 7;
#pragma unroll
    for (int i = 0; i < 8; ++i) { LAS float* d = scr + (8 * i + kr) * 33 + 4 * nq; d[0] = v[i][0]; d[1] = v[i][1]; d[2] = v[i][2]; d[3] = v[i][3]; }
    LDS_WAIT(); asm volatile("" ::: "memory");
    const int c = lane & 7;
    f32x4 k0s = (f32x4){scale, scale, scale, scale}, k1s = k0s;
    if (kscale) { k0s = *(const f32x4*)(kscale + k0 + 8 * c) * scale; k1s = *(const f32x4*)(kscale + k0 + 8 * c + 4) * scale; }
#pragma unroll
    for (int j = 0; j < 4; ++j) { const int n = (lane >> 3) + 8 * j; const LAS float* s = scr + (8 * c) * 33 + n;
        u32x2 o; o.x = pg8::pk4_fp8(s[0 * 33] * k0s[0], s[1 * 33] * k0s[1], s[2 * 33] * k0s[2], s[3 * 33] * k0s[3]); o.y = pg8::pk4_fp8(s[4 * 33] * k1s[0], s[5 * 33] * k1s[1], s[6 * 33] * k1s[2], s[7 * 33] * k1s[3]);
        *(GAS u32x2*)(WT + (size_t)rowmap(n0 + n) * K + k0 + 8 * c) = o; }
    LDS_WAIT(); asm volatile("" ::: "memory");
}
template <class RowMap>
__device__ __forceinline__ void p0_convert_experts8(const float* W, int K, int N, unsigned char* WT, const RowMap& rowmap, LAS float* scr, int gw, int NGW, int lane, float scale, const float* kscale) {
    const int per = (K / 64) * (N / 32), tot = NE * per; const size_t esz = (size_t)K * N;
    f32x4 va[8], vb[8], vc[8], vd[8]; int it = gw;
#define P0_LD(i_, v_) do { if ((i_) < tot) p0_load8(W + (size_t)((i_) / per) * esz, N, (i_) % per, lane, v_); } while (0)
#define P0_FN(i_, v_) do { if ((i_) < tot) p0_finish8(v_, K, N, WT + (size_t)((i_) / per) * esz, rowmap, scr, (i_) % per, lane, scale, kscale); } while (0)
    P0_LD(it, va); P0_LD(it + NGW, vb); P0_LD(it + 2 * NGW, vc);
    for (; it < tot; it += 4 * NGW) {
        P0_LD(it + 3 * NGW, vd); P0_FN(it, va);
        P0_LD(it + 4 * NGW, va); P0_FN(it + NGW, vb);
        P0_LD(it + 5 * NGW, vb); P0_FN(it + 2 * NGW, vc);
        P0_LD(it + 6 * NGW, vc); P0_FN(it + 3 * NGW, vd);
    }
#undef P0_LD
#undef P0_FN
}
struct MapId { int off; __device__ __forceinline__ int operator()(int n) const { return off + n; } };
struct MapIn { __device__ __forceinline__ int operator()(int n) const { if (n < 6144) return n; const int c = (n - 6144) & 1023, isb = (n - 6144) >> 10; return 6144 + 256 * (c >> 7) + 128 * isb + (c & 127); } };
struct MapRG { int off; __device__ __forceinline__ int operator()(int n) const { return 256 * (n >> 7) + (n & 127) + off; } };
struct MapGU { __device__ __forceinline__ int operator()(int n) const { const int f = n >> 1, half = n & 1; return 256 * (f >> 7) + 128 * half + (f & 127); } };

#ifndef DUP_MASK
#define DUP_MASK 0u
#endif

#define NREP(k) (((DUP_MASK >> (k)) & 1u) ? 2 : 1)
__device__ __forceinline__ int hid_tid() { int t = threadIdx.x; asm volatile("" : "+v"(t)); return t; }
#define PHASE_IDS() const int tid = hid_tid(), lane = tid & 63, wave = __builtin_amdgcn_readfirstlane(tid >> 6); (void)lane; (void)wave
__global__ void __launch_bounds__(512, 2) mega(MArgs args) {
    extern __shared__ __attribute__((aligned(16))) unsigned char lds_raw[];
    LAS unsigned char* lds = (LAS unsigned char*)lds_raw;
    volatile LAS unsigned* MISC = (volatile LAS unsigned*)(lds + MISC_OFF);
    const int G = gridDim.x; const int bx = blockIdx.x; const int vcu = (G % 8 == 0) ? (bx % 8) * (G / 8) + bx / 8 : bx;
    unsigned char* ws = args.ws;
    gu32* ctl = (gu32*)(ws + WS_CTL);
    for (int u = threadIdx.x; u < (LDS_BYTES - LDSCTL_OFF) / 4; u += NWAVES * 64) ((LAS unsigned*)(lds + LDSCTL_OFF))[u] = 0u;
    __syncthreads();
    XcdBarrier bar = xcd_barrier_post((unsigned*)(ctl + CW_BAR), MISC + 8);
    const int lo = args.ph_lo, hi = args.ph_hi;
#define IN(k) (lo <= (k) && (k) < hi)
#define BOTH(k) (IN(k) && IN((k) + 1))
#define GRID_BAR() xcd_barrier(bar)
    const float* x = args.in[0];
    bf16_t* XN = (bf16_t*)(ws + WS_XN); bf16_t* SEG0 = (bf16_t*)(ws + WS_SEG);
    bf16_t* WIN_T = (bf16_t*)(ws + WS_WIN_T);

    if (IN(0)) for (int rep = 0; rep < NREP(0); ++rep) {
        if (rep) __syncthreads();
        PHASE_IDS();
        LAS float* scr = (LAS float*)(lds + wave * 16384);
        const int gw = vcu * NWAVES + wave, NGW = G * NWAVES;
        constexpr int I_IN = (D / 64) * (8192 / 32);
        for (int it = gw; it < I_IN; it += NGW) p0_transpose_item(args.in[2], D, 8192, WIN_T, MapIn{}, scr, it, lane);
        {
            bf16_t* WRG_T = (bf16_t*)(ws + WS_WRG_T); constexpr int I_RG = (256 / 64) * (256 / 32);
            for (int it = gw; it < 8 * I_RG; it += NGW) { const int mat = it / I_RG, r = it % I_RG, hh = mat >> 1, ax = mat & 1;
                p0_transpose_item(args.in[ax ? 9 : 7] + (size_t)hh * 65536, 256, 256, WRG_T + (size_t)hh * 512 * 256, MapRG{ax * 128}, scr, r, lane); }
        }
        {
            constexpr int I_SQ = (D / 64) * (D / 32);
            for (int it = gw; it < 3 * I_SQ; it += NGW) { const int mat = it / I_SQ, r = it % I_SQ;
                p0_transpose_item(args.in[12 + mat], D, D, (bf16_t*)(ws + (mat == 0 ? WS_WPA_T : mat == 1 ? WS_WPB_T : WS_WOUT_T)), MapId{0}, scr, r, lane); }
        }
        {
            constexpr int I_GU = (D / 64) * (2048 / 32), I_DN = (DFF / 64) * (D / 32);
            bf16_t* WGU_T = (bf16_t*)(ws + WS_WGU_T); bf16_t* WDN_T = (bf16_t*)(ws + WS_WDN_T);
#if MOE_FP8
#if !MOE_CONV_IN_P1
            p0_convert_experts8(args.in[18], D, 2048, (unsigned char*)WGU_T, MapGU{}, scr, gw, NGW, lane, pg8::F8_SW, args.in[15]);
            p0_convert_experts8(args.in[20], DFF, D, (unsigned char*)WDN_T, MapId{0}, scr, gw, NGW, lane, pg8::F8_SW, (const float*)nullptr);
#endif
            (void)I_GU; (void)I_DN;
#else
            for (int it = gw; it < NE * I_GU; it += NGW) { const int e = it / I_GU, r = it % I_GU; p0_transpose_item(args.in[18] + (size_t)e * D * 2048, D, 2048, WGU_T + (size_t)e * 2048 * D, MapGU{}, scr, r, lane, args.in[15]); }
            for (int it = gw; it < NE * I_DN; it += NGW) { const int e = it / I_DN, r = it % I_DN; p0_transpose_item(args.in[20] + (size_t)e * DFF * D, DFF, D, WDN_T + (size_t)e * D * DFF, MapId{0}, scr, r, lane); }
#endif
            float* BGUP = (float*)(ws + WS_BGUP); const MapGU mg{};
            for (int i = bx * 512 + tid; i < NE * 2048; i += G * 512) { const int e = i >> 11, n = i & 2047; BGUP[e * 2048 + mg(n)] = args.in[19][i]; }
        }
        const float* nm = args.in[1];
        {
            f32x4 wnm[4];
#pragma unroll
            for (int j = 0; j < 4; ++j) wnm[j] = ((const GAS f32x4*)nm)[lane + 64 * j];
            for (int r2 = 0; r2 < NREP(17); ++r2) for (int m0 = gw; m0 < T; m0 += 4 * NGW) {
                f32x4 v[4][4];
#pragma unroll
                for (int a = 0; a < 4; ++a) { const int m = (m0 + a * NGW < T) ? m0 + a * NGW : m0; const GAS f32x4* xr = (const GAS f32x4*)(x + (size_t)m * D) + lane;
#pragma unroll
                    for (int j = 0; j < 4; ++j) v[a][j] = xr[64 * j]; }
#pragma unroll
                for (int a = 0; a < 4; ++a) { const int m = m0 + a * NGW; float s = 0.f;
#pragma unroll
                    for (int j = 0; j < 4; ++j) s += (v[a][j].x * v[a][j].x + v[a][j].y * v[a][j].y) + (v[a][j].z * v[a][j].z + v[a][j].w * v[a][j].w);
                    const float rstd = rsqrtf(wave_sum(s) * (1.f / D) + EPS);
                    if (m < T) { GAS u32x2* o8 = (GAS u32x2*)(XN + (size_t)m * D) + lane;
#pragma unroll
                        for (int j = 0; j < 4; ++j) { const f32x4 w = wnm[j]; u32x2 o; o.x = pk2(v[a][j].x * rstd * w.x, v[a][j].y * rstd * w.y); o.y = pk2(v[a][j].z * rstd * w.z, v[a][j].w * rstd * w.w); o8[64 * j] = o; } } }
            }
        }
        {
            bf16_t* WRH = (bf16_t*)(ws + WS_WRT); bf16_t* WRL = WRH + 32 * 1024;
            for (int i = bx * 512 + tid; i < 32 * 1024; i += G * 512) { const int e2 = i >> 10, k = i & 1023; const float v = args.in[16][k * NE + e2] * args.in[15][k];
                const bf16_t hb = f2bf(v); WRH[i] = hb; WRL[i] = f2bf(v - bf2f(hb)); }
        }
        if (bx == 0) {
            float* LBV = (float*)(ws + WS_LBV); float* LOGSIG = (float*)(ws + WS_LOGSIG);
            for (int i = tid; i < 1024; i += 512) {
                const float a0 = args.in[3][i], a1 = args.in[3][1024 + i]; const float mm = fmaxf(a0, a1); const float e0 = __expf(a0 - mm), e1 = __expf(a1 - mm);
                LBV[i] = e0 / (e0 + e1);
                const float L = args.in[11][i]; LOGSIG[i] = fminf(L, 0.f) - log1pf(__expf(-fabsf(L)));
            }
        }
        if (BOTH(0) && rep == NREP(0) - 1) { GRID_BAR();
#if defined(EXTRA_BARS)
            for (int eb = 0; eb < EXTRA_BARS; ++eb) GRID_BAR();
#endif
        }
    }
    if (IN(1)) {
        pg8::DenseOrder S; S.init(XN, (size_t)D * 2, WIN_T, (size_t)D * 2, T, 8192, G, bx);
        pg8::EpiSeg E{SEG0};
#if MOE_CONV_IN_P1
        {   PHASE_IDS();
            const int ksplit = (bx >> 3) & 15;
            S.i0 = 0; S.i1 = ksplit;
            pg8::gemm_phase<pg8::EpiSeg, pg8::DenseOrder, false>(lds, D, D, S, E);
            {   LAS float* scr = (LAS float*)(lds + wave * 16384); const int gw = vcu * NWAVES + wave, NGW = G * NWAVES;
                p0_convert_experts8(args.in[18], D, 2048, ws + WS_WGU_T, MapGU{}, scr, gw, NGW, lane, pg8::F8_SW, args.in[15]);
                p0_convert_experts8(args.in[20], DFF, D, ws + WS_WDN_T, MapId{0}, scr, gw, NGW, lane, pg8::F8_SW, (const float*)nullptr); }
            __syncthreads();
            S.i0 = ksplit; S.i1 = 1 << 30;
            pg8::gemm_phase<pg8::EpiSeg, pg8::DenseOrder, false>(lds, D, D, S, E); }
#else
        for (int rep = 0; rep < NREP(1); ++rep) pg8::gemm_phase<pg8::EpiSeg, pg8::DenseOrder, false>(lds, D, D, S, E);
#endif
        if (BOTH(1)) GRID_BAR();
    }
    bf16_t* SQ = SEG0; bf16_t* SF = SEG0 + (size_t)T * 1024; bf16_t* SV = SEG0 + (size_t)2 * T * 1024; bf16_t* SG = SEG0 + (size_t)3 * T * 1024;
    bf16_t* USP = (bf16_t*)(ws + WS_USP); float* DEC = (float*)(ws + WS_DEC);
    bf16_t* SXB = SEG0 + (size_t)4 * T * 1024; bf16_t* SGATE = SEG0 + (size_t)5 * T * 1024; bf16_t* XCb = (bf16_t*)(ws + WS_XC); bf16_t* UUb = (bf16_t*)(ws + WS_UU);
    if (IN(2)) {
        PHASE_IDS();
        if (NREP(13) == 2) hgrn2_pass_a_phase<true>(lds, bx, G, SQ, SF, SV, (const float*)(ws + WS_LBV), (float*)USP, DEC, (float*)(ws + WS_LRUP));
        hgrn2_pass_a_phase<false>(lds, bx, G, SQ, SF, SV, (const float*)(ws + WS_LBV), (float*)USP, DEC, (float*)(ws + WS_LRUP));
        for (int rep = 0; rep < NREP(2); ++rep) {
            const int cg = tid & 127, c0 = cg * 8; const float* cw = args.in[5]; const float* cbv = args.in[6];
            float w[4][8], bb[8];
#pragma unroll
            for (int k = 0; k < 4; ++k)
#pragma unroll
                for (int j = 0; j < 8; ++j) w[k][j] = cw[k * 1024 + c0 + j];
#pragma unroll
            for (int j = 0; j < 8; ++j) bb[j] = cbv[c0 + j];
            for (int rb = bx * 4 + (tid >> 7); rb < T / 8; rb += G * 4) {
                const int t0 = rb * 8; const bool first = (t0 & (SEQ - 1)) == 0;
                u32x4 xr[11];
#pragma unroll
                for (int i = 0; i < 11; ++i) { const int tt = t0 - 3 + i; xr[i] = (i < 3 && first) ? (u32x4){0u, 0u, 0u, 0u} : *(const u32x4*)(SXB + (size_t)tt * 1024 + c0); }
#pragma unroll
                for (int r = 0; r < 8; ++r) {
                    float a[8];
#pragma unroll
                    for (int j = 0; j < 8; ++j) a[j] = bb[j];
#pragma unroll
                    for (int k = 0; k < 4; ++k) { const unsigned xu[4] = {xr[r + k].x, xr[r + k].y, xr[r + k].z, xr[r + k].w};
#pragma unroll
                        for (int j = 0; j < 4; ++j) { a[2 * j] += __uint_as_float(xu[j] << 16) * w[k][2 * j]; a[2 * j + 1] += __uint_as_float(xu[j] & 0xffff0000u) * w[k][2 * j + 1]; } }
                    u32x4 o; o.x = pk2(a[0], a[1]); o.y = pk2(a[2], a[3]); o.z = pk2(a[4], a[5]); o.w = pk2(a[6], a[7]);
                    *(u32x4*)(XCb + (size_t)(t0 + r) * 1024 + c0) = o;
                }
            }
        }
        if (BOTH(2)) GRID_BAR();
    }
    if (IN(3)) {
        PHASE_IDS();
        if (NREP(14) == 2) for (int gt = bx * 512 + tid; gt < BATCH * NH * 4096; gt += G * 512) hgrn2_pass_b<true>(gt, (float*)USP, (const float*)(ws + WS_LRUP));
        for (int gt = bx * 512 + tid; gt < BATCH * NH * 4096; gt += G * 512) hgrn2_pass_b<false>(gt, (float*)USP, (const float*)(ws + WS_LRUP));
        {
            pg8::GateOrder S{(const char*)XCb, (const char*)(ws + WS_WRG_T), G, bx};
            pg8::EpiGates E{XCb, args.in[8], args.in[10], (const float*)(ws + WS_LOGSIG), SXB, UUb};
            for (int rep = 0; rep < NREP(3); ++rep) pg8::gemm_phase<pg8::EpiGates, pg8::GateOrder, false>(lds, 256, 1024, S, E);
        }
        if (BOTH(3)) GRID_BAR();
    }
    if (IN(4)) {
        if (NREP(15) == 2) hgrn2_pass_c_phase<true>(lds, bx, G, SQ, SF, SV, SG, (const float*)USP, args.in[4], SQ, DEC);
        hgrn2_pass_c_phase<false>(lds, bx, G, SQ, SF, SV, SG, (const float*)USP, args.in[4], SQ, DEC);
        for (int rep = 0; rep < NREP(4); ++rep) for (int u = bx; u < BATCH * 64; u += G) lru_s1(u >> 6, u & 63, SXB, UUb, (float*)(ws + WS_LRUP), (float*)(ws + WS_LRUH));
        if (BOTH(4)) GRID_BAR();
    }
    if (IN(5)) {
        for (int u = bx; u < BATCH * 32; u += G) { const int b = u >> 5, n = u & 31;
            if (NREP(16) == 2) lru_s3<true>(b, n, SXB, UUb, (const float*)(ws + WS_LRUP), (const float*)(ws + WS_LRUH), SGATE);
            lru_s3<false>(b, n, SXB, UUb, (const float*)(ws + WS_LRUP), (const float*)(ws + WS_LRUH), SGATE); }
        if (BOTH(5)) GRID_BAR();
    }
    bf16_t* MGb = SF; bf16_t* X1Wb = (bf16_t*)(ws + WS_X1W);
    if (IN(6)) {
        {
            pg8::DenseOrder S; S.init(SQ, (size_t)D * 2, ws + WS_WPA_T, (size_t)D * 2, T, D, G, bx);
            pg8::EpiMerge E{SEG0 + (size_t)7 * T * 1024, MGb};
            pg8::MidMerge MD{(size_t)((const char*)SGATE - (const char*)SQ) - 16 * 128, (size_t)(WS_WPB_T - WS_WPA_T) - 16 * 128, SEG0 + (size_t)6 * T * 1024};
            for (int rep = 0; rep < NREP(6); ++rep) pg8::gemm_phase<pg8::EpiMerge, pg8::DenseOrder, false, pg8::MidMerge>(lds, 2 * D, D, S, E, D, MD); }
        if (BOTH(6)) GRID_BAR();
    }
    if (IN(7)) {
        pg8::DenseOrder S; S.init(MGb, (size_t)D * 2, ws + WS_WOUT_T, (size_t)D * 2, T, D, G, bx);
        pg8::EpiOut2 E{x, X1Wb, MOE_FP8 ? (unsigned char*)(ws + WS_X1) : (unsigned char*)nullptr};
        for (int rep = 0; rep < NREP(7); ++rep) pg8::gemm_phase<pg8::EpiOut2, pg8::DenseOrder, false>(lds, D, D, S, E);
        if (BOTH(7)) GRID_BAR();
    }
    float* RSTD = (float*)(ws + WS_RSTD); int* TOPE = (int*)(ws + WS_TOPE); float* TOPW = (float*)(ws + WS_TOPW); int* POS = (int*)(ws + WS_POS);
    int* LIST = (int*)(ws + WS_LIST); float* GWs = (float*)(ws + WS_GW); float* RSs = (float*)(ws + WS_RS); int* WGH = (int*)(ws + WS_WGH);
    bf16_t* ACTb = (bf16_t*)(ws + WS_ACT); bf16_t* Yb = (bf16_t*)(ws + WS_Y);
    LAS int* m_tp = (LAS int*)(lds + MOE_TP); LAS int* m_off = (LAS int*)(lds + MOE_OFF); LAS int* m_hist = (LAS int*)(lds + MOE_HIST); LAS int* m_base = (LAS int*)(lds + MOE_BASE); LAS int* m_lcur = (LAS int*)(lds + MOE_LCUR);
    if (IN(8)) {
        PHASE_IDS();
        constexpr int WP = 1040;
        LAS unsigned char* Lhi = lds; LAS unsigned char* Llo = lds + 32 * WP;
        LAS float* lgt = (LAS float*)(lds + 2 * 32 * WP);
        LAS float* rss_s = lgt + 128 * 32;
        const bf16_t* WRH = (const bf16_t*)(ws + WS_WRT); const bf16_t* WRL = WRH + 32 * 1024;
        const float* br = args.in[17];
        const int cc = lane & 15, q = lane >> 4, e = lane & 31, sub = lane >> 5;
        if (tid < 32) m_hist[tid] = 0;
        for (int tb = bx * 128; tb < T; tb += G * 128) {
            const int tok0 = tb + 16 * wave;
            f32x4 acc[2] = {(f32x4){0.f, 0.f, 0.f, 0.f}, (f32x4){0.f, 0.f, 0.f, 0.f}};
            float ssq = 0.f;
            for (int hh = 0; hh < 2; ++hh) {
                __syncthreads();
#pragma unroll
                for (int j = 0; j < 4; ++j) { const int vi = tid + 512 * j, r = vi >> 6, ch = vi & 63;
                    *(LAS u32x4*)(Lhi + r * WP + ch * 16) = *(const u32x4*)(WRH + r * 1024 + 512 * hh + ch * 8);
                    *(LAS u32x4*)(Llo + r * WP + ch * 16) = *(const u32x4*)(WRL + r * 1024 + 512 * hh + ch * 8); }
                __syncthreads();
                const bf16_t* xa = X1Wb + (size_t)(tok0 + cc) * D + 512 * hh + 8 * q;
#pragma unroll 8
                for (int ks = 0; ks < 16; ++ks) {
                    const u32x4 aw = *(const u32x4*)(xa + 32 * ks); const bf16x8 af = __builtin_bit_cast(bf16x8, aw);
                    { float f[8]; pg8::unpack8(aw, f);
#pragma unroll
                      for (int j = 0; j < 8; ++j) ssq += f[j] * f[j]; }
#pragma unroll
                    for (int tl = 0; tl < 2; ++tl) {
                        const bf16x8 bh = *(const LAS bf16x8*)(Lhi + (16 * tl + cc) * WP + (32 * ks + 8 * q) * 2), bl = *(const LAS bf16x8*)(Llo + (16 * tl + cc) * WP + (32 * ks + 8 * q) * 2);
                        acc[tl] = __builtin_amdgcn_mfma_f32_16x16x32_bf16(af, bh, acc[tl], 0, 0, 0);
                        acc[tl] = __builtin_amdgcn_mfma_f32_16x16x32_bf16(af, bl, acc[tl], 0, 0, 0);
                    }
                }
            }
            ssq += __shfl_xor(ssq, 16); ssq += __shfl_xor(ssq, 32);
            if (q == 0) rss_s[16 * wave + cc] = ssq;
#pragma unroll
            for (int tl = 0; tl < 2; ++tl)
#pragma unroll
                for (int r = 0; r < 4; ++r) lgt[(16 * wave + 4 * q + r) * 32 + 16 * tl + cc] = acc[tl][r];
            __syncthreads();
            for (int it2 = 0; it2 < 8; ++it2) {
                const int tk = 16 * wave + 2 * it2 + sub; const int t = tb + tk;
                const float rstd = rsqrtf(rss_s[tk] * (1.0f / D) + EPS);
                float cur = lgt[tk * 32 + e] * rstd + br[e];
                float val[4]; int idx[4];
#pragma unroll
                for (int k = 0; k < 4; ++k) { float bv = cur; int bi = e;
#pragma unroll
                    for (int o = 1; o < 32; o <<= 1) { const float ov = __shfl_xor(bv, o); const int oi = __shfl_xor(bi, o); if (ov > bv || (ov == bv && oi < bi)) { bv = ov; bi = oi; } }
                    val[k] = bv; idx[k] = bi; if (e == bi) cur = -INFINITY; }
                float w4[4], den = 0.f;
#pragma unroll
                for (int k = 0; k < 4; ++k) { w4[k] = __expf(val[k] - val[0]); den += w4[k]; }
                const float inv = 1.0f / den;
                if (e < 4) { const int ie = e == 0 ? idx[0] : e == 1 ? idx[1] : e == 2 ? idx[2] : idx[3]; const float we = (e == 0 ? w4[0] : e == 1 ? w4[1] : e == 2 ? w4[2] : w4[3]) * inv;
                    TOPE[(size_t)t * 4 + e] = ie; TOPW[(size_t)t * 4 + e] = we; atomicAdd((int*)(m_hist + ie), 1); }
                if (e == 0) RSTD[t] = rstd;
            }
        }
        __syncthreads();
        if (tid < 32) { const int hc = m_hist[tid]; WGH[bx * 32 + tid] = hc; atomicAdd((unsigned*)(ctl + CW_CNT + tid), (unsigned)hc); }
        if (BOTH(8)) GRID_BAR();
    }
    if (IN(9) || IN(10) || IN(11)) {
        PHASE_IDS();
        if (tid == 0) { int tp = 0, of = 0; for (int j = 0; j < 32; ++j) { const int cn = (int)__hip_atomic_load(ctl + CW_CNT + j, __ATOMIC_RELAXED, __HIP_MEMORY_SCOPE_AGENT); m_tp[j] = tp; m_off[j] = of; tp += (cn + 255) >> 8; of += cn; } m_tp[32] = tp; m_off[32] = of; }
        __syncthreads();
    }
    if (IN(9)) {
        PHASE_IDS();
        if (tid < 32) { m_base[tid] = (int)atomicAdd((unsigned*)(ctl + CW_CUR + tid), (unsigned)WGH[bx * 32 + tid]); m_lcur[tid] = 0; }
        __syncthreads();
        for (int tb = bx * 128; tb < T; tb += G * 128) {
            const int t = tb + 16 * wave + (lane >> 2), k = lane & 3; const int ie = TOPE[(size_t)t * 4 + k];
            const int p = m_off[ie] + m_base[ie] + atomicAdd((int*)(m_lcur + ie), 1);
            LIST[p] = t; GWs[p] = TOPW[(size_t)t * 4 + k]; RSs[p] = RSTD[t]; POS[(size_t)t * 4 + k] = p;
        }
        if (BOTH(9)) GRID_BAR();
    }
    if (IN(10)) {
#if MOE_FP8
        pg8::MoeOrder S{m_tp, m_off, (const char*)(ws + WS_X1), (const char*)(ws + WS_WGU_T), LIST, (size_t)2048 * D, (size_t)256 * D, (size_t)D, 3, G, bx, 1};
        pg8::EpiGU8 E{RSs, (const float*)(ws + WS_BGUP), (unsigned char*)ACTb};
        for (int rep = 0; rep < NREP(10); ++rep) pg8::gemm_phase<pg8::EpiGU8, pg8::MoeOrder, true, pg8::NoMid, true>(lds, D / 2, D / 2, S, E);
#else
        pg8::MoeOrder S{m_tp, m_off, (const char*)X1Wb, (const char*)(ws + WS_WGU_T), LIST, (size_t)2048 * D * 2, (size_t)256 * D * 2, (size_t)D * 2, 3, G, bx, 1};
        pg8::EpiGU2 E{RSs, (const float*)(ws + WS_BGUP), ACTb};
        for (int rep = 0; rep < NREP(10); ++rep) pg8::gemm_phase<pg8::EpiGU2, pg8::MoeOrder, true>(lds, D, D, S, E);
#endif
        if (BOTH(10)) GRID_BAR();
    }
    if (IN(11)) {
#if MOE_FP8
        pg8::MoeOrder S{m_tp, m_off, (const char*)ACTb, (const char*)(ws + WS_WDN_T), LIST, (size_t)D * DFF, (size_t)256 * DFF, (size_t)DFF, 2, G, bx, 0};
        pg8::EpiDown8 E{GWs, args.in[21], (unsigned char*)Yb};
        for (int rep = 0; rep < NREP(11); ++rep) pg8::gemm_phase<pg8::EpiDown8, pg8::MoeOrder, false, pg8::NoMid, true>(lds, DFF / 2, DFF / 2, S, E);
#else
        pg8::MoeOrder S{m_tp, m_off, (const char*)ACTb, (const char*)(ws + WS_WDN_T), LIST, (size_t)D * DFF * 2, (size_t)256 * DFF * 2, (size_t)DFF * 2, 2, G, bx, 0};
        pg8::EpiDown2 E{GWs, args.in[21], Yb};
        for (int rep = 0; rep < NREP(11); ++rep) pg8::gemm_phase<pg8::EpiDown2, pg8::MoeOrder, false>(lds, DFF, DFF, S, E);
#endif
        if (BOTH(11)) GRID_BAR();
    }
    if (IN(12)) {
        PHASE_IDS();
        const float* NFIN = args.in[22]; float* out = args.out;
        for (int rep = 0; rep < NREP(12); ++rep) for (int t = bx * 8 + wave; t < T; t += G * 16) {
            const int tt[2] = {t, t + G * 8 < T ? t + G * 8 : t};
            int4 ps[2]; u32x4 xw[2][2], yw[2][4];
#pragma unroll
            for (int a = 0; a < 2; ++a) ps[a] = *(const int4*)(POS + (size_t)tt[a] * 4);
#pragma unroll
            for (int a = 0; a < 2; ++a) { const u32x4* xr = (const u32x4*)(X1Wb + (size_t)tt[a] * D) + lane * 2; xw[a][0] = xr[0]; xw[a][1] = xr[1]; }
#pragma unroll
            for (int a = 0; a < 2; ++a) { const int pp[4] = {ps[a].x, ps[a].y, ps[a].z, ps[a].w};
#pragma unroll
                for (int k = 0; k < 4; ++k) yw[a][k] = *((const u32x4*)((const unsigned char*)Yb + (size_t)pp[k] * 1024) + lane); }
#pragma unroll
            for (int a = 0; a < 2; ++a) {
                float v[16], f[8];
                pg8::unpack8(xw[a][0], f);
#pragma unroll
                for (int j = 0; j < 8; ++j) v[j] = f[j];
                pg8::unpack8(xw[a][1], f);
#pragma unroll
                for (int j = 0; j < 8; ++j) v[8 + j] = f[j];
#pragma unroll
                for (int k = 0; k < 4; ++k) { const unsigned yv[4] = {yw[a][k].x, yw[a][k].y, yw[a][k].z, yw[a][k].w};
#pragma unroll
                    for (int j = 0; j < 4; ++j) { const f32x2v lo = __builtin_amdgcn_cvt_pk_f32_fp8((int)yv[j], false), hi = __builtin_amdgcn_cvt_pk_f32_fp8((int)yv[j], true);
                        v[4 * j] += lo[0] * (1.0f / pg8::F8_SY); v[4 * j + 1] += lo[1] * (1.0f / pg8::F8_SY); v[4 * j + 2] += hi[0] * (1.0f / pg8::F8_SY); v[4 * j + 3] += hi[1] * (1.0f / pg8::F8_SY); } }
                float ss = 0.f;
#pragma unroll
                for (int j = 0; j < 16; ++j) ss += v[j] * v[j];
                const float rstd = rsqrtf(wave_sum(ss) * (1.0f / D) + EPS);
                if (a == 0 || tt[1] != tt[0]) {
                    f32x4* orow = (f32x4*)(out + (size_t)tt[a] * D) + lane * 4; const f32x4* nw = (const f32x4*)NFIN + lane * 4;
#pragma unroll
                    for (int j = 0; j < 4; ++j) { const f32x4 w = nw[j]; orow[j] = (f32x4){v[4 * j] * rstd * w[0], v[4 * j + 1] * rstd * w[1], v[4 * j + 2] * rstd * w[2], v[4 * j + 3] * rstd * w[3]}; }
                }
            }
        }
    }
#undef IN
#undef BOTH
#undef GRID_BAR
}

extern "C" void kernel_launch(void* const* d_in, const int* in_sizes, int n_in, void* d_out, int out_size, void* d_ws, size_t ws_size, hipStream_t stream) {
    (void)in_sizes; (void)n_in; (void)out_size; (void)ws_size;
    unsigned char* ws = (unsigned char*)d_ws;
    static int grid = 0;
    if (grid == 0) {
        int dev = 0, cus = 0;
        (void)hipGetDevice(&dev); (void)hipDeviceGetAttribute(&cus, hipDeviceAttributeMultiprocessorCount, dev);
        (void)hipFuncSetAttribute((const void*)mega, hipFuncAttributeMaxDynamicSharedMemorySize, LDS_BYTES);
        grid = cus > 0 ? cus : 256;
    }
    (void)hipMemsetAsync(ws + WS_CTL, 0, CTL_ZERO_BYTES, stream);
    MArgs ma{};
    for (int i = 0; i < 23; ++i) ma.in[i] = (const float*)d_in[i];
    ma.out = (float*)d_out; ma.ws = ws; ma.ph_lo = 0; ma.ph_hi = 13;
    hipLaunchKernelGGL(mega, dim3(grid), dim3(512), LDS_BYTES, stream, ma);
}
```

```cpp
#include <hip/hip_runtime.h>
#include <cstdio>
#include <cstdint>

#ifndef MOE_FP8
#define MOE_FP8 2
#endif
#ifndef MOE_CONV_IN_P1
#define MOE_CONV_IN_P1 1
#endif
constexpr int HG_NB = 16;
typedef unsigned short bf16_t;
typedef short bf16x8 __attribute__((ext_vector_type(8)));
typedef float f32x4 __attribute__((ext_vector_type(4)));

constexpr int BATCH = 8, SEQ = 4096, D = 1024, T = BATCH * SEQ;
constexpr int NH = 8, DK = 128, DV = 128;
constexpr int LRU_H = 4, LRU_B = 256;
constexpr int NE = 32, TOPK = 4, DFF = 1024;
constexpr float EPS = 1e-5f;
constexpr size_t MiB = 1u << 20;

constexpr size_t WS_XN   = 224 * MiB;
constexpr size_t WS_SEG  = 288 * MiB;
constexpr size_t SEG_BYTES = (size_t)T * 1024 * 2;
constexpr size_t WS_X1   = 800 * MiB;
constexpr size_t WS_X1W  = 928 * MiB;
enum { SG_Q = 0, SG_F = 1, SG_V = 2, SG_G = 3, SG_XB = 4, SG_GATE = 5, SG_GA = 6, SG_GB = 7 };

__device__ __forceinline__ float bf2f(bf16_t v) { return __uint_as_float(((unsigned)v) << 16); }
__device__ __forceinline__ bf16_t f2bf(float f) { unsigned u = __float_as_uint(f); u += 0x7fffu + ((u >> 16) & 1u); return (bf16_t)(u >> 16); }
__device__ __forceinline__ float sigmoidf_(float x) { return __builtin_amdgcn_rcpf(1.0f + __expf(-x)); }
__device__ __forceinline__ float siluf_(float x) { return x * sigmoidf_(x); }
__device__ __forceinline__ float wave_sum(float v) {
#pragma unroll
    for (int o = 1; o < 64; o <<= 1) v += __shfl_xor(v, o);
    return v;
}

#define LAS __attribute__((address_space(3)))
#define GAS __attribute__((address_space(1)))
typedef unsigned u32x4 __attribute__((ext_vector_type(4)));
typedef unsigned u32x2 __attribute__((ext_vector_type(2)));
typedef GAS unsigned gu32;
#define LDS_WAIT() asm volatile("s_waitcnt lgkmcnt(0)" ::: "memory")
#define VM_WAIT() asm volatile("s_waitcnt vmcnt(0)" ::: "memory")

constexpr size_t WS_CTL = 0, CTL_ZERO_BYTES = 64 * 1024;
constexpr size_t WS_LBV = 1 * MiB;
constexpr size_t WS_LOGSIG = 1 * MiB + 8192;
constexpr size_t WS_BGUP = 1 * MiB + 65536;
constexpr size_t WS_WRT = 1 * MiB + 512 * 1024;
constexpr size_t WS_WIN_T = 2 * MiB, WS_WRG_T = 18 * MiB, WS_WPA_T = 19 * MiB, WS_WPB_T = 21 * MiB, WS_WOUT_T = 23 * MiB;
constexpr size_t WS_DEC = 25 * MiB;
constexpr size_t WS_LRUP = 27 * MiB, WS_LRUH = 29 * MiB;
constexpr size_t WS_DECB = 31 * MiB;
constexpr size_t WS_WGU_T = 32 * MiB, WS_WDN_T = 160 * MiB;
constexpr size_t WS_XC = 224 * MiB;
constexpr size_t WS_USP = 800 * MiB;
constexpr size_t WS_UU = 928 * MiB;
constexpr int CW_TMO = 0, CW_BAR = 1024;

#define XB_TMO      128
#define XB_XCNT(j)  (256  + 64 * (j))
#define XB_XSUB(j)  (1280 + 64 * (j))
#define XB_XGEN(j)  (2304 + 64 * (j))
#define XB_TOP      3328
#define XB_TOPGEN   3392
#define XCD_BAR_WORDS 3456
#define XB_SPIN_CAP (1u << 18)
__device__ __forceinline__ unsigned xb_ld(unsigned* p)              { return __hip_atomic_load(p, __ATOMIC_RELAXED, __HIP_MEMORY_SCOPE_AGENT); }
__device__ __forceinline__ unsigned xb_add(unsigned* p, unsigned v) { return __hip_atomic_fetch_add(p, v, __ATOMIC_RELAXED, __HIP_MEMORY_SCOPE_AGENT); }
__device__ __forceinline__ unsigned xb_xcc_id() { return (unsigned)__builtin_amdgcn_s_getreg((3 << 11) | 20) & 0xFu; }
#define XB_SPIN(cond, bar) do { unsigned _sp = 0; while (cond) { __builtin_amdgcn_s_sleep(1); \
    if ((++_sp & 255u) == 0u) { if (xb_ld(&(bar)[XB_TMO])) break; if (_sp > XB_SPIN_CAP) { atomicAdd(&(bar)[XB_TMO], 1u); break; } } } } while (0)
struct XcdBarrier { unsigned* bar; unsigned x; volatile LAS unsigned* st; };
__device__ __forceinline__ XcdBarrier xcd_barrier_post(unsigned* bar, volatile LAS unsigned* st) {
    XcdBarrier b; b.bar = bar; b.x = xb_xcc_id(); b.st = st;
    if (threadIdx.x == 0) (void)xb_add(&bar[XB_XCNT(b.x)], 1u);
    return b;
}
__device__ __forceinline__ void xcd_barrier_complete(unsigned* bar, unsigned x, unsigned& nloc, unsigned& nx) {
    const unsigned G = gridDim.x * gridDim.y * gridDim.z;
    unsigned sum, cnt, mine, sp = 0u;
    for (;;) {
        sum = 0u; cnt = 0u; mine = 0u;
#pragma unroll
        for (unsigned j = 0; j < 16; ++j) { const unsigned c = xb_ld(&bar[XB_XCNT(j)]); sum += c; cnt += (c > 0u) ? 1u : 0u; mine = (j == x) ? c : mine; }
        if (sum == G) break;
        __builtin_amdgcn_s_sleep(1);
        if ((++sp & 255u) == 0u) { if (xb_ld(&bar[XB_TMO])) break; if (sp > XB_SPIN_CAP) { atomicAdd(&bar[XB_TMO], 1u); break; } }
    }
    nloc = mine > 0u ? mine : 1u; nx = cnt > 0u ? cnt : 1u;
}
__device__ __forceinline__ void xcd_barrier(const XcdBarrier& b) {
    asm volatile("s_waitcnt vmcnt(0)" ::: "memory");
    __syncthreads();
    if (threadIdx.x == 0) {
        unsigned* bar = b.bar;
        __builtin_amdgcn_s_waitcnt(0);
        unsigned nloc = b.st[0], nx = b.st[1];
        if (nloc == 0u) { xcd_barrier_complete(bar, b.x, nloc, nx); b.st[0] = nloc; b.st[1] = nx; }
        const unsigned old = xb_add(&bar[XB_XSUB(b.x)], 1u);
        const unsigned gen = old / nloc;
        if (old + 1u == (gen + 1u) * nloc) {
            __builtin_amdgcn_fence(__ATOMIC_RELEASE, "agent");
            asm volatile("s_waitcnt vmcnt(0)" ::: "memory");
            const unsigned og = xb_add(&bar[XB_TOP], 1u);
            const unsigned tg = og / nx;
            if (og + 1u == (tg + 1u) * nx) xb_add(&bar[XB_TOPGEN], 1u);
            else XB_SPIN(xb_ld(&bar[XB_TOPGEN]) == tg, bar);
            __builtin_amdgcn_fence(__ATOMIC_ACQUIRE, "agent");
            xb_add(&bar[XB_XGEN(b.x)], 1u);
            asm volatile("s_waitcnt vmcnt(0)" ::: "memory");
        } else {
            XB_SPIN(xb_ld(&bar[XB_XGEN(b.x)]) == gen, bar);
            __builtin_amdgcn_fence(__ATOMIC_ACQUIRE, "agent");
            asm volatile("s_waitcnt vmcnt(0)" ::: "memory");
        }
    }
    __syncthreads();
}

namespace pg8 {
typedef long i64x2 __attribute__((ext_vector_type(2)));
typedef int i32x4 __attribute__((ext_vector_type(4)));
typedef int i32x8 __attribute__((ext_vector_type(8)));
constexpr int BM = 256, BK = 64, HALF = 128, HTB = HALF * BK * 2, STAGE_BYTES = 8 * HTB, NXCD = 8, WGM = 4;
__host__ __device__ __forceinline__ int lds_byte(int r, int c) { const int st = (r >> 4) * 2 + (c >> 5), rr = r & 15, cc = c & 31, ob = rr * 64 + cc * 2; return st * 1024 + (ob ^ (((ob >> 9) & 1) << 5)); }
__host__ __device__ __forceinline__ void stage_rc(int b, int& R, int& C) { const int st = b / 1024, sb = b % 1024, swz = sb ^ (((sb >> 9) & 1) << 5); R = (st >> 1) * 16 + swz / 64; C = (st & 1) * 32 + (swz % 64) / 2; }
__host__ __device__ __forceinline__ int perm32(int rho) { const int n = rho >> 4, i = rho & 15; return 8 * (i >> 2) + 4 * n + (i & 3); }
__device__ __forceinline__ unsigned cvt_pk_bf16(float lo, float hi) { unsigned r; asm volatile("v_cvt_pk_bf16_f32 %0, %1, %2" : "=v"(r) : "v"(lo), "v"(hi)); return r; }

struct Unit { const char* a; const char* b; int pm, pn, e, rows; };
struct NoMid { static constexpr int KJ = 0; size_t jumpA, jumpB; template <class U> __device__ __forceinline__ void operator()(f32x4 (&)[2][2][4][2], const U&, int, int, int, int) const {} };
template <class E, class = void> struct has_post { static constexpr bool v = false; };
template <class E> struct has_post<E, decltype((void)E::POST)> { static constexpr bool v = true; };
template <class Epi, class Sched, bool GATHER, class Mid = NoMid, bool FP8 = false>
__device__ __forceinline__ void gemm_phase(LAS unsigned char* lds, const int K, const int lda  , const Sched& S, const Epi& E, const int ldb_ = 0, const Mid MD = Mid{}) {
    const int ldb = ldb_ ? ldb_ : K;
    const int tid = threadIdx.x, wid = __builtin_amdgcn_readfirstlane(tid >> 6), lane = tid & 63, wr = wid >> 2, wc = wid & 3, fr = lane & 15, fq = lane >> 4;
    const int nt = K / BK;
    unsigned vA[2][2], voffB[2];
#pragma unroll
    for (int i = 0; i < 2; ++i) { int R, C; stage_rc(tid * 16 + i * 8192, R, C); const int Rb = Epi::PERM ? ((R & ~31) + perm32(R & 31)) : R;
        vA[0][i] = (unsigned)(R * lda + C) * 2u; vA[1][i] = (unsigned)((R + HALF) * lda + C) * 2u; voffB[i] = (unsigned)(Rb * ldb + C) * 2u; }
    const size_t kstep = (size_t)(BK * 2);
    const size_t hstepB = (size_t)HALF * ldb * 2;
    const unsigned ldsw = (unsigned)wid * 1024u;
    const int aoff = lds_byte(wr * 64 + fr, fq * 8), boff = lds_byte(wc * 32 + fr, fq * 8);
#define PG8_SA(b, h) (((b) * 2 + (h)) * HTB)
#define PG8_SB(b, h) ((4 + (b) * 2 + (h)) * HTB)
#define PG8_STAGE(bufoff, gbase, voff) do { _Pragma("unroll") for (int _i = 0; _i < 2; ++_i) \
        __builtin_amdgcn_global_load_lds((const unsigned*)((const char*)(gbase) + (voff)[_i]), (LAS unsigned*)(lds + (bufoff) + ldsw + _i * 8192), 16, 0, 0); } while (0)
#define PG8_LDA(dst, b, h) do { if constexpr (MX) { _Pragma("unroll") for (int m = 0; m < 4; ++m) dst##8[m] = __builtin_shufflevector(*(const LAS i32x4*)(lds + PG8_SA(b, h) + aoff + m * 2048), *(const LAS i32x4*)(lds + PG8_SA(b, h) + aoff + m * 2048 + 1024), 0, 1, 2, 3, 4, 5, 6, 7); } \
        else { _Pragma("unroll") for (int m = 0; m < 4; ++m) _Pragma("unroll") for (int k = 0; k < 2; ++k) dst[m][k] = *(const LAS bf16x8*)(lds + PG8_SA(b, h) + aoff + m * 2048 + k * 1024); } } while (0)
#define PG8_LDB(dst, b, h) do { if constexpr (MX) { _Pragma("unroll") for (int n = 0; n < 2; ++n) dst##8[n] = __builtin_shufflevector(*(const LAS i32x4*)(lds + PG8_SB(b, h) + boff + n * 2048), *(const LAS i32x4*)(lds + PG8_SB(b, h) + boff + n * 2048 + 1024), 0, 1, 2, 3, 4, 5, 6, 7); } \
        else { _Pragma("unroll") for (int n = 0; n < 2; ++n) _Pragma("unroll") for (int k = 0; k < 2; ++k) dst[n][k] = *(const LAS bf16x8*)(lds + PG8_SB(b, h) + boff + n * 2048 + k * 1024); } } while (0)
#define PG8_MMA(ai, bj, At, Bt) do { __builtin_amdgcn_s_setprio(1); _Pragma("unroll") for (int m = 0; m < 4; ++m) _Pragma("unroll") for (int n = 0; n < 2; ++n) { \
        if constexpr (MX) {     \
            asm volatile("v_mfma_scale_f32_16x16x128_f8f6f4 %0, %1, %2, %0, %3, %3 op_sel_hi:[0,0,0]" : "+v"(acc[ai][bj][m][n]) : "v"(Bt##8[n]), "v"(At##8[m]), "v"(mxscale)); \
        } else { _Pragma("unroll") for (int k = 0; k < 2; ++k) { \
        if constexpr (FP8) { const i64x2 _b = __builtin_bit_cast(i64x2, Bt[n][k]), _a = __builtin_bit_cast(i64x2, At[m][k]); \
            acc[ai][bj][m][n] = __builtin_amdgcn_mfma_f32_16x16x32_fp8_fp8(_b[0], _a[0], acc[ai][bj][m][n], 0, 0, 0); acc[ai][bj][m][n] = __builtin_amdgcn_mfma_f32_16x16x32_fp8_fp8(_b[1], _a[1], acc[ai][bj][m][n], 0, 0, 0); } \
        else acc[ai][bj][m][n] = __builtin_amdgcn_mfma_f32_16x16x32_bf16(Bt[n][k], At[m][k], acc[ai][bj][m][n], 0, 0, 0); } } } __builtin_amdgcn_s_setprio(0); } while (0)
#define PG8_WAIT_V(n) asm volatile("s_waitcnt vmcnt(" #n ")" ::: "memory")
#define PG8_WAIT_L(n) asm volatile("s_waitcnt lgkmcnt(" #n ")" ::: "memory")
#define PG8_BAR __builtin_amdgcn_s_barrier()
#define PG8_SCHED __builtin_amdgcn_sched_barrier(0)
    Unit cur, nxt; int ui = 0;
    if (!S.next(0, cur)) return;
    f32x4 acc[2][2][4][2];
#pragma unroll
    for (int a = 0; a < 2; ++a)
#pragma unroll
        for (int b = 0; b < 2; ++b)
#pragma unroll
            for (int m = 0; m < 4; ++m)
#pragma unroll
                for (int n = 0; n < 2; ++n) acc[a][b][m][n] = (f32x4){0.f, 0.f, 0.f, 0.f};
    constexpr bool MX = FP8 && (MOE_FP8 == 2);
    int mxscale = 0x7F7F7F7F; asm volatile("" : "+v"(mxscale));
    bf16x8 At[4][2], B0[2][2], B1[2][2]; i32x8 At8[4], B08[2], B18[2];
    const char* cA = cur.a; const char* cB = cur.b;
#define PG8_GOFF(unit, dst) do { int _tz = threadIdx.x; asm volatile("" : "+v"(_tz)); int _R0, _C0, _R1, _C1; stage_rc(_tz * 16, _R0, _C0); stage_rc(_tz * 16 + 8192, _R1, _C1); int _r[4]; S.rows(unit, _R0, _R1, _r); \
        dst[0][0] = (unsigned)(_r[0] * lda + _C0) * 2u; dst[0][1] = (unsigned)(_r[1] * lda + _C1) * 2u; dst[1][0] = (unsigned)(_r[2] * lda + _C0) * 2u; dst[1][1] = (unsigned)(_r[3] * lda + _C1) * 2u; } while (0)
    LAS u32x4* noff = (LAS u32x4*)(lds + STAGE_BYTES + 4096) + tid;
    if constexpr (GATHER) { PG8_GOFF(cur, vA); }
    PG8_STAGE(PG8_SB(0, 0), cB, voffB); PG8_STAGE(PG8_SB(0, 1), cB + hstepB, voffB); PG8_STAGE(PG8_SA(0, 0), cA, vA[0]); PG8_STAGE(PG8_SA(0, 1), cA, vA[1]);
    if (wr == 1) PG8_BAR;
    PG8_WAIT_V(2); PG8_BAR;
    PG8_STAGE(PG8_SB(1, 0), cB + kstep, voffB); PG8_STAGE(PG8_SA(1, 0), cA + kstep, vA[0]); PG8_STAGE(PG8_SB(1, 1), cB + hstepB + kstep, voffB);
    PG8_WAIT_V(6); PG8_BAR;
    for (;;) {
        const bool has_next = S.next(ui + 1, nxt);
        const char* nA = has_next ? nxt.a : cA; const char* nB = has_next ? nxt.b : cB;
#pragma unroll 1
        for (int t = 0; t < nt; t += 2) {
            const bool last = (t == nt - 2);
            const char* a1 = cA + (size_t)(t + 1) * kstep;
            const char* a2 = last ? nA : cA + (size_t)(t + 2) * kstep; const char* b2 = last ? nB : cB + (size_t)(t + 2) * kstep;
            const char* a3 = a2 + kstep; const char* b3 = b2 + kstep;
            if constexpr (Mid::KJ > 0) {
                if (t + 1 >= Mid::KJ) a1 += MD.jumpA;
                if (!last && t + 2 >= Mid::KJ) { a2 += MD.jumpA; b2 += MD.jumpB; a3 += MD.jumpA; b3 += MD.jumpB; }
                if (t == Mid::KJ) MD(acc, cur, wr, wc, fr, fq);
            }
            asm volatile("" : "+s"(a1), "+s"(a2), "+s"(a3), "+s"(b2), "+s"(b3));
            unsigned o2[2][2];
            if constexpr (GATHER) {
#pragma unroll
                for (int h = 0; h < 2; ++h)
#pragma unroll
                    for (int i = 0; i < 2; ++i) o2[h][i] = vA[h][i];
                if (last && has_next) { PG8_GOFF(nxt, o2); *noff = (u32x4){o2[0][0], o2[0][1], o2[1][0], o2[1][1]}; }
            } else {
#pragma unroll
                for (int h = 0; h < 2; ++h)
#pragma unroll
                    for (int i = 0; i < 2; ++i) o2[h][i] = vA[h][i];
            }
            PG8_LDB(B0, 0, 0); PG8_LDB(B1, 0, 1); PG8_SCHED; PG8_LDA(At, 0, 0); PG8_STAGE(PG8_SA(1, 1), a1, vA[1]);
            PG8_WAIT_V(8); PG8_WAIT_L(0); PG8_BAR; PG8_MMA(0, 0, At, B0); PG8_MMA(0, 1, At, B1); PG8_BAR; PG8_SCHED;
            PG8_LDA(At, 0, 1); PG8_STAGE(PG8_SB(0, 0), b2, voffB); PG8_STAGE(PG8_SB(0, 1), b2 + hstepB, voffB); PG8_STAGE(PG8_SA(0, 0), a2, o2[0]);
            PG8_WAIT_V(8); PG8_WAIT_L(0); PG8_BAR; PG8_MMA(1, 0, At, B0); PG8_MMA(1, 1, At, B1); PG8_BAR; PG8_SCHED;
            PG8_LDB(B0, 1, 0); PG8_LDB(B1, 1, 1); PG8_SCHED; PG8_LDA(At, 1, 0); PG8_STAGE(PG8_SA(0, 1), a2, o2[1]);
            PG8_WAIT_V(8); PG8_WAIT_L(0); PG8_BAR; PG8_MMA(0, 0, At, B0); PG8_MMA(0, 1, At, B1); PG8_BAR; PG8_SCHED;
            PG8_LDA(At, 1, 1); PG8_STAGE(PG8_SB(1, 0), b3, voffB); PG8_STAGE(PG8_SB(1, 1), b3 + hstepB, voffB); PG8_STAGE(PG8_SA(1, 0), a3, o2[0]);
            PG8_WAIT_V(8); PG8_WAIT_L(0); PG8_BAR; PG8_MMA(1, 0, At, B0); PG8_MMA(1, 1, At, B1); PG8_BAR; PG8_SCHED;
        }
        if constexpr (MX) asm volatile("s_nop 15\n\ts_nop 7" ::: "memory");
        if (wr == 0) PG8_BAR;
        E(acc, cur, wr, wc, fr, fq);
#if defined(DUP_EPI)
        if constexpr (Epi::DUPE) { asm volatile("" ::: "memory"); E(acc, cur, wr, wc, fr, fq); }
#endif
        if constexpr (has_post<Epi>::v) { PG8_WAIT_V(0); PG8_BAR; E.post(cur); }
        if (!has_next) break;
#pragma unroll
        for (int a = 0; a < 2; ++a)
#pragma unroll
            for (int b = 0; b < 2; ++b)
#pragma unroll
                for (int m = 0; m < 4; ++m)
#pragma unroll
                    for (int n = 0; n < 2; ++n) acc[a][b][m][n] = (f32x4){0.f, 0.f, 0.f, 0.f};
        cur = nxt; cA = nA; cB = nB; ++ui;
        if constexpr (GATHER) { const u32x4 nv = *noff; vA[0][0] = nv.x; vA[0][1] = nv.y; vA[1][0] = nv.z; vA[1][1] = nv.w; }
        if (wr == 1) PG8_BAR;
    }
    PG8_WAIT_V(0);
    PG8_BAR;
#undef PG8_GOFF
#undef PG8_SA
#undef PG8_SB
#undef PG8_STAGE
#undef PG8_LDA
#undef PG8_LDB
#undef PG8_MMA
#undef PG8_WAIT_V
#undef PG8_WAIT_L
#undef PG8_BAR
#undef PG8_SCHED
}

struct DenseOrder {
    const char* A; const char* Bt; size_t a_tile, b_tile; int nM, nN, nwg, G, c; int i0 = 0, i1 = 1 << 30;
    __device__ __forceinline__ void init(const void* A_, size_t lda_bytes, const void* Bt_, size_t K_bytes, int M, int N, int G_, int c_) {
        A = (const char*)A_; Bt = (const char*)Bt_; a_tile = 256 * lda_bytes; b_tile = 256 * K_bytes; nM = M / BM; nN = N / BM; nwg = nM * nN; G = G_; c = c_; }
    __device__ __forceinline__ bool next(int i, Unit& u) const {
        if (i0 + i >= i1) return false;
        const long L = (long)(i0 + i) * G + c; if (L >= nwg) return false;
        int wgid = (int)L; { const int q = nwg / NXCD, r = nwg % NXCD, xcd = wgid % NXCD, off = wgid / NXCD; wgid = (xcd < r ? xcd * (q + 1) : r * (q + 1) + (xcd - r) * q) + off; }
        const int nig = WGM * nN, gid = wgid / nig, fm = gid * WGM, gsz = (nM - fm) < WGM ? (nM - fm) : WGM;
        u.pm = fm + ((wgid % nig) % gsz); u.pn = (wgid % nig) / gsz; u.e = 0; u.rows = 256;
        u.a = A + (size_t)u.pm * a_tile; u.b = Bt + (size_t)u.pn * b_tile; return true;
    }
};

struct EpiSeg {
    static constexpr bool PERM = true;
#if defined(DUP_EPI)
    static constexpr bool DUPE = ((DUP_EPI >> 0) & 1) != 0;
#endif
    bf16_t* seg0;
    __device__ __forceinline__ void operator()(const f32x4 (&acc)[2][2][4][2], const Unit& u, int wr, int wc, int fr, int fq) const {
        const int row0 = u.pm * BM + wr * 64 + fr;
        if (u.pn < 24) {
            bf16_t* base = seg0 + (size_t)(u.pn >> 2) * ((size_t)T * 1024);
            const int col0 = (u.pn & 3) * BM + wc * 32 + 8 * fq;
#pragma unroll
            for (int ai = 0; ai < 2; ++ai)
#pragma unroll
                for (int m = 0; m < 4; ++m) { bf16_t* rowp = base + (size_t)(row0 + ai * HALF + m * 16) * 1024 + col0;
#pragma unroll
                    for (int bj = 0; bj < 2; ++bj) { const f32x4 v0 = acc[ai][bj][m][0], v1 = acc[ai][bj][m][1];
                        u32x4 w; w.x = cvt_pk_bf16(v0[0], v0[1]); w.y = cvt_pk_bf16(v0[2], v0[3]); w.z = cvt_pk_bf16(v1[0], v1[1]); w.w = cvt_pk_bf16(v1[2], v1[3]);
                        *(u32x4*)(rowp + bj * HALF) = w; } }
        } else {
            bf16_t* ratio = seg0 + (size_t)6 * ((size_t)T * 1024); bf16_t* sgb = seg0 + (size_t)7 * ((size_t)T * 1024);
            const int col0 = (u.pn - 24) * HALF + wc * 32 + 8 * fq;
#pragma unroll
            for (int ai = 0; ai < 2; ++ai)
#pragma unroll
                for (int m = 0; m < 4; ++m) { const size_t e = (size_t)(row0 + ai * HALF + m * 16) * 1024 + col0; float rt[8], sb[8];
#pragma unroll
                    for (int n = 0; n < 2; ++n)
#pragma unroll
                        for (int k = 0; k < 4; ++k) { const float ea = 1.0f + __expf(-acc[ai][0][m][n][k]), eb = 1.0f + __expf(-acc[ai][1][m][n][k]); const float ib = __builtin_amdgcn_rcpf(eb);
                            sb[4 * n + k] = ib; rt[4 * n + k] = eb * __builtin_amdgcn_rcpf(ea); }
                    u32x4 w1, w2; w1.x = cvt_pk_bf16(rt[0], rt[1]); w1.y = cvt_pk_bf16(rt[2], rt[3]); w1.z = cvt_pk_bf16(rt[4], rt[5]); w1.w = cvt_pk_bf16(rt[6], rt[7]);
                    w2.x = cvt_pk_bf16(sb[0], sb[1]); w2.y = cvt_pk_bf16(sb[2], sb[3]); w2.z = cvt_pk_bf16(sb[4], sb[5]); w2.w = cvt_pk_bf16(sb[6], sb[7]);
                    *(u32x4*)(ratio + e) = w1; *(u32x4*)(sgb + e) = w2; }
        }
    }
};

struct GateOrder {
    const char* XC; const char* W; int G, c;
    __device__ __forceinline__ bool next(int i, Unit& u) const {
        const int L = i * G + c; if (L >= 128 * 8) return false;
        u.pn = L & 1; u.e = (L >> 1) & 3; u.pm = L >> 3; u.rows = 256;
        u.a = XC + (size_t)u.pm * 256 * 2048 + (size_t)u.e * 512; u.b = W + ((size_t)u.e * 512 + (size_t)u.pn * 256) * 512; return true;
    }
};
struct EpiGates {
    static constexpr bool PERM = true;
#if defined(DUP_EPI)
    static constexpr bool DUPE = ((DUP_EPI >> 1) & 1) != 0;
#endif
    static constexpr bool POST = true;
    const bf16_t* XC; const float* ba; const float* bxx; const float* LOGSIG; bf16_t* LA; bf16_t* UU; float* LP; float* LH;
    __device__ __forceinline__ void operator()(const f32x4 (&acc)[2][2][4][2], const Unit& u, int wr, int wc, int fr, int fq) const {
        const int cb = 256 * u.e + 128 * u.pn + 32 * wc + 8 * fq;
        f32x4 va[2], vx[2], ls[2];
#pragma unroll
        for (int n = 0; n < 2; ++n) { va[n] = *(const f32x4*)(ba + cb + 4 * n); vx[n] = *(const f32x4*)(bxx + cb + 4 * n); ls[n] = *(const f32x4*)(LOGSIG + cb + 4 * n); }
        u32x4 xall[2][4];
#pragma unroll
        for (int ai = 0; ai < 2; ++ai)
#pragma unroll
            for (int m = 0; m < 4; ++m) xall[ai][m] = *(const u32x4*)(XC + (size_t)(u.pm * BM + ai * HALF + wr * 64 + m * 16 + fr) * 1024 + cb);
        asm volatile("" ::: "memory");
#pragma unroll
        for (int ai = 0; ai < 2; ++ai)
#pragma unroll
            for (int m = 0; m < 4; ++m) {
                const int t = u.pm * BM + ai * HALF + wr * 64 + m * 16 + fr; const size_t e = (size_t)t * 1024 + cb;
                const u32x4 xw = xall[ai][m]; const unsigned xu[4] = {xw.x, xw.y, xw.z, xw.w};
                const bool first = (t & (SEQ - 1)) == 0;
                float la[8], uu[8];
#pragma unroll
                for (int n = 0; n < 2; ++n)
#pragma unroll
                    for (int k = 0; k < 4; ++k) {
                        const float r = sigmoidf_(acc[ai][0][m][n][k] + va[n][k]), ig = sigmoidf_(acc[ai][1][m][n][k] + vx[n][k]);
                        const float l = 8.0f * r * ls[n][k]; const float mult = first ? 1.0f : __builtin_amdgcn_sqrtf(fmaxf(1.0f - __expf(2.0f * l), 0.f));
                        const int idx = 4 * n + k; const float xc = (idx & 1) ? __uint_as_float(xu[idx >> 1] & 0xffff0000u) : __uint_as_float(xu[idx >> 1] << 16);
                        la[idx] = l; uu[idx] = xc * ig * mult;
                    }
                u32x4 o1, o2; o1.x = cvt_pk_bf16(la[0], la[1]); o1.y = cvt_pk_bf16(la[2], la[3]); o1.z = cvt_pk_bf16(la[4], la[5]); o1.w = cvt_pk_bf16(la[6], la[7]);
                o2.x = cvt_pk_bf16(uu[0], uu[1]); o2.y = cvt_pk_bf16(uu[2], uu[3]); o2.z = cvt_pk_bf16(uu[4], uu[5]); o2.w = cvt_pk_bf16(uu[6], uu[7]);
                *(u32x4*)(LA + e) = o1; *(u32x4*)(UU + e) = o2;
            }
    }
    __device__ __forceinline__ void post(const Unit& u) const {
        int tid = threadIdx.x; asm volatile("" : "+v"(tid));
        const int w = tid >> 6, lane = tid & 63, seg = lane >> 4;
        const int ch = 256 * u.e + 128 * u.pn + 64 * (w & 1) + 4 * (lane & 15), t0 = u.pm * BM + 64 * (w >> 1);
        const size_t e0 = (size_t)(t0 + 16 * seg) * 1024 + ch;
        unsigned long long l[16], x[16];
#pragma unroll
        for (int j = 0; j < 16; ++j) { l[j] = __hip_atomic_load((const unsigned long long*)(LA + e0 + (size_t)j * 1024), __ATOMIC_RELAXED, __HIP_MEMORY_SCOPE_AGENT); x[j] = __hip_atomic_load((const unsigned long long*)(UU + e0 + (size_t)j * 1024), __ATOMIC_RELAXED, __HIP_MEMORY_SCOPE_AGENT); }
        float sl[4] = {0.f, 0.f, 0.f, 0.f}, h[4] = {0.f, 0.f, 0.f, 0.f};
#pragma unroll
        for (int j = 0; j < 16; ++j) { const unsigned lw[2] = {(unsigned)l[j], (unsigned)(l[j] >> 32)}, xw[2] = {(unsigned)x[j], (unsigned)(x[j] >> 32)};
#pragma unroll
            for (int k = 0; k < 2; ++k) { const float la0 = __uint_as_float(lw[k] << 16), la1 = __uint_as_float(lw[k] & 0xffff0000u);
                sl[2 * k] += la0; sl[2 * k + 1] += la1;
                h[2 * k] = __expf(la0) * h[2 * k] + __uint_as_float(xw[k] << 16); h[2 * k + 1] = __expf(la1) * h[2 * k + 1] + __uint_as_float(xw[k] & 0xffff0000u); } }
#pragma unroll
        for (int st = 0; st < 2; ++st) { const bool take = st == 0 ? (seg & 1) != 0 : seg == 3;
#pragma unroll
            for (int k = 0; k < 4; ++k) { const float ps = __shfl_xor(sl[k], 16 << st), ph = __shfl_xor(h[k], 16 << st);
                if (take) { h[k] = ph * __expf(sl[k]) + h[k]; sl[k] += ps; } } }
        if (seg == 3) { const size_t o = (size_t)(t0 >> 6) * 1024 + ch;
            *(f32x4*)(LP + o) = (f32x4){__expf(sl[0]), __expf(sl[1]), __expf(sl[2]), __expf(sl[3])}; *(f32x4*)(LH + o) = (f32x4){h[0], h[1], h[2], h[3]}; }
    }
};

__device__ __forceinline__ void unpack8(const u32x4 w, float (&f)[8]) { const unsigned u[4] = {w.x, w.y, w.z, w.w};
#pragma unroll
    for (int i = 0; i < 4; ++i) { f[2 * i] = __uint_as_float(u[i] << 16); f[2 * i + 1] = __uint_as_float(u[i] & 0xffff0000u); } }
struct MidMerge {
    static constexpr int KJ = 16; size_t jumpA, jumpB; const bf16_t* RATIO;
    __device__ __forceinline__ void operator()(f32x4 (&acc)[2][2][4][2], const Unit& u, int wr, int wc, int fr, int fq) const {
        int row0 = u.pm * BM + wr * 64 + fr; const int col0 = u.pn * BM + wc * 32 + 8 * fq;
        asm volatile("" : "+v"(row0));
#pragma unroll
        for (int ai = 0; ai < 2; ++ai)
#pragma unroll
            for (int mp = 0; mp < 2; ++mp) {
                u32x4 rw[2][2];
#pragma unroll
                for (int mm = 0; mm < 2; ++mm)
#pragma unroll
                    for (int bj = 0; bj < 2; ++bj) rw[mm][bj] = *(const u32x4*)(RATIO + (size_t)(row0 + ai * HALF + (2 * mp + mm) * 16) * 1024 + col0 + bj * HALF);
#pragma unroll
                for (int mm = 0; mm < 2; ++mm)
#pragma unroll
                    for (int bj = 0; bj < 2; ++bj) { float r[8]; unpack8(rw[mm][bj], r); const int m = 2 * mp + mm;
#pragma unroll
                        for (int k = 0; k < 4; ++k) { acc[ai][bj][m][0][k] *= r[k]; acc[ai][bj][m][1][k] *= r[4 + k]; } }
                asm volatile("" ::: "memory"); }
    }
};
struct EpiMerge {
    static constexpr bool PERM = true;
    const bf16_t* SGB; bf16_t* MG;
    __device__ __forceinline__ void operator()(const f32x4 (&acc)[2][2][4][2], const Unit& u, int wr, int wc, int fr, int fq) const {
        const int row0 = u.pm * BM + wr * 64 + fr, col0 = u.pn * BM + wc * 32 + 8 * fq;
#pragma unroll
        for (int ai = 0; ai < 2; ++ai) {
            u32x4 gv[4][2];
#pragma unroll
            for (int m = 0; m < 4; ++m)
#pragma unroll
                for (int bj = 0; bj < 2; ++bj) gv[m][bj] = *(const u32x4*)(SGB + (size_t)(row0 + ai * HALF + m * 16) * 1024 + col0 + bj * HALF);
            asm volatile("" ::: "memory");
#pragma unroll
            for (int m = 0; m < 4; ++m)
#pragma unroll
                for (int bj = 0; bj < 2; ++bj) { const size_t e = (size_t)(row0 + ai * HALF + m * 16) * 1024 + col0 + bj * HALF;
                    float g[8]; unpack8(gv[m][bj], g); float v[8];
#pragma unroll
                    for (int k = 0; k < 4; ++k) { v[k] = g[k] * acc[ai][bj][m][0][k]; v[4 + k] = g[4 + k] * acc[ai][bj][m][1][k]; }
                    u32x4 w; w.x = cvt_pk_bf16(v[0], v[1]); w.y = cvt_pk_bf16(v[2], v[3]); w.z = cvt_pk_bf16(v[4], v[5]); w.w = cvt_pk_bf16(v[6], v[7]);
                    *(u32x4*)(MG + e) = w; }
            asm volatile("" ::: "memory");
        }
    }
};
__device__ __forceinline__ unsigned pk4_fp8(float a, float b, float c, float d);
struct EpiOut2 {
    static constexpr bool PERM = true;
#if defined(DUP_EPI)
    static constexpr bool DUPE = ((DUP_EPI >> 4) & 1) != 0;
#endif
    const float* X; bf16_t* X1B; unsigned char* X1F8;
    __device__ __forceinline__ void operator()(const f32x4 (&acc)[2][2][4][2], const Unit& u, int wr, int wc, int fr, int fq) const {
        const int row0 = u.pm * BM + wr * 64 + fr, col0 = u.pn * BM + wc * 32 + 8 * fq;
#pragma unroll
        for (int ai = 0; ai < 2; ++ai) {
            f32x4 xv[4][2][2];
#pragma unroll
            for (int m = 0; m < 4; ++m)
#pragma unroll
                for (int bj = 0; bj < 2; ++bj) { const size_t e = (size_t)(row0 + ai * HALF + m * 16) * 1024 + col0 + bj * HALF; xv[m][bj][0] = *(const f32x4*)(X + e); xv[m][bj][1] = *(const f32x4*)(X + e + 4); }
            asm volatile("" ::: "memory");
#pragma unroll
            for (int m = 0; m < 4; ++m)
#pragma unroll
                for (int bj = 0; bj < 2; ++bj) { const size_t e = (size_t)(row0 + ai * HALF + m * 16) * 1024 + col0 + bj * HALF;
                    const f32x4 y0 = xv[m][bj][0] + acc[ai][bj][m][0], y1 = xv[m][bj][1] + acc[ai][bj][m][1];
                    u32x4 w; w.x = cvt_pk_bf16(y0[0], y0[1]); w.y = cvt_pk_bf16(y0[2], y0[3]); w.z = cvt_pk_bf16(y1[0], y1[1]); w.w = cvt_pk_bf16(y1[2], y1[3]);
                    *(u32x4*)(X1B + e) = w;
                    if (X1F8) { u32x2 w8; w8.x = pk4_fp8(y0[0], y0[1], y0[2], y0[3]); w8.y = pk4_fp8(y1[0], y1[1], y1[2], y1[3]); *(u32x2*)(X1F8 + e) = w8; } }
            asm volatile("" ::: "memory");
        }
    }
};

struct MoeOrder {
    const LAS int* tp; const LAS int* off; const char* A; const char* W; const int* LIST;
    size_t w_expert_bytes, w_tile_bytes, a_row_bytes; int lg, G, c, gather;
    __device__ __forceinline__ bool next(int i, Unit& u) const {
#if defined(MOE_ORDER_XCD)
        const int nt_all = tp[32], per = (nt_all + 7) >> 3, x = c & 7, lu = i * (G >> 3) + (c >> 3);
        int ti, pn;
        if (lg == 3) { const int g = lu >> 6, r = lu & 63; pn = 4 * (r >> 5) + (r & 3); ti = x * per + 8 * g + ((r & 31) >> 2); if (8 * g + ((r & 31) >> 2) >= per) return false; }
        else { const int g = lu >> 5, r = lu & 31; pn = r & 3; ti = x * per + 8 * g + (r >> 2); if (8 * g + (r >> 2) >= per) return false; }
        if (ti >= nt_all) return false;
#else
        const int L = i * G + c, ti = L >> lg, pn = L & ((1 << lg) - 1);
        if (ti >= tp[32]) return false;
#endif
        int e = 0;
#pragma unroll 8
        for (int j = 1; j < 32; ++j) e += (tp[j] <= ti) ? 1 : 0;
        e = __builtin_amdgcn_readfirstlane(e);
        const int rt = ti - tp[e], cnt = off[e + 1] - off[e], row0 = off[e] + 256 * rt;
        u.e = e; u.pn = pn; u.pm = __builtin_amdgcn_readfirstlane(row0); u.rows = __builtin_amdgcn_readfirstlane(min(256, cnt - 256 * rt));
        u.a = gather ? A : A + (size_t)u.pm * a_row_bytes; u.b = W + (size_t)e * w_expert_bytes + (size_t)pn * w_tile_bytes; return true;
    }
    __device__ __forceinline__ void rows(const Unit& u, int R0, int R1, int (&r)[4]) const {
        const int* l = LIST + u.pm; const int mx = u.rows - 1;
        r[0] = l[min(R0, mx)]; r[1] = l[min(R1, mx)]; r[2] = l[min(R0 + 128, mx)]; r[3] = l[min(R1 + 128, mx)];
    }
};
struct EpiGU2 {
    static constexpr bool PERM = true;
#if defined(DUP_EPI)
    static constexpr bool DUPE = ((DUP_EPI >> 5) & 1) != 0;
#endif
    const float* RS; const float* BGUP; bf16_t* ACT;
    __device__ __forceinline__ void operator()(const f32x4 (&acc)[2][2][4][2], const Unit& u, int wr, int wc, int fr, int fq) const {
        const int cl = 32 * wc + 8 * fq; const float* bp = BGUP + (size_t)u.e * 2048 + 256 * u.pn + cl;
        f32x4 bg[2], bl[2];
#pragma unroll
        for (int n = 0; n < 2; ++n) { bg[n] = *(const f32x4*)(bp + 4 * n); bl[n] = *(const f32x4*)(bp + 128 + 4 * n); }
#pragma unroll
        for (int ai = 0; ai < 2; ++ai)
#pragma unroll
            for (int m = 0; m < 4; ++m) { const int r = ai * HALF + wr * 64 + m * 16 + fr;
                if (r < u.rows) { const size_t p = (size_t)u.pm + r; const float rs = RS[p]; float a[8];
#pragma unroll
                    for (int n = 0; n < 2; ++n)
#pragma unroll
                        for (int k = 0; k < 4; ++k) { const float g = fminf(acc[ai][0][m][n][k] * rs + bg[n][k], 7.0f), l = fminf(fmaxf(acc[ai][1][m][n][k] * rs + bl[n][k], -7.0f), 7.0f);
                            a[4 * n + k] = g * sigmoidf_(1.702f * g) * (l + 1.0f); }
                    u32x4 w; w.x = cvt_pk_bf16(a[0], a[1]); w.y = cvt_pk_bf16(a[2], a[3]); w.z = cvt_pk_bf16(a[4], a[5]); w.w = cvt_pk_bf16(a[6], a[7]);
                    *(u32x4*)(ACT + p * 1024 + 128 * u.pn + cl) = w; } }
    }
};
struct EpiDown2 {
    static constexpr bool PERM = true;
#if defined(DUP_EPI)
    static constexpr bool DUPE = ((DUP_EPI >> 6) & 1) != 0;
#endif
    const float* GW; const float* BD; unsigned char* Y;
    __device__ __forceinline__ void operator()(const f32x4 (&acc)[2][2][4][2], const Unit& u, int wr, int wc, int fr, int fq) const {
        const int col0 = u.pn * BM + 32 * wc + 8 * fq; const float* bp = BD + (size_t)u.e * 1024 + col0;
        f32x4 bv[2][2];
#pragma unroll
        for (int bj = 0; bj < 2; ++bj)
#pragma unroll
            for (int n = 0; n < 2; ++n) bv[bj][n] = *(const f32x4*)(bp + bj * HALF + 4 * n);
#pragma unroll
        for (int ai = 0; ai < 2; ++ai)
#pragma unroll
            for (int m = 0; m < 4; ++m) { const int r = ai * HALF + wr * 64 + m * 16 + fr;
                if (r < u.rows) { const size_t p = (size_t)u.pm + r; const float gw = GW[p];
#pragma unroll
                    for (int bj = 0; bj < 2; ++bj) { const f32x4 v0 = (acc[ai][bj][m][0] + bv[bj][0]) * gw, v1 = (acc[ai][bj][m][1] + bv[bj][1]) * gw;
                        u32x4 w; w.x = cvt_pk_bf16(v0[0], v0[1]); w.y = cvt_pk_bf16(v0[2], v0[3]); w.z = cvt_pk_bf16(v1[0], v1[1]); w.w = cvt_pk_bf16(v1[2], v1[3]);
                        *(u32x4*)(Y + p * 1024 + col0 + bj * HALF) = w; } } }
    }
};

constexpr float F8_SW = 32.0f, F8_SA = 4.0f, F8_SY = 16.0f;
__device__ __forceinline__ unsigned pk4_fp8(float a, float b, float c, float d) {
    a = fminf(fmaxf(a, -448.f), 448.f); b = fminf(fmaxf(b, -448.f), 448.f); c = fminf(fmaxf(c, -448.f), 448.f); d = fminf(fmaxf(d, -448.f), 448.f);
    int w = 0; w = __builtin_amdgcn_cvt_pk_fp8_f32(a, b, w, false); w = __builtin_amdgcn_cvt_pk_fp8_f32(c, d, w, true); return (unsigned)w; }
struct EpiGU8 {
    static constexpr bool PERM = true;
    const float* RS; const float* BGUP; unsigned char* ACT8;
    __device__ __forceinline__ void operator()(const f32x4 (&acc)[2][2][4][2], const Unit& u, int wr, int wc, int fr, int fq) const {
        const int cl = 32 * wc + 8 * fq; const float* bp = BGUP + (size_t)u.e * 2048 + 256 * u.pn + cl;
        f32x4 bg[2], bl[2];
#pragma unroll
        for (int n = 0; n < 2; ++n) { bg[n] = *(const f32x4*)(bp + 4 * n); bl[n] = *(const f32x4*)(bp + 128 + 4 * n); }
        float rsv[2][4];
#pragma unroll
        for (int ai = 0; ai < 2; ++ai)
#pragma unroll
            for (int m = 0; m < 4; ++m) { const int r = ai * HALF + wr * 64 + m * 16 + fr; rsv[ai][m] = RS[(size_t)u.pm + min(r, u.rows - 1)]; }
        asm volatile("" ::: "memory");
#pragma unroll
        for (int ai = 0; ai < 2; ++ai)
#pragma unroll
            for (int m = 0; m < 4; ++m) { const int r = ai * HALF + wr * 64 + m * 16 + fr;
                if (r < u.rows) { const size_t p = (size_t)u.pm + r; const float rs = rsv[ai][m] * (1.0f / F8_SW); float a[8];
#pragma unroll
                    for (int n = 0; n < 2; ++n)
#pragma unroll
                        for (int k = 0; k < 4; ++k) { const float g = fminf(acc[ai][0][m][n][k] * rs + bg[n][k], 7.0f), l = fminf(fmaxf(acc[ai][1][m][n][k] * rs + bl[n][k], -7.0f), 7.0f);
                            a[4 * n + k] = g * sigmoidf_(1.702f * g) * (l + 1.0f) * F8_SA; }
                    u32x2 w; w.x = pk4_fp8(a[0], a[1], a[2], a[3]); w.y = pk4_fp8(a[4], a[5], a[6], a[7]);
                    *(u32x2*)(ACT8 + p * 1024 + 128 * u.pn + cl) = w; } }
    }
};
struct EpiDown8 {
    static constexpr bool PERM = true;
    const float* GW; const float* BD; unsigned char* Y;
    __device__ __forceinline__ void operator()(const f32x4 (&acc)[2][2][4][2], const Unit& u, int wr, int wc, int fr, int fq) const {
        const int col0 = u.pn * BM + 32 * wc + 8 * fq; const float* bp = BD + (size_t)u.e * 1024 + col0;
        f32x4 bv[2][2];
#pragma unroll
        for (int bj = 0; bj < 2; ++bj)
#pragma unroll
            for (int n = 0; n < 2; ++n) bv[bj][n] = *(const f32x4*)(bp + bj * HALF + 4 * n);
        constexpr float inv = 1.0f / (F8_SW * F8_SA);
        float gwv[2][4];
#pragma unroll
        for (int ai = 0; ai < 2; ++ai)
#pragma unroll
            for (int m = 0; m < 4; ++m) { const int r = ai * HALF + wr * 64 + m * 16 + fr; gwv[ai][m] = GW[(size_t)u.pm + min(r, u.rows - 1)]; }
        asm volatile("" ::: "memory");
#pragma unroll
        for (int ai = 0; ai < 2; ++ai)
#pragma unroll
            for (int m = 0; m < 4; ++m) { const int r = ai * HALF + wr * 64 + m * 16 + fr;
                if (r < u.rows) { const size_t p = (size_t)u.pm + r; const float gw = gwv[ai][m];
#pragma unroll
                    for (int bj = 0; bj < 2; ++bj) { const f32x4 v0 = (acc[ai][bj][m][0] * inv + bv[bj][0]) * (gw * F8_SY), v1 = (acc[ai][bj][m][1] * inv + bv[bj][1]) * (gw * F8_SY);
                        u32x2 w; w.x = pk4_fp8(v0[0], v0[1], v0[2], v0[3]); w.y = pk4_fp8(v1[0], v1[1], v1[2], v1[3]);
                        *(u32x2*)(Y + p * 1024 + col0 + bj * HALF) = w; } } }
    }
};
}


__device__ __forceinline__ unsigned pk2(float lo, float hi) { return (unsigned)f2bf(lo) | ((unsigned)f2bf(hi) << 16); }
#define SINK_U(x) asm volatile("" :: "v"(x))
template <bool DRY>
__device__ __forceinline__ void hgrn2_pass_b(int gthread, float* UB, const float* DECB) {
    constexpr int NBH = 64 / HG_NB;
    const int bh = gthread >> 12, rem = gthread & 4095, dv = rem >> 5, dkg = rem & 31;
    f32x4 S = (f32x4){0.f, 0.f, 0.f, 0.f};
    float* p = UB + (size_t)bh * NBH * 16384 + dv * 128 + dkg * 4;
    const float* dp = DECB + (size_t)bh * NBH * 128 + dkg * 4;
    f32x4 u[NBH], d4[NBH];
#pragma unroll
    for (int k = 0; k < NBH; ++k) { u[k] = *(const f32x4*)(p + (size_t)k * 16384); d4[k] = *(const f32x4*)(dp + k * 128); }
#pragma unroll
    for (int k = 0; k < NBH; ++k) { if (!DRY) *(f32x4*)(p + (size_t)k * 16384) = S; else SINK_U(S[0]); S = d4[k] * S + u[k]; }
}

typedef short v4i16_t __attribute__((ext_vector_type(4)));
__device__ __forceinline__ u32x2 vtr64(const LAS unsigned char* p) { return __builtin_bit_cast(u32x2, __builtin_amdgcn_ds_read_tr16_b64_v4i16((LAS v4i16_t*)p)); }
template <bool DRY>
__device__ __forceinline__ void hgrn2_pass_c_phase(LAS unsigned char* lds, int bx, int G, bf16_t* QI, const bf16_t* KI, const bf16_t* Vs, const bf16_t* Gs, const float* SP, const float* gn_w, bf16_t* OA, const float* DEC) {
    constexpr int P = 272, L_Q = 0, L_K = 17408, L_V = 34816, L_G = 52224, L_S = 69632, L_SS = 104448, NCH = BATCH * NH * 64;
    const int tid = threadIdx.x, lane = tid & 63, w = __builtin_amdgcn_readfirstlane(tid >> 6);
    const int it = w >> 1, hv = w & 1, cc = lane & 15, q = lane >> 4;
    const int lrow = tid >> 4, lch = tid & 15;
    u32x4 rq[2], rk[2], rv[2], rg[2];
    f32x4 Sreg[8];
#define PC_LOAD(cid_) do { const int _bh = (cid_) >> 6, _n = (cid_) & 63, _b = _bh >> 3, _h = _bh & 7; \
        const size_t _e = ((size_t)_b * SEQ + (size_t)_n * 64 + lrow) * 1024 + _h * 128 + lch * 8; \
        _Pragma("unroll") for (int _j = 0; _j < 2; ++_j) { rq[_j] = *(const u32x4*)(QI + _e + (size_t)_j * 32 * 1024); rk[_j] = *(const u32x4*)(KI + _e + (size_t)_j * 32 * 1024); \
            rv[_j] = *(const u32x4*)(Vs + _e + (size_t)_j * 32 * 1024); rg[_j] = *(const u32x4*)(Gs + _e + (size_t)_j * 32 * 1024); } \
        } while (0)
    constexpr int NBLK = NCH / HG_NB;
#define PC_CID(li_) (HG_NB * (bx + ((li_) / HG_NB) * G) + ((li_) % HG_NB))
#define PC_OK(li_) (bx + ((li_) / HG_NB) * G < NBLK)
    int li = 0;
    if (PC_OK(0)) PC_LOAD(PC_CID(0));
    for (; PC_OK(li); ++li) {
        const int cid = PC_CID(li);
        __syncthreads();
#pragma unroll
        for (int j = 0; j < 2; ++j) { const int o = (lrow + 32 * j) * P + lch * 16;
            *(LAS u32x4*)(lds + L_Q + o) = rq[j]; *(LAS u32x4*)(lds + L_K + o) = rk[j]; *(LAS u32x4*)(lds + L_V + o) = rv[j]; *(LAS u32x4*)(lds + L_G + o) = rg[j]; }
        if (cid % HG_NB == 0) {
            const float* eb = SP + (size_t)(cid / HG_NB) * 16384;
#pragma unroll
            for (int j = 0; j < 8; ++j)
#pragma unroll
                for (int r = 0; r < 4; ++r) Sreg[j][r] = eb[(16 * w + 4 * q + r) * 128 + 16 * j + cc];
#pragma unroll
            for (int j = 0; j < 8; ++j)
#pragma unroll
                for (int r = 0; r < 4; ++r) *(LAS bf16_t*)(lds + L_S + (16 * w + 4 * q + r) * P + (16 * j + cc) * 2) = f2bf(Sreg[j][r]);
        }
        if (PC_OK(li + 1)) PC_LOAD(PC_CID(li + 1));
        __syncthreads();
        const int bh = cid >> 6, n = cid & 63, b = bh >> 3, h = bh & 7;
        const size_t t0 = (size_t)b * SEQ + (size_t)n * 64;
        bf16x8 qf[4];
#pragma unroll
        for (int ks = 0; ks < 4; ++ks) qf[ks] = *(const LAS bf16x8*)(lds + L_Q + (16 * it + cc) * P + (32 * ks + 8 * q) * 2);
        f32x4 sT[4];
#pragma unroll
        for (int jt = 0; jt < 4; ++jt) {
            sT[jt] = (f32x4){0.f, 0.f, 0.f, 0.f};
            if (jt <= it) {
#pragma unroll
                for (int ks = 0; ks < 4; ++ks) { const bf16x8 kf = *(const LAS bf16x8*)(lds + L_K + (16 * jt + cc) * P + (32 * ks + 8 * q) * 2); sT[jt] = __builtin_amdgcn_mfma_f32_16x16x32_bf16(kf, qf[ks], sT[jt], 0, 0, 0); }
                if (jt == it) {
#pragma unroll
                    for (int r = 0; r < 4; ++r) if (4 * q + r > cc) sT[jt][r] = 0.f;
                }
            }
        }
        bf16x8 pf[2];
#pragma unroll
        for (int s2 = 0; s2 < 2; ++s2) { u32x4 pw; pw.x = pk2(sT[2 * s2][0], sT[2 * s2][1]); pw.y = pk2(sT[2 * s2][2], sT[2 * s2][3]); pw.z = pk2(sT[2 * s2 + 1][0], sT[2 * s2 + 1][1]); pw.w = pk2(sT[2 * s2 + 1][2], sT[2 * s2 + 1][3]); pf[s2] = __builtin_bit_cast(bf16x8, pw); }
        f32x4 acc[4];
#pragma unroll
        for (int dt = 0; dt < 4; ++dt) acc[dt] = (f32x4){0.f, 0.f, 0.f, 0.f};
#pragma unroll
        for (int dt = 0; dt < 4; ++dt) {
            const int dvt = 4 * hv + dt, dv = 16 * dvt + cc;
#pragma unroll
            for (int s2 = 0; s2 < 2; ++s2) {
                if (2 * s2 <= it) {
                    const LAS unsigned char* vp = lds + L_V + (32 * s2 + 4 * q + (cc >> 2)) * P + (16 * dvt + 4 * (cc & 3)) * 2;
                    const u32x2 lo = vtr64(vp), hi2 = vtr64(vp + 16 * P);
                    const bf16x8 vf = __builtin_bit_cast(bf16x8, (u32x4){lo.x, lo.y, hi2.x, hi2.y});
                    acc[dt] = __builtin_amdgcn_mfma_f32_16x16x32_bf16(vf, pf[s2], acc[dt], 0, 0, 0);
                }
            }
#pragma unroll
            for (int ks = 0; ks < 4; ++ks) { const bf16x8 sf = *(const LAS bf16x8*)(lds + L_S + dv * P + (32 * ks + 8 * q) * 2); acc[dt] = __builtin_amdgcn_mfma_f32_16x16x32_bf16(sf, qf[ks], acc[dt], 0, 0, 0); }
        }
        float ss = 0.f;
#pragma unroll
        for (int dt = 0; dt < 4; ++dt) ss += (acc[dt][0] * acc[dt][0] + acc[dt][1] * acc[dt][1]) + (acc[dt][2] * acc[dt][2] + acc[dt][3] * acc[dt][3]);
        ss += __shfl_xor(ss, 16); ss += __shfl_xor(ss, 32);
        LAS float* SS = (LAS float*)(lds + L_SS);
        if (q == 0) SS[(16 * it + cc) * 2 + hv] = ss;
        __syncthreads();
        const float rstd = rsqrtf((SS[(16 * it + cc) * 2] + SS[(16 * it + cc) * 2 + 1]) * (1.0f / DV) + EPS);
#pragma unroll
        for (int dt = 0; dt < 4; ++dt) {
            const int dv0 = 16 * (4 * hv + dt) + 4 * q; const size_t e = (t0 + 16 * it + cc) * 1024 + h * 128 + dv0;
            const u32x2 gw2 = *(const LAS u32x2*)(lds + L_G + (16 * it + cc) * P + dv0 * 2); const f32x4 gn = *(const f32x4*)(gn_w + h * 128 + dv0);
            const float g0 = __uint_as_float(gw2.x << 16), g1 = __uint_as_float(gw2.x & 0xffff0000u), g2 = __uint_as_float(gw2.y << 16), g3 = __uint_as_float(gw2.y & 0xffff0000u);
            u32x2 o; o.x = pk2(acc[dt][0] * rstd * gn[0] * siluf_(g0), acc[dt][1] * rstd * gn[1] * siluf_(g1)); o.y = pk2(acc[dt][2] * rstd * gn[2] * siluf_(g2), acc[dt][3] * rstd * gn[3] * siluf_(g3));
            if (!DRY) *(u32x2*)(OA + e) = o; else { SINK_U(o.x); SINK_U(o.y); }
        }
        if (cid % HG_NB != HG_NB - 1) {
            f32x4 a2[8];
#pragma unroll
            for (int j = 0; j < 8; ++j) a2[j] = (f32x4){0.f, 0.f, 0.f, 0.f};
#pragma unroll
            for (int ks = 0; ks < 2; ++ks) {
                const LAS unsigned char* ap = lds + L_V + (32 * ks + 8 * q + (cc >> 2)) * P + (16 * w + 4 * (cc & 3)) * 2;
                const u32x2 alo = vtr64(ap), ahi = vtr64(ap + 4 * P);
                const bf16x8 av = __builtin_bit_cast(bf16x8, (u32x4){alo.x, alo.y, ahi.x, ahi.y});
#pragma unroll
                for (int j = 0; j < 8; ++j) { const LAS unsigned char* bp = lds + L_K + (32 * ks + 8 * q + (cc >> 2)) * P + (16 * j + 4 * (cc & 3)) * 2;
                    const u32x2 blo = vtr64(bp), bhi = vtr64(bp + 4 * P);
                    a2[j] = __builtin_amdgcn_mfma_f32_16x16x32_bf16(av, __builtin_bit_cast(bf16x8, (u32x4){blo.x, blo.y, bhi.x, bhi.y}), a2[j], 0, 0, 0); }
            }
            const float* dc = DEC + (size_t)cid * 128;
#pragma unroll
            for (int j = 0; j < 8; ++j) { const float dj = dc[16 * j + cc];
#pragma unroll
                for (int r = 0; r < 4; ++r) { Sreg[j][r] = dj * (Sreg[j][r] + a2[j][r]); *(LAS bf16_t*)(lds + L_S + (16 * w + 4 * q + r) * P + (16 * j + cc) * 2) = f2bf(Sreg[j][r]); } }
        }
    }
    __syncthreads();
#undef PC_LOAD
#undef PC_CID
#undef PC_OK
}

template <bool DRY>
__device__ __forceinline__ void hgrn2_pass_a_phase(LAS unsigned char* lds, int bx, int G, bf16_t* Qs, bf16_t* Fs, const bf16_t* Vs, const float* LBV, float* UB, float* DEC, float* DECB) {
    constexpr int P = 272, L_Q = 0, L_F = 17408, L_V = 34816, L_KD = 52224, L_SEG = 69632, NCH = BATCH * NH * 64;
    const int tid = threadIdx.x, lane = tid & 63, w = __builtin_amdgcn_readfirstlane(tid >> 6), d = tid & 127, sg = tid >> 7;
    const int cc = lane & 15, q = lane >> 4, lrow = tid >> 4, lch = tid & 15;
    LAS float* SEGSUM = (LAS float*)(lds + L_SEG);
    u32x4 rq[2], rf[2], rv[2];
#define PA_LOAD(cid_) do { const int _bh = (cid_) >> 6, _n = (cid_) & 63, _b = _bh >> 3, _h = _bh & 7; \
        const size_t _e = ((size_t)_b * SEQ + (size_t)_n * 64 + lrow) * 1024 + _h * 128 + lch * 8; \
        _Pragma("unroll") for (int _j = 0; _j < 2; ++_j) { rq[_j] = *(const u32x4*)(Qs + _e + (size_t)_j * 32 * 1024); rf[_j] = *(const u32x4*)(Fs + _e + (size_t)_j * 32 * 1024); rv[_j] = *(const u32x4*)(Vs + _e + (size_t)_j * 32 * 1024); } } while (0)
    constexpr int NBLK = NCH / HG_NB;
    LAS float* ETOT = (LAS float*)(lds + L_SEG + 2048);
#define PA_CID(li_) (HG_NB * (bx + ((li_) / HG_NB) * G) + ((li_) % HG_NB))
#define PA_OK(li_) (bx + ((li_) / HG_NB) * G < NBLK)
    int li = 0; float prev_etot = 1.f;
    f32x4 acc[8];
    if (PA_OK(0)) PA_LOAD(PA_CID(0));
    for (; PA_OK(li); ++li) {
        const int cid = PA_CID(li);
        __syncthreads();
#pragma unroll
        for (int j = 0; j < 2; ++j) { const int o = (lrow + 32 * j) * P + lch * 16; *(LAS u32x4*)(lds + L_Q + o) = rq[j]; *(LAS u32x4*)(lds + L_F + o) = rf[j]; *(LAS u32x4*)(lds + L_V + o) = rv[j]; }
        if (PA_OK(li + 1)) PA_LOAD(PA_CID(li + 1));
        __syncthreads();
        const int bh = cid >> 6, n = cid & 63, b = bh >> 3, h = bh & 7;
        const size_t t0 = (size_t)b * SEQ + (size_t)n * 64;
        const float lb = LBV[h * 128 + d];
        float kk[16], cum[16], qs[16]; float c = 1.f;
#pragma unroll
        for (int i = 0; i < 16; ++i) {
            const float fl = bf2f(*(const LAS bf16_t*)(lds + L_F + (16 * sg + i) * P + 2 * d)); qs[i] = siluf_(bf2f(*(const LAS bf16_t*)(lds + L_Q + (16 * sg + i) * P + 2 * d)));
            const float f = lb + (1.0f - lb) * sigmoidf_(fl);
            kk[i] = 1.0f - f; c *= f; cum[i] = c;
        }
        SEGSUM[sg * 128 + d] = c;
        __syncthreads();
        float eoffs = 1.f, etot = 1.f;
#pragma unroll
        for (int s2 = 0; s2 < 4; ++s2) { const float v = SEGSUM[s2 * 128 + d]; etot *= v; if (s2 < sg) eoffs *= v; }
#pragma unroll
        for (int i = 0; i < 16; i += 2) {
            const float ex0 = eoffs * cum[i], ex1 = eoffs * cum[i + 1];
            const float ki0 = kk[i] * __builtin_amdgcn_rcpf(ex0), ki1 = kk[i + 1] * __builtin_amdgcn_rcpf(ex1);
            const unsigned wq = pg8::cvt_pk_bf16(qs[i] * ex0, qs[i + 1] * ex1), wk = pg8::cvt_pk_bf16(ki0, ki1), wd = pg8::cvt_pk_bf16(ki0 * etot, ki1 * etot);
            *(LAS bf16_t*)(lds + L_Q + (16 * sg + i) * P + 2 * d) = (bf16_t)(wq & 0xffffu); *(LAS bf16_t*)(lds + L_Q + (16 * sg + i + 1) * P + 2 * d) = (bf16_t)(wq >> 16);
            *(LAS bf16_t*)(lds + L_F + (16 * sg + i) * P + 2 * d) = (bf16_t)(wk & 0xffffu); *(LAS bf16_t*)(lds + L_F + (16 * sg + i + 1) * P + 2 * d) = (bf16_t)(wk >> 16);
            *(LAS bf16_t*)(lds + L_KD + (16 * sg + i) * P + 2 * d) = (bf16_t)(wd & 0xffffu); *(LAS bf16_t*)(lds + L_KD + (16 * sg + i + 1) * P + 2 * d) = (bf16_t)(wd >> 16);
        }
        if (sg == 0) { ETOT[d] = etot; prev_etot = (cid % HG_NB == 0) ? etot : prev_etot * etot; if (!DRY) { DEC[(size_t)cid * 128 + d] = etot; if (cid % HG_NB == HG_NB - 1) DECB[(size_t)(cid / HG_NB) * 128 + d] = prev_etot; } }
        __syncthreads();
#pragma unroll
        for (int j = 0; j < 2; ++j) { const int o = (lrow + 32 * j) * P + lch * 16; const size_t e = (t0 + lrow + 32 * j) * 1024 + h * 128 + lch * 8;
            const u32x4 a = *(const LAS u32x4*)(lds + L_Q + o), b2 = *(const LAS u32x4*)(lds + L_F + o);
            if (!DRY) { *(u32x4*)(Qs + e) = a; *(u32x4*)(Fs + e) = b2; } else { SINK_U(a.x); SINK_U(b2.x); } }
        if (cid % HG_NB == 0) {
#pragma unroll
            for (int j = 0; j < 8; ++j) acc[j] = (f32x4){0.f, 0.f, 0.f, 0.f};
        } else { const f32x4 e4 = *(const LAS f32x4*)(ETOT + 16 * w + 4 * q);
#pragma unroll
            for (int j = 0; j < 8; ++j) acc[j] = acc[j] * e4; }
#pragma unroll
        for (int ks = 0; ks < 2; ++ks) {
            const LAS unsigned char* ap = lds + L_KD + (32 * ks + 8 * q + (cc >> 2)) * P + (16 * w + 4 * (cc & 3)) * 2;
            const u32x2 alo = vtr64(ap), ahi = vtr64(ap + 4 * P);
            const bf16x8 a = __builtin_bit_cast(bf16x8, (u32x4){alo.x, alo.y, ahi.x, ahi.y});
#pragma unroll
            for (int j = 0; j < 8; ++j) { const LAS unsigned char* bp = lds + L_V + (32 * ks + 8 * q + (cc >> 2)) * P + (16 * j + 4 * (cc & 3)) * 2;
                const u32x2 blo = vtr64(bp), bhi = vtr64(bp + 4 * P);
                acc[j] = __builtin_amdgcn_mfma_f32_16x16x32_bf16(a, __builtin_bit_cast(bf16x8, (u32x4){blo.x, blo.y, bhi.x, bhi.y}), acc[j], 0, 0, 0); }
        }
        if (cid % HG_NB == HG_NB - 1) { float* ut = UB + (size_t)(cid / HG_NB) * 16384;
#pragma unroll
            for (int j = 0; j < 8; ++j) { if (!DRY) *(f32x4*)(ut + (16 * j + cc) * 128 + 16 * w + 4 * q) = acc[j]; else { SINK_U(acc[j][0]); SINK_U(acc[j][3]); } } }
    }
    __syncthreads();
#undef PA_LOAD
#undef PA_CID
#undef PA_OK
}

__device__ __forceinline__ float gelu_fast(float x) { const float u = 0.7978845608028654f * (x + 0.044715f * x * x * x); return x * sigmoidf_(2.0f * u); }
template <bool DRY>
__device__ __forceinline__ void lru_s3(int b, int npair, const bf16_t* LA, const bf16_t* UU, const float* LP, const float* LH, bf16_t* GATE_OB) {
    const int tid = threadIdx.x, half = tid >> 8, c0 = 4 * (tid & 255); const int n = half ? 63 - npair : npair;
    const size_t e0 = ((size_t)b * SEQ + (size_t)n * 64) * 1024 + c0;
    float h[4] = {0.f, 0.f, 0.f, 0.f};
    {
        const size_t o = ((size_t)b * 64) * 1024 + c0;
        for (int m0 = 0; m0 < n; m0 += 8) {
            f32x4 p[8], hh[8];
#pragma unroll
            for (int j = 0; j < 8; ++j) { const int mm = (m0 + j < n) ? m0 + j : 0; p[j] = *(const f32x4*)(LP + o + (size_t)mm * 1024); hh[j] = *(const f32x4*)(LH + o + (size_t)mm * 1024); }
#pragma unroll
            for (int j = 0; j < 8; ++j) if (m0 + j < n) {
#pragma unroll
                for (int k = 0; k < 4; ++k) h[k] = p[j][k] * h[k] + hh[j][k]; }
        }
    }
    for (int t0 = 0; t0 < 64; t0 += 8) {
        u32x2 l[8], u[8], g[8];
#pragma unroll
        for (int j = 0; j < 8; ++j) { const size_t e = e0 + (size_t)(t0 + j) * 1024; l[j] = *(const u32x2*)(LA + e); u[j] = *(const u32x2*)(UU + e); g[j] = *(const u32x2*)(GATE_OB + e); }
#pragma unroll
        for (int j = 0; j < 8; ++j) {
            const unsigned lw[2] = {l[j].x, l[j].y}, uw[2] = {u[j].x, u[j].y}, gw[2] = {g[j].x, g[j].y}; float ov[4];
#pragma unroll
            for (int k = 0; k < 2; ++k) {
                h[2 * k] = __expf(__uint_as_float(lw[k] << 16)) * h[2 * k] + __uint_as_float(uw[k] << 16);
                h[2 * k + 1] = __expf(__uint_as_float(lw[k] & 0xffff0000u)) * h[2 * k + 1] + __uint_as_float(uw[k] & 0xffff0000u);
                ov[2 * k] = h[2 * k] * gelu_fast(__uint_as_float(gw[k] << 16)); ov[2 * k + 1] = h[2 * k + 1] * gelu_fast(__uint_as_float(gw[k] & 0xffff0000u)); }
            u32x2 o; o.x = pk2(ov[0], ov[1]); o.y = pk2(ov[2], ov[3]);
            if (!DRY) *(u32x2*)(GATE_OB + e0 + (size_t)(t0 + j) * 1024) = o; else { SINK_U(o.x); SINK_U(o.y); }
        }
    }
}

constexpr int RING_BYTES = 131072, LDSCTL_OFF = RING_BYTES, MISC_OFF = LDSCTL_OFF + 320, LDS_BYTES = 147456;
constexpr int NWAVES = 8;


constexpr size_t WS_ACT = 224 * MiB, WS_Y = 512 * MiB;
constexpr size_t WS_RSTD = 992 * MiB, WS_TOPE = 993 * MiB, WS_TOPW = 994 * MiB, WS_POS = 995 * MiB, WS_LIST = 996 * MiB, WS_GW = 997 * MiB, WS_RS = 998 * MiB, WS_WGH = 999 * MiB;
constexpr int CW_CNT = 512, CW_CUR = 576;
constexpr int MOE_TP = LDSCTL_OFF + 1024, MOE_OFF = LDSCTL_OFF + 1024 + 256, MOE_HIST = LDSCTL_OFF + 1024 + 512, MOE_BASE = LDSCTL_OFF + 1024 + 768, MOE_LCUR = LDSCTL_OFF + 2048;

typedef float f32x2v __attribute__((ext_vector_type(2)));
struct MArgs { const float* in[23]; float* out; unsigned char* ws; int ph_lo, ph_hi; };


template <class RowMap>
__device__ __forceinline__ void p0_transpose_item(const float* W, int K, int N, bf16_t* WT, const RowMap& rowmap, LAS float* scr, int item, int lane, const float* kscale = nullptr) {
    const int nblk = N / 32, kb = item / nblk, nb = item % nblk, k0 = 64 * kb, n0 = 32 * nb;
    {
        const int kr = lane >> 3, nq = lane & 7; f32x4 v[8];
#pragma unroll
        for (int i = 0; i < 8; ++i) v[i] = *(const f32x4*)(W + (size_t)(k0 + 8 * i + kr) * N + n0 + 4 * nq);
#pragma unroll
        for (int i = 0; i < 8; ++i) { LAS float* d = scr + (8 * i + kr) * 33 + 4 * nq; d[0] = v[i][0]; d[1] = v[i][1]; d[2] = v[i][2]; d[3] = v[i][3]; }
    }
    LDS_WAIT(); asm volatile("" ::: "memory");
    const int c = lane & 7;
    f32x4 k0s = (f32x4){1.f, 1.f, 1.f, 1.f}, k1s = k0s;
    if (kscale) { k0s = *(const f32x4*)(kscale + k0 + 8 * c); k1s = *(const f32x4*)(kscale + k0 + 8 * c + 4); }
#pragma unroll
    for (int j = 0; j < 4; ++j) { const int n = (lane >> 3) + 8 * j; const LAS float* s = scr + (8 * c) * 33 + n;
        u32x4 o; o.x = pk2(s[0 * 33] * k0s[0], s[1 * 33] * k0s[1]); o.y = pk2(s[2 * 33] * k0s[2], s[3 * 33] * k0s[3]); o.z = pk2(s[4 * 33] * k1s[0], s[5 * 33] * k1s[1]); o.w = pk2(s[6 * 33] * k1s[2], s[7 * 33] * k1s[3]);
        *(GAS u32x4*)(WT + (size_t)rowmap(n0 + n) * K + k0 + 8 * c) = o; }
    LDS_WAIT(); asm volatile("" ::: "memory");
}

__device__ __forceinline__ void p0_load8(const float* W, int N, int item, int lane, f32x4 (&v)[8]) {
    const int nblk = N / 32, kb = item / nblk, nb = item % nblk, k0 = 64 * kb, n0 = 32 * nb; const int kr = lane >> 3, nq = lane & 7;
#pragma unroll
    for (int i = 0; i < 8; ++i) v[i] = __builtin_nontemporal_load((const f32x4*)(W + (size_t)(k0 + 8 * i + kr) * N + n0 + 4 * nq));
}
template <class RowMap>
__device__ __forceinline__ void p0_finish8(const f32x4 (&v)[8], int K, int N, unsigned char* WT, const RowMap& rowmap, LAS float* scr, int item, int lane, float scale, const float* kscale) {
    const int nblk = N / 32, kb = item / nblk, nb = item % nblk, k0 = 64 * kb, n0 = 32 * nb; const int kr = lane >> 3, nq = lane & 7;
#pragma unroll
    for (int i = 0; i < 8; ++i) { LAS float* d = scr + (8 * i + kr) * 33 + 4 * nq; d[0] = v[i][0]; d[1] = v[i][1]; d[2] = v[i][2]; d[3] = v[i][3]; }
    LDS_WAIT(); asm volatile("" ::: "memory");
    const int c = lane & 7;
    f32x4 k0s = (f32x4){scale, scale, scale, scale}, k1s = k0s;
    if (kscale) { k0s = *(const f32x4*)(kscale + k0 + 8 * c) * scale; k1s = *(const f32x4*)(kscale + k0 + 8 * c + 4) * scale; }
#pragma unroll
    for (int j = 0; j < 4; ++j) { const int n = (lane >> 3) + 8 * j; const LAS float* s = scr + (8 * c) * 33 + n;
        u32x2 o; o.x = pg8::pk4_fp8(s[0 * 33] * k0s[0], s[1 * 33] * k0s[1], s[2 * 33] * k0s[2], s[3 * 33] * k0s[3]); o.y = pg8::pk4_fp8(s[4 * 33] * k1s[0], s[5 * 33] * k1s[1], s[6 * 33] * k1s[2], s[7 * 33] * k1s[3]);
        *(GAS u32x2*)(WT + (size_t)rowmap(n0 + n) * K + k0 + 8 * c) = o; }
    LDS_WAIT(); asm volatile("" ::: "memory");
}
template <class RowMap>
__device__ __forceinline__ void p0_convert_experts8(const float* W, int K, int N, unsigned char* WT, const RowMap& rowmap, LAS float* scr, int gw, int NGW, int lane, float scale, const float* kscale) {
    const int per = (K / 64) * (N / 32), tot = NE * per; const size_t esz = (size_t)K * N;
    f32x4 va[8], vb[8], vc[8], vd[8]; int it = gw;
#define P0_LD(i_, v_) do { if ((i_) < tot) p0_load8(W + (size_t)((i_) / per) * esz, N, (i_) % per, lane, v_); } while (0)
#define P0_FN(i_, v_) do { if ((i_) < tot) p0_finish8(v_, K, N, WT + (size_t)((i_) / per) * esz, rowmap, scr, (i_) % per, lane, scale, kscale); } while (0)
    P0_LD(it, va); P0_LD(it + NGW, vb); P0_LD(it + 2 * NGW, vc);
    for (; it < tot; it += 4 * NGW) {
        P0_LD(it + 3 * NGW, vd); P0_FN(it, va);
        P0_LD(it + 4 * NGW, va); P0_FN(it + NGW, vb);
        P0_LD(it + 5 * NGW, vb); P0_FN(it + 2 * NGW, vc);
        P0_LD(it + 6 * NGW, vc); P0_FN(it + 3 * NGW, vd);
    }
#undef P0_LD
#undef P0_FN
}
struct MapId { int off; __device__ __forceinline__ int operator()(int n) const { return off + n; } };
struct MapIn { __device__ __forceinline__ int operator()(int n) const { if (n < 6144) return n; const int c = (n - 6144) & 1023, isb = (n - 6144) >> 10; return 6144 + 256 * (c >> 7) + 128 * isb + (c & 127); } };
struct MapRG { int off; __device__ __forceinline__ int operator()(int n) const { return 256 * (n >> 7) + (n & 127) + off; } };
struct MapGU { __device__ __forceinline__ int operator()(int n) const { const int f = n >> 1, half = n & 1; return 256 * (f >> 7) + 128 * half + (f & 127); } };

#ifndef DUP_MASK
#define DUP_MASK 0u
#endif

#define NREP(k) (((DUP_MASK >> (k)) & 1u) ? 2 : 1)
__device__ __forceinline__ int hid_tid() { int t = threadIdx.x; asm volatile("" : "+v"(t)); return t; }
#define PHASE_IDS() const int tid = hid_tid(), lane = tid & 63, wave = __builtin_amdgcn_readfirstlane(tid >> 6); (void)lane; (void)wave
__global__ void __launch_bounds__(512, 2) mega(MArgs args) {
    extern __shared__ __attribute__((aligned(16))) unsigned char lds_raw[];
    LAS unsigned char* lds = (LAS unsigned char*)lds_raw;
    volatile LAS unsigned* MISC = (volatile LAS unsigned*)(lds + MISC_OFF);
    const int G = gridDim.x; const int bx = blockIdx.x; const int vcu = (G % 8 == 0) ? (bx % 8) * (G / 8) + bx / 8 : bx;
    unsigned char* ws = args.ws;
    gu32* ctl = (gu32*)(ws + WS_CTL);
    for (int u = threadIdx.x; u < (LDS_BYTES - LDSCTL_OFF) / 4; u += NWAVES * 64) ((LAS unsigned*)(lds + LDSCTL_OFF))[u] = 0u;
    __syncthreads();
    XcdBarrier bar = xcd_barrier_post((unsigned*)(ctl + CW_BAR), MISC + 8);
    const int lo = args.ph_lo, hi = args.ph_hi;
#define IN(k) (lo <= (k) && (k) < hi)
#define BOTH(k) (IN(k) && IN((k) + 1))
#define GRID_BAR() xcd_barrier(bar)
    const float* x = args.in[0];
    bf16_t* XN = (bf16_t*)(ws + WS_XN); bf16_t* SEG0 = (bf16_t*)(ws + WS_SEG);
    bf16_t* WIN_T = (bf16_t*)(ws + WS_WIN_T);

    if (IN(0)) for (int rep = 0; rep < NREP(0); ++rep) {
        if (rep) __syncthreads();
        PHASE_IDS();
        LAS float* scr = (LAS float*)(lds + wave * 16384);
        const int gw = vcu * NWAVES + wave, NGW = G * NWAVES;
        constexpr int I_IN = (D / 64) * (8192 / 32);
        for (int it = gw; it < I_IN; it += NGW) p0_transpose_item(args.in[2], D, 8192, WIN_T, MapIn{}, scr, it, lane);
        {
            bf16_t* WRG_T = (bf16_t*)(ws + WS_WRG_T); constexpr int I_RG = (256 / 64) * (256 / 32);
            for (int it = gw; it < 8 * I_RG; it += NGW) { const int mat = it / I_RG, r = it % I_RG, hh = mat >> 1, ax = mat & 1;
                p0_transpose_item(args.in[ax ? 9 : 7] + (size_t)hh * 65536, 256, 256, WRG_T + (size_t)hh * 512 * 256, MapRG{ax * 128}, scr, r, lane); }
        }
        {
            constexpr int I_SQ = (D / 64) * (D / 32);
            for (int it = gw; it < 3 * I_SQ; it += NGW) { const int mat = it / I_SQ, r = it % I_SQ;
                p0_transpose_item(args.in[12 + mat], D, D, (bf16_t*)(ws + (mat == 0 ? WS_WPA_T : mat == 1 ? WS_WPB_T : WS_WOUT_T)), MapId{0}, scr, r, lane); }
        }
        {
            constexpr int I_GU = (D / 64) * (2048 / 32), I_DN = (DFF / 64) * (D / 32);
            bf16_t* WGU_T = (bf16_t*)(ws + WS_WGU_T); bf16_t* WDN_T = (bf16_t*)(ws + WS_WDN_T);
#if MOE_FP8
#if !MOE_CONV_IN_P1
            p0_convert_experts8(args.in[18], D, 2048, (unsigned char*)WGU_T, MapGU{}, scr, gw, NGW, lane, pg8::F8_SW, args.in[15]);
            p0_convert_experts8(args.in[20], DFF, D, (unsigned char*)WDN_T, MapId{0}, scr, gw, NGW, lane, pg8::F8_SW, (const float*)nullptr);
#endif
            (void)I_GU; (void)I_DN;
#else
            for (int it = gw; it < NE * I_GU; it += NGW) { const int e = it / I_GU, r = it % I_GU; p0_transpose_item(args.in[18] + (size_t)e * D * 2048, D, 2048, WGU_T + (size_t)e * 2048 * D, MapGU{}, scr, r, lane, args.in[15]); }
            for (int it = gw; it < NE * I_DN; it += NGW) { const int e = it / I_DN, r = it % I_DN; p0_transpose_item(args.in[20] + (size_t)e * DFF * D, DFF, D, WDN_T + (size_t)e * D * DFF, MapId{0}, scr, r, lane); }
#endif
            float* BGUP = (float*)(ws + WS_BGUP); const MapGU mg{};
            for (int i = bx * 512 + tid; i < NE * 2048; i += G * 512) { const int e = i >> 11, n = i & 2047; BGUP[e * 2048 + mg(n)] = args.in[19][i]; }
        }
        const float* nm = args.in[1];
        {
            f32x4 wnm[4];
#pragma unroll
            for (int j = 0; j < 4; ++j) wnm[j] = ((const GAS f32x4*)nm)[lane + 64 * j];
            for (int r2 = 0; r2 < NREP(17); ++r2) for (int m0 = gw; m0 < T; m0 += 4 * NGW) {
                f32x4 v[4][4];
#pragma unroll
                for (int a = 0; a < 4; ++a) { const int m = (m0 + a * NGW < T) ? m0 + a * NGW : m0; const GAS f32x4* xr = (const GAS f32x4*)(x + (size_t)m * D) + lane;
#pragma unroll
                    for (int j = 0; j < 4; ++j) v[a][j] = xr[64 * j]; }
#pragma unroll
                for (int a = 0; a < 4; ++a) { const int m = m0 + a * NGW; float s = 0.f;
#pragma unroll
                    for (int j = 0; j < 4; ++j) s += (v[a][j].x * v[a][j].x + v[a][j].y * v[a][j].y) + (v[a][j].z * v[a][j].z + v[a][j].w * v[a][j].w);
                    const float rstd = rsqrtf(wave_sum(s) * (1.f / D) + EPS);
                    if (m < T) { GAS u32x2* o8 = (GAS u32x2*)(XN + (size_t)m * D) + lane;
#pragma unroll
                        for (int j = 0; j < 4; ++j) { const f32x4 w = wnm[j]; u32x2 o; o.x = pk2(v[a][j].x * rstd * w.x, v[a][j].y * rstd * w.y); o.y = pk2(v[a][j].z * rstd * w.z, v[a][j].w * rstd * w.w); o8[64 * j] = o; } } }
            }
        }
        {
            bf16_t* WRH = (bf16_t*)(ws + WS_WRT); bf16_t* WRL = WRH + 32 * 1024;
            for (int i = bx * 512 + tid; i < 32 * 1024; i += G * 512) { const int e2 = i >> 10, k = i & 1023; const float v = args.in[16][k * NE + e2] * args.in[15][k];
                const bf16_t hb = f2bf(v); WRH[i] = hb; WRL[i] = f2bf(v - bf2f(hb)); }
        }
        if (bx == 0) {
            float* LBV = (float*)(ws + WS_LBV); float* LOGSIG = (float*)(ws + WS_LOGSIG);
            for (int i = tid; i < 1024; i += 512) {
                const float a0 = args.in[3][i], a1 = args.in[3][1024 + i]; const float mm = fmaxf(a0, a1); const float e0 = __expf(a0 - mm), e1 = __expf(a1 - mm);
                LBV[i] = e0 / (e0 + e1);
                const float L = args.in[11][i]; LOGSIG[i] = fminf(L, 0.f) - log1pf(__expf(-fabsf(L)));
            }
        }
        if (BOTH(0) && rep == NREP(0) - 1) { GRID_BAR();
#if defined(EXTRA_BARS)
            for (int eb = 0; eb < EXTRA_BARS; ++eb) GRID_BAR();
#endif
        }
    }
    if (IN(1)) {
        pg8::DenseOrder S; S.init(XN, (size_t)D * 2, WIN_T, (size_t)D * 2, T, 8192, G, bx);
        pg8::EpiSeg E{SEG0};
#if MOE_CONV_IN_P1
        {   PHASE_IDS();
            const int ksplit = (bx >> 3) & 15;
            S.i0 = 0; S.i1 = ksplit;
            pg8::gemm_phase<pg8::EpiSeg, pg8::DenseOrder, false>(lds, D, D, S, E);
            {   LAS float* scr = (LAS float*)(lds + wave * 16384); const int gw = vcu * NWAVES + wave, NGW = G * NWAVES;
                p0_convert_experts8(args.in[18], D, 2048, ws + WS_WGU_T, MapGU{}, scr, gw, NGW, lane, pg8::F8_SW, args.in[15]);
                p0_convert_experts8(args.in[20], DFF, D, ws + WS_WDN_T, MapId{0}, scr, gw, NGW, lane, pg8::F8_SW, (const float*)nullptr); }
            __syncthreads();
            S.i0 = ksplit; S.i1 = 1 << 30;
            pg8::gemm_phase<pg8::EpiSeg, pg8::DenseOrder, false>(lds, D, D, S, E); }
#else
        for (int rep = 0; rep < NREP(1); ++rep) pg8::gemm_phase<pg8::EpiSeg, pg8::DenseOrder, false>(lds, D, D, S, E);
#endif
        if (BOTH(1)) GRID_BAR();
    }
    bf16_t* SQ = SEG0; bf16_t* SF = SEG0 + (size_t)T * 1024; bf16_t* SV = SEG0 + (size_t)2 * T * 1024; bf16_t* SG = SEG0 + (size_t)3 * T * 1024;
    bf16_t* USP = (bf16_t*)(ws + WS_USP); float* DEC = (float*)(ws + WS_DEC);
    bf16_t* SXB = SEG0 + (size_t)4 * T * 1024; bf16_t* SGATE = SEG0 + (size_t)5 * T * 1024; bf16_t* XCb = (bf16_t*)(ws + WS_XC); bf16_t* UUb = (bf16_t*)(ws + WS_UU);
    if (IN(2)) {
        PHASE_IDS();
        if (NREP(13) == 2) hgrn2_pass_a_phase<true>(lds, bx, G, SQ, SF, SV, (const float*)(ws + WS_LBV), (float*)USP, DEC, (float*)(ws + WS_DECB));
        hgrn2_pass_a_phase<false>(lds, bx, G, SQ, SF, SV, (const float*)(ws + WS_LBV), (float*)USP, DEC, (float*)(ws + WS_DECB));
        for (int rep = 0; rep < NREP(2); ++rep) {
            const int cg = tid & 127, c0 = cg * 8; const float* cw = args.in[5]; const float* cbv = args.in[6];
            float w[4][8], bb[8];
#pragma unroll
            for (int k = 0; k < 4; ++k)
#pragma unroll
                for (int j = 0; j < 8; ++j) w[k][j] = cw[k * 1024 + c0 + j];
#pragma unroll
            for (int j = 0; j < 8; ++j) bb[j] = cbv[c0 + j];
            for (int rb = bx * 4 + (tid >> 7); rb < T / 8; rb += G * 4) {
                const int t0 = rb * 8; const bool first = (t0 & (SEQ - 1)) == 0;
                u32x4 xr[11];
#pragma unroll
                for (int i = 0; i < 11; ++i) { const int tt = t0 - 3 + i; xr[i] = (i < 3 && first) ? (u32x4){0u, 0u, 0u, 0u} : *(const u32x4*)(SXB + (size_t)tt * 1024 + c0); }
#pragma unroll
                for (int r = 0; r < 8; ++r) {
                    float a[8];
#pragma unroll
                    for (int j = 0; j < 8; ++j) a[j] = bb[j];
#pragma unroll
                    for (int k = 0; k < 4; ++k) { const unsigned xu[4] = {xr[r + k].x, xr[r + k].y, xr[r + k].z, xr[r + k].w};
#pragma unroll
                        for (int j = 0; j < 4; ++j) { a[2 * j] += __uint_as_float(xu[j] << 16) * w[k][2 * j]; a[2 * j + 1] += __uint_as_float(xu[j] & 0xffff0000u) * w[k][2 * j + 1]; } }
                    u32x4 o; o.x = pk2(a[0], a[1]); o.y = pk2(a[2], a[3]); o.z = pk2(a[4], a[5]); o.w = pk2(a[6], a[7]);
                    *(u32x4*)(XCb + (size_t)(t0 + r) * 1024 + c0) = o;
                }
            }
        }
        if (BOTH(2)) GRID_BAR();
    }
    if (IN(3)) {
        PHASE_IDS();
        if (NREP(14) == 2) for (int gt = bx * 512 + tid; gt < BATCH * NH * 4096; gt += G * 512) hgrn2_pass_b<true>(gt, (float*)USP, (const float*)(ws + WS_DECB));
        for (int gt = bx * 512 + tid; gt < BATCH * NH * 4096; gt += G * 512) hgrn2_pass_b<false>(gt, (float*)USP, (const float*)(ws + WS_DECB));
        {
            pg8::GateOrder S{(const char*)XCb, (const char*)(ws + WS_WRG_T), G, bx};
            pg8::EpiGates E{XCb, args.in[8], args.in[10], (const float*)(ws + WS_LOGSIG), SXB, UUb, (float*)(ws + WS_LRUP), (float*)(ws + WS_LRUH)};
            for (int rep = 0; rep < NREP(3); ++rep) pg8::gemm_phase<pg8::EpiGates, pg8::GateOrder, false>(lds, 256, 1024, S, E);
        }
        if (BOTH(3)) GRID_BAR();
    }
    if (IN(4)) {
        if (NREP(15) == 2) hgrn2_pass_c_phase<true>(lds, bx, G, SQ, SF, SV, SG, (const float*)USP, args.in[4], SQ, DEC);
        hgrn2_pass_c_phase<false>(lds, bx, G, SQ, SF, SV, SG, (const float*)USP, args.in[4], SQ, DEC);
        for (int u = bx; u < BATCH * 32; u += G) { const int b = u >> 5, n = u & 31;
            if (NREP(16) == 2) lru_s3<true>(b, n, SXB, UUb, (const float*)(ws + WS_LRUP), (const float*)(ws + WS_LRUH), SGATE);
            lru_s3<false>(b, n, SXB, UUb, (const float*)(ws + WS_LRUP), (const float*)(ws + WS_LRUH), SGATE); }
        if (IN(4) && IN(6)) GRID_BAR();
    }
    bf16_t* MGb = SF; bf16_t* X1Wb = (bf16_t*)(ws + WS_X1W);
    if (IN(6)) {
        {
            pg8::DenseOrder S; S.init(SQ, (size_t)D * 2, ws + WS_WPA_T, (size_t)D * 2, T, D, G, bx);
            pg8::EpiMerge E{SEG0 + (size_t)7 * T * 1024, MGb};
            pg8::MidMerge MD{(size_t)((const char*)SGATE - (const char*)SQ) - 16 * 128, (size_t)(WS_WPB_T - WS_WPA_T) - 16 * 128, SEG0 + (size_t)6 * T * 1024};
            for (int rep = 0; rep < NREP(6); ++rep) pg8::gemm_phase<pg8::EpiMerge, pg8::DenseOrder, false, pg8::MidMerge>(lds, 2 * D, D, S, E, D, MD); }
        if (BOTH(6)) GRID_BAR();
    }
    if (IN(7)) {
        pg8::DenseOrder S; S.init(MGb, (size_t)D * 2, ws + WS_WOUT_T, (size_t)D * 2, T, D, G, bx);
        pg8::EpiOut2 E{x, X1Wb, MOE_FP8 ? (unsigned char*)(ws + WS_X1) : (unsigned char*)nullptr};
        for (int rep = 0; rep < NREP(7); ++rep) pg8::gemm_phase<pg8::EpiOut2, pg8::DenseOrder, false>(lds, D, D, S, E);
        if (BOTH(7)) GRID_BAR();
    }
    float* RSTD = (float*)(ws + WS_RSTD); int* TOPE = (int*)(ws + WS_TOPE); float* TOPW = (float*)(ws + WS_TOPW); int* POS = (int*)(ws + WS_POS);
    int* LIST = (int*)(ws + WS_LIST); float* GWs = (float*)(ws + WS_GW); float* RSs = (float*)(ws + WS_RS); int* WGH = (int*)(ws + WS_WGH);
    bf16_t* ACTb = (bf16_t*)(ws + WS_ACT); bf16_t* Yb = (bf16_t*)(ws + WS_Y);
    LAS int* m_tp = (LAS int*)(lds + MOE_TP); LAS int* m_off = (LAS int*)(lds + MOE_OFF); LAS int* m_hist = (LAS int*)(lds + MOE_HIST); LAS int* m_base = (LAS int*)(lds + MOE_BASE); LAS int* m_lcur = (LAS int*)(lds + MOE_LCUR);
    if (IN(8)) {
        PHASE_IDS();
        constexpr int WP = 1040;
        LAS unsigned char* Lhi = lds; LAS unsigned char* Llo = lds + 32 * WP;
        LAS float* lgt = (LAS float*)(lds + 2 * 32 * WP);
        LAS float* rss_s = lgt + 128 * 32;
        const bf16_t* WRH = (const bf16_t*)(ws + WS_WRT); const bf16_t* WRL = WRH + 32 * 1024;
        const float* br = args.in[17];
        const int cc = lane & 15, q = lane >> 4, e = lane & 31, sub = lane >> 5;
        if (tid < 32) m_hist[tid] = 0;
        for (int tb = bx * 128; tb < T; tb += G * 128) {
            const int tok0 = tb + 16 * wave;
            f32x4 acc[2] = {(f32x4){0.f, 0.f, 0.f, 0.f}, (f32x4){0.f, 0.f, 0.f, 0.f}};
            float ssq = 0.f;
            for (int hh = 0; hh < 2; ++hh) {
                __syncthreads();
#pragma unroll
                for (int j = 0; j < 4; ++j) { const int vi = tid + 512 * j, r = vi >> 6, ch = vi & 63;
                    *(LAS u32x4*)(Lhi + r * WP + ch * 16) = *(const u32x4*)(WRH + r * 1024 + 512 * hh + ch * 8);
                    *(LAS u32x4*)(Llo + r * WP + ch * 16) = *(const u32x4*)(WRL + r * 1024 + 512 * hh + ch * 8); }
                __syncthreads();
                const bf16_t* xa = X1Wb + (size_t)(tok0 + cc) * D + 512 * hh + 8 * q;
#pragma unroll 8
                for (int ks = 0; ks < 16; ++ks) {
                    const u32x4 aw = *(const u32x4*)(xa + 32 * ks); const bf16x8 af = __builtin_bit_cast(bf16x8, aw);
                    { float f[8]; pg8::unpack8(aw, f);
#pragma unroll
                      for (int j = 0; j < 8; ++j) ssq += f[j] * f[j]; }
#pragma unroll
                    for (int tl = 0; tl < 2; ++tl) {
                        const bf16x8 bh = *(const LAS bf16x8*)(Lhi + (16 * tl + cc) * WP + (32 * ks + 8 * q) * 2), bl = *(const LAS bf16x8*)(Llo + (16 * tl + cc) * WP + (32 * ks + 8 * q) * 2);
                        acc[tl] = __builtin_amdgcn_mfma_f32_16x16x32_bf16(af, bh, acc[tl], 0, 0, 0);
                        acc[tl] = __builtin_amdgcn_mfma_f32_16x16x32_bf16(af, bl, acc[tl], 0, 0, 0);
                    }
                }
            }
            ssq += __shfl_xor(ssq, 16); ssq += __shfl_xor(ssq, 32);
            if (q == 0) rss_s[16 * wave + cc] = ssq;
#pragma unroll
            for (int tl = 0; tl < 2; ++tl)
#pragma unroll
                for (int r = 0; r < 4; ++r) lgt[(16 * wave + 4 * q + r) * 32 + 16 * tl + cc] = acc[tl][r];
            __syncthreads();
            for (int it2 = 0; it2 < 8; ++it2) {
                const int tk = 16 * wave + 2 * it2 + sub; const int t = tb + tk;
                const float rstd = rsqrtf(rss_s[tk] * (1.0f / D) + EPS);
                float cur = lgt[tk * 32 + e] * rstd + br[e];
                float val[4]; int idx[4];
#pragma unroll
                for (int k = 0; k < 4; ++k) { float bv = cur; int bi = e;
#pragma unroll
                    for (int o = 1; o < 32; o <<= 1) { const float ov = __shfl_xor(bv, o); const int oi = __shfl_xor(bi, o); if (ov > bv || (ov == bv && oi < bi)) { bv = ov; bi = oi; } }
                    val[k] = bv; idx[k] = bi; if (e == bi) cur = -INFINITY; }
                float w4[4], den = 0.f;
#pragma unroll
                for (int k = 0; k < 4; ++k) { w4[k] = __expf(val[k] - val[0]); den += w4[k]; }
                const float inv = 1.0f / den;
                if (e < 4) { const int ie = e == 0 ? idx[0] : e == 1 ? idx[1] : e == 2 ? idx[2] : idx[3]; const float we = (e == 0 ? w4[0] : e == 1 ? w4[1] : e == 2 ? w4[2] : w4[3]) * inv;
                    TOPE[(size_t)t * 4 + e] = ie; TOPW[(size_t)t * 4 + e] = we; atomicAdd((int*)(m_hist + ie), 1); }
                if (e == 0) RSTD[t] = rstd;
            }
        }
        __syncthreads();
        if (tid < 32) { const int hc = m_hist[tid]; WGH[bx * 32 + tid] = hc; atomicAdd((unsigned*)(ctl + CW_CNT + tid), (unsigned)hc); }
        if (BOTH(8)) GRID_BAR();
    }
    if (IN(9) || IN(10) || IN(11)) {
        PHASE_IDS();
        if (tid == 0) { int tp = 0, of = 0; for (int j = 0; j < 32; ++j) { const int cn = (int)__hip_atomic_load(ctl + CW_CNT + j, __ATOMIC_RELAXED, __HIP_MEMORY_SCOPE_AGENT); m_tp[j] = tp; m_off[j] = of; tp += (cn + 255) >> 8; of += cn; } m_tp[32] = tp; m_off[32] = of; }
        __syncthreads();
    }
    if (IN(9)) {
        PHASE_IDS();
        if (tid < 32) { m_base[tid] = (int)atomicAdd((unsigned*)(ctl + CW_CUR + tid), (unsigned)WGH[bx * 32 + tid]); m_lcur[tid] = 0; }
        __syncthreads();
        for (int tb = bx * 128; tb < T; tb += G * 128) {
            const int t = tb + 16 * wave + (lane >> 2), k = lane & 3; const int ie = TOPE[(size_t)t * 4 + k];
            const int p = m_off[ie] + m_base[ie] + atomicAdd((int*)(m_lcur + ie), 1);
            LIST[p] = t; GWs[p] = TOPW[(size_t)t * 4 + k]; RSs[p] = RSTD[t]; POS[(size_t)t * 4 + k] = p;
        }
        if (BOTH(9)) GRID_BAR();
    }
    if (IN(10)) {
#if MOE_FP8
        pg8::MoeOrder S{m_tp, m_off, (const char*)(ws + WS_X1), (const char*)(ws + WS_WGU_T), LIST, (size_t)2048 * D, (size_t)256 * D, (size_t)D, 3, G, bx, 1};
        pg8::EpiGU8 E{RSs, (const float*)(ws + WS_BGUP), (unsigned char*)ACTb};
        for (int rep = 0; rep < NREP(10); ++rep) pg8::gemm_phase<pg8::EpiGU8, pg8::MoeOrder, true, pg8::NoMid, true>(lds, D / 2, D / 2, S, E);
#else
        pg8::MoeOrder S{m_tp, m_off, (const char*)X1Wb, (const char*)(ws + WS_WGU_T), LIST, (size_t)2048 * D * 2, (size_t)256 * D * 2, (size_t)D * 2, 3, G, bx, 1};
        pg8::EpiGU2 E{RSs, (const float*)(ws + WS_BGUP), ACTb};
        for (int rep = 0; rep < NREP(10); ++rep) pg8::gemm_phase<pg8::EpiGU2, pg8::MoeOrder, true>(lds, D, D, S, E);
#endif
        if (BOTH(10)) GRID_BAR();
    }
    if (IN(11)) {
#if MOE_FP8
        pg8::MoeOrder S{m_tp, m_off, (const char*)ACTb, (const char*)(ws + WS_WDN_T), LIST, (size_t)D * DFF, (size_t)256 * DFF, (size_t)DFF, 2, G, bx, 0};
        pg8::EpiDown8 E{GWs, args.in[21], (unsigned char*)Yb};
        for (int rep = 0; rep < NREP(11); ++rep) pg8::gemm_phase<pg8::EpiDown8, pg8::MoeOrder, false, pg8::NoMid, true>(lds, DFF / 2, DFF / 2, S, E);
#else
        pg8::MoeOrder S{m_tp, m_off, (const char*)ACTb, (const char*)(ws + WS_WDN_T), LIST, (size_t)D * DFF * 2, (size_t)256 * DFF * 2, (size_t)DFF * 2, 2, G, bx, 0};
        pg8::EpiDown2 E{GWs, args.in[21], Yb};
        for (int rep = 0; rep < NREP(11); ++rep) pg8::gemm_phase<pg8::EpiDown2, pg8::MoeOrder, false>(lds, DFF, DFF, S, E);
#endif
        if (BOTH(11)) GRID_BAR();
    }
    if (IN(12)) {
        PHASE_IDS();
        const float* NFIN = args.in[22]; float* out = args.out;
        for (int rep = 0; rep < NREP(12); ++rep) for (int t = bx * 8 + wave; t < T; t += G * 16) {
            const int tt[2] = {t, t + G * 8 < T ? t + G * 8 : t};
            int4 ps[2]; u32x4 xw[2][2], yw[2][4];
#pragma unroll
            for (int a = 0; a < 2; ++a) ps[a] = *(const int4*)(POS + (size_t)tt[a] * 4);
#pragma unroll
            for (int a = 0; a < 2; ++a) { const u32x4* xr = (const u32x4*)(X1Wb + (size_t)tt[a] * D) + lane * 2; xw[a][0] = xr[0]; xw[a][1] = xr[1]; }
#pragma unroll
            for (int a = 0; a < 2; ++a) { const int pp[4] = {ps[a].x, ps[a].y, ps[a].z, ps[a].w};
#pragma unroll
                for (int k = 0; k < 4; ++k) yw[a][k] = *((const u32x4*)((const unsigned char*)Yb + (size_t)pp[k] * 1024) + lane); }
#pragma unroll
            for (int a = 0; a < 2; ++a) {
                float v[16], f[8];
                pg8::unpack8(xw[a][0], f);
#pragma unroll
                for (int j = 0; j < 8; ++j) v[j] = f[j];
                pg8::unpack8(xw[a][1], f);
#pragma unroll
                for (int j = 0; j < 8; ++j) v[8 + j] = f[j];
#pragma unroll
                for (int k = 0; k < 4; ++k) { const unsigned yv[4] = {yw[a][k].x, yw[a][k].y, yw[a][k].z, yw[a][k].w};
#pragma unroll
                    for (int j = 0; j < 4; ++j) { const f32x2v lo = __builtin_amdgcn_cvt_pk_f32_fp8((int)yv[j], false), hi = __builtin_amdgcn_cvt_pk_f32_fp8((int)yv[j], true);
                        v[4 * j] += lo[0] * (1.0f / pg8::F8_SY); v[4 * j + 1] += lo[1] * (1.0f / pg8::F8_SY); v[4 * j + 2] += hi[0] * (1.0f / pg8::F8_SY); v[4 * j + 3] += hi[1] * (1.0f / pg8::F8_SY); } }
                float ss = 0.f;
#pragma unroll
                for (int j = 0; j < 16; ++j) ss += v[j] * v[j];
                const float rstd = rsqrtf(wave_sum(ss) * (1.0f / D) + EPS);
                if (a == 0 || tt[1] != tt[0]) {
                    f32x4* orow = (f32x4*)(out + (size_t)tt[a] * D) + lane * 4; const f32x4* nw = (const f32x4*)NFIN + lane * 4;
#pragma unroll
                    for (int j = 0; j < 4; ++j) { const f32x4 w = nw[j]; orow[j] = (f32x4){v[4 * j] * rstd * w[0], v[4 * j + 1] * rstd * w[1], v[4 * j + 2] * rstd * w[2], v[4 * j + 3] * rstd * w[3]}; }
                }
            }
        }
    }
#undef IN
#undef BOTH
#undef GRID_BAR
}

extern "C" void kernel_launch(void* const* d_in, const int* in_sizes, int n_in, void* d_out, int out_size, void* d_ws, size_t ws_size, hipStream_t stream) {
    (void)in_sizes; (void)n_in; (void)out_size; (void)ws_size;
    unsigned char* ws = (unsigned char*)d_ws;
    static int grid = 0;
    if (grid == 0) {
        int dev = 0, cus = 0;
        (void)hipGetDevice(&dev); (void)hipDeviceGetAttribute(&cus, hipDeviceAttributeMultiprocessorCount, dev);
        (void)hipFuncSetAttribute((const void*)mega, hipFuncAttributeMaxDynamicSharedMemorySize, LDS_BYTES);
        grid = cus > 0 ? cus : 256;
    }
    (void)hipMemsetAsync(ws + WS_CTL, 0, CTL_ZERO_BYTES, stream);
    MArgs ma{};
    for (int i = 0; i < 23; ++i) ma.in[i] = (const float*)d_in[i];
    ma.out = (float*)d_out; ma.ws = ws; ma.ph_lo = 0; ma.ph_hi = 13;
    hipLaunchKernelGGL(mega, dim3(grid), dim3(512), LDS_BYTES, stream, ma);
}
```

```cpp
#include <hip/hip_runtime.h>
#include <cstdio>
#include <cstdint>

#ifndef MOE_FP8
#define MOE_FP8 2
#endif
#ifndef MOE_CONV_IN_P1
#define MOE_CONV_IN_P1 1
#endif
constexpr int HG_NB = 16;
typedef unsigned short bf16_t;
typedef short bf16x8 __attribute__((ext_vector_type(8)));
typedef float f32x4 __attribute__((ext_vector_type(4)));
typedef float f32x2v __attribute__((ext_vector_type(2)));

constexpr int BATCH = 8, SEQ = 4096, D = 1024, T = BATCH * SEQ;
constexpr int NH = 8, DK = 128, DV = 128;
constexpr int LRU_H = 4, LRU_B = 256;
constexpr int NE = 32, TOPK = 4, DFF = 1024;
constexpr float EPS = 1e-5f;
constexpr size_t MiB = 1u << 20;

constexpr size_t WS_XN   = 224 * MiB;
constexpr size_t WS_SEG  = 288 * MiB;
constexpr size_t SEG_BYTES = (size_t)T * 1024 * 2;
constexpr size_t WS_X1   = 800 * MiB;
constexpr size_t WS_X1W  = 928 * MiB;
enum { SG_Q = 0, SG_F = 1, SG_V = 2, SG_G = 3, SG_XB = 4, SG_GATE = 5, SG_GA = 6, SG_GB = 7 };

__device__ __forceinline__ float bf2f(bf16_t v) { return __uint_as_float(((unsigned)v) << 16); }
__device__ __forceinline__ bf16_t f2bf(float f) { unsigned u = __float_as_uint(f); u += 0x7fffu + ((u >> 16) & 1u); return (bf16_t)(u >> 16); }
__device__ __forceinline__ float sigmoidf_(float x) { return __builtin_amdgcn_rcpf(1.0f + __expf(-x)); }
__device__ __forceinline__ float siluf_(float x) { return x * sigmoidf_(x); }
__device__ __forceinline__ float wave_sum(float v) {
#pragma unroll
    for (int o = 1; o < 64; o <<= 1) v += __shfl_xor(v, o);
    return v;
}

#define LAS __attribute__((address_space(3)))
#define GAS __attribute__((address_space(1)))
typedef unsigned u32x4 __attribute__((ext_vector_type(4)));
typedef unsigned u32x2 __attribute__((ext_vector_type(2)));
typedef GAS unsigned gu32;
#define LDS_WAIT() asm volatile("s_waitcnt lgkmcnt(0)" ::: "memory")
#define VM_WAIT() asm volatile("s_waitcnt vmcnt(0)" ::: "memory")

constexpr size_t WS_CTL = 0, CTL_ZERO_BYTES = 64 * 1024;
constexpr size_t WS_LBV = 1 * MiB;
constexpr size_t WS_LOGSIG = 1 * MiB + 8192;
constexpr size_t WS_BGUP = 1 * MiB + 65536;
constexpr size_t WS_WRT = 1 * MiB + 512 * 1024;
constexpr size_t WS_WIN_T = 2 * MiB, WS_WRG_T = 18 * MiB, WS_WPA_T = 19 * MiB, WS_WPB_T = 21 * MiB, WS_WOUT_T = 23 * MiB;
constexpr size_t WS_DEC = 25 * MiB;
constexpr size_t WS_LRUP = 27 * MiB, WS_LRUH = 29 * MiB;
constexpr size_t WS_DECB = 31 * MiB;
constexpr size_t WS_WGU_T = 32 * MiB, WS_WDN_T = 160 * MiB;
constexpr size_t WS_XC = 224 * MiB;
constexpr size_t WS_USP = 800 * MiB;
constexpr size_t WS_UU = 928 * MiB;
constexpr int CW_TMO = 0, CW_BAR = 1024;

#define XB_TMO      128
#define XB_XCNT(j)  (256  + 64 * (j))
#define XB_XSUB(j)  (1280 + 64 * (j))
#define XB_XGEN(j)  (2304 + 64 * (j))
#define XB_TOP      3328
#define XB_TOPGEN   3392
#define XCD_BAR_WORDS 3456
#define XB_SPIN_CAP (1u << 18)
__device__ __forceinline__ unsigned xb_ld(unsigned* p)              { return __hip_atomic_load(p, __ATOMIC_RELAXED, __HIP_MEMORY_SCOPE_AGENT); }
__device__ __forceinline__ unsigned xb_add(unsigned* p, unsigned v) { return __hip_atomic_fetch_add(p, v, __ATOMIC_RELAXED, __HIP_MEMORY_SCOPE_AGENT); }
__device__ __forceinline__ unsigned xb_xcc_id() { return (unsigned)__builtin_amdgcn_s_getreg((3 << 11) | 20) & 0xFu; }
#define XB_SPIN(cond, bar) do { unsigned _sp = 0; while (cond) { __builtin_amdgcn_s_sleep(1); \
    if ((++_sp & 255u) == 0u) { if (xb_ld(&(bar)[XB_TMO])) break; if (_sp > XB_SPIN_CAP) { atomicAdd(&(bar)[XB_TMO], 1u); break; } } } } while (0)
struct XcdBarrier { unsigned* bar; unsigned x; volatile LAS unsigned* st; };
__device__ __forceinline__ XcdBarrier xcd_barrier_post(unsigned* bar, volatile LAS unsigned* st) {
    XcdBarrier b; b.bar = bar; b.x = xb_xcc_id(); b.st = st;
    if (threadIdx.x == 0) (void)xb_add(&bar[XB_XCNT(b.x)], 1u);
    return b;
}
__device__ __forceinline__ void xcd_barrier_complete(unsigned* bar, unsigned x, unsigned& nloc, unsigned& nx) {
    const unsigned G = gridDim.x * gridDim.y * gridDim.z;
    unsigned sum, cnt, mine, sp = 0u;
    for (;;) {
        sum = 0u; cnt = 0u; mine = 0u;
#pragma unroll
        for (unsigned j = 0; j < 16; ++j) { const unsigned c = xb_ld(&bar[XB_XCNT(j)]); sum += c; cnt += (c > 0u) ? 1u : 0u; mine = (j == x) ? c : mine; }
        if (sum == G) break;
        __builtin_amdgcn_s_sleep(1);
        if ((++sp & 255u) == 0u) { if (xb_ld(&bar[XB_TMO])) break; if (sp > XB_SPIN_CAP) { atomicAdd(&bar[XB_TMO], 1u); break; } }
    }
    nloc = mine > 0u ? mine : 1u; nx = cnt > 0u ? cnt : 1u;
}
__device__ __forceinline__ void xcd_barrier(const XcdBarrier& b) {
    asm volatile("s_waitcnt vmcnt(0)" ::: "memory");
    __syncthreads();
    if (threadIdx.x == 0) {
        unsigned* bar = b.bar;
        __builtin_amdgcn_s_waitcnt(0);
        unsigned nloc = b.st[0], nx = b.st[1];
        if (nloc == 0u) { xcd_barrier_complete(bar, b.x, nloc, nx); b.st[0] = nloc; b.st[1] = nx; }
        const unsigned old = xb_add(&bar[XB_XSUB(b.x)], 1u);
        const unsigned gen = old / nloc;
        if (old + 1u == (gen + 1u) * nloc) {
            __builtin_amdgcn_fence(__ATOMIC_RELEASE, "agent");
            asm volatile("s_waitcnt vmcnt(0)" ::: "memory");
            const unsigned og = xb_add(&bar[XB_TOP], 1u);
            const unsigned tg = og / nx;
            if (og + 1u == (tg + 1u) * nx) xb_add(&bar[XB_TOPGEN], 1u);
            else XB_SPIN(xb_ld(&bar[XB_TOPGEN]) == tg, bar);
            __builtin_amdgcn_fence(__ATOMIC_ACQUIRE, "agent");
            xb_add(&bar[XB_XGEN(b.x)], 1u);
            asm volatile("s_waitcnt vmcnt(0)" ::: "memory");
        } else {
            XB_SPIN(xb_ld(&bar[XB_XGEN(b.x)]) == gen, bar);
            __builtin_amdgcn_fence(__ATOMIC_ACQUIRE, "agent");
            asm volatile("s_waitcnt vmcnt(0)" ::: "memory");
        }
    }
    __syncthreads();
}

namespace pg8 {
typedef long i64x2 __attribute__((ext_vector_type(2)));
typedef int i32x4 __attribute__((ext_vector_type(4)));
typedef int i32x8 __attribute__((ext_vector_type(8)));
constexpr int BM = 256, BK = 64, HALF = 128, HTB = HALF * BK * 2, STAGE_BYTES = 8 * HTB, NXCD = 8, WGM = 4;
__host__ __device__ __forceinline__ int lds_byte(int r, int c) { const int st = (r >> 4) * 2 + (c >> 5), rr = r & 15, cc = c & 31, ob = rr * 64 + cc * 2; return st * 1024 + (ob ^ (((ob >> 9) & 1) << 5)); }
__host__ __device__ __forceinline__ void stage_rc(int b, int& R, int& C) { const int st = b / 1024, sb = b % 1024, swz = sb ^ (((sb >> 9) & 1) << 5); R = (st >> 1) * 16 + swz / 64; C = (st & 1) * 32 + (swz % 64) / 2; }
__host__ __device__ __forceinline__ int perm32(int rho) { const int n = rho >> 4, i = rho & 15; return 8 * (i >> 2) + 4 * n + (i & 3); }
__device__ __forceinline__ unsigned cvt_pk_bf16(float lo, float hi) { unsigned r; asm volatile("v_cvt_pk_bf16_f32 %0, %1, %2" : "=v"(r) : "v"(lo), "v"(hi)); return r; }

struct Unit { const char* a; const char* b; int pm, pn, e, rows; };
struct NoMid { static constexpr int KJ = 0; size_t jumpA, jumpB; template <class U> __device__ __forceinline__ void operator()(f32x4 (&)[2][2][4][2], const U&, int, int, int, int) const {} };
template <class E, class = void> struct has_post { static constexpr bool v = false; };
template <class E> struct has_post<E, decltype((void)E::POST)> { static constexpr bool v = true; };
template <class Epi, class Sched, bool GATHER, class Mid = NoMid, bool FP8 = false>
__device__ __forceinline__ void gemm_phase(LAS unsigned char* lds, const int K, const int lda  , const Sched& S, const Epi& E, const int ldb_ = 0, const Mid MD = Mid{}) {
    const int ldb = ldb_ ? ldb_ : K;
    const int tid = threadIdx.x, wid = __builtin_amdgcn_readfirstlane(tid >> 6), lane = tid & 63, wr = wid >> 2, wc = wid & 3, fr = lane & 15, fq = lane >> 4;
    const int nt = K / BK;
    unsigned vA[2][2], voffB[2];
#pragma unroll
    for (int i = 0; i < 2; ++i) { int R, C; stage_rc(tid * 16 + i * 8192, R, C); const int Rb = Epi::PERM ? ((R & ~31) + perm32(R & 31)) : R;
        vA[0][i] = (unsigned)(R * lda + C) * 2u; vA[1][i] = (unsigned)((R + HALF) * lda + C) * 2u; voffB[i] = (unsigned)(Rb * ldb + C) * 2u; }
    const size_t kstep = (size_t)(BK * 2);
    const size_t hstepB = (size_t)HALF * ldb * 2;
    const unsigned ldsw = (unsigned)wid * 1024u;
    const int aoff = lds_byte(wr * 64 + fr, fq * 8), boff = lds_byte(wc * 32 + fr, fq * 8);
#define PG8_SA(b, h) (((b) * 2 + (h)) * HTB)
#define PG8_SB(b, h) ((4 + (b) * 2 + (h)) * HTB)
#define PG8_STAGE(bufoff, gbase, voff) do { _Pragma("unroll") for (int _i = 0; _i < 2; ++_i) \
        __builtin_amdgcn_global_load_lds((const unsigned*)((const char*)(gbase) + (voff)[_i]), (LAS unsigned*)(lds + (bufoff) + ldsw + _i * 8192), 16, 0, 0); } while (0)
#define PG8_LDA(dst, b, h) do { if constexpr (MX) { _Pragma("unroll") for (int m = 0; m < 4; ++m) dst##8[m] = __builtin_shufflevector(*(const LAS i32x4*)(lds + PG8_SA(b, h) + aoff + m * 2048), *(const LAS i32x4*)(lds + PG8_SA(b, h) + aoff + m * 2048 + 1024), 0, 1, 2, 3, 4, 5, 6, 7); } \
        else { _Pragma("unroll") for (int m = 0; m < 4; ++m) _Pragma("unroll") for (int k = 0; k < 2; ++k) dst[m][k] = *(const LAS bf16x8*)(lds + PG8_SA(b, h) + aoff + m * 2048 + k * 1024); } } while (0)
#define PG8_LDB(dst, b, h) do { if constexpr (MX) { _Pragma("unroll") for (int n = 0; n < 2; ++n) dst##8[n] = __builtin_shufflevector(*(const LAS i32x4*)(lds + PG8_SB(b, h) + boff + n * 2048), *(const LAS i32x4*)(lds + PG8_SB(b, h) + boff + n * 2048 + 1024), 0, 1, 2, 3, 4, 5, 6, 7); } \
        else { _Pragma("unroll") for (int n = 0; n < 2; ++n) _Pragma("unroll") for (int k = 0; k < 2; ++k) dst[n][k] = *(const LAS bf16x8*)(lds + PG8_SB(b, h) + boff + n * 2048 + k * 1024); } } while (0)
#define PG8_MMA(ai, bj, At, Bt) do { __builtin_amdgcn_s_setprio(1); _Pragma("unroll") for (int m = 0; m < 4; ++m) _Pragma("unroll") for (int n = 0; n < 2; ++n) { \
        if constexpr (MX) {     \
            asm volatile("v_mfma_scale_f32_16x16x128_f8f6f4 %0, %1, %2, %0, %3, %3 op_sel_hi:[0,0,0]" : "+v"(acc[ai][bj][m][n]) : "v"(Bt##8[n]), "v"(At##8[m]), "v"(mxscale)); \
        } else { _Pragma("unroll") for (int k = 0; k < 2; ++k) { \
        if constexpr (FP8) { const i64x2 _b = __builtin_bit_cast(i64x2, Bt[n][k]), _a = __builtin_bit_cast(i64x2, At[m][k]); \
            acc[ai][bj][m][n] = __builtin_amdgcn_mfma_f32_16x16x32_fp8_fp8(_b[0], _a[0], acc[ai][bj][m][n], 0, 0, 0); acc[ai][bj][m][n] = __builtin_amdgcn_mfma_f32_16x16x32_fp8_fp8(_b[1], _a[1], acc[ai][bj][m][n], 0, 0, 0); } \
        else acc[ai][bj][m][n] = __builtin_amdgcn_mfma_f32_16x16x32_bf16(Bt[n][k], At[m][k], acc[ai][bj][m][n], 0, 0, 0); } } } __builtin_amdgcn_s_setprio(0); } while (0)
#define PG8_WAIT_V(n) asm volatile("s_waitcnt vmcnt(" #n ")" ::: "memory")
#define PG8_WAIT_L(n) asm volatile("s_waitcnt lgkmcnt(" #n ")" ::: "memory")
#define PG8_BAR __builtin_amdgcn_s_barrier()
#define PG8_SCHED __builtin_amdgcn_sched_barrier(0)
    Unit cur, nxt; int ui = 0;
    if (!S.next(0, cur)) return;
    f32x4 acc[2][2][4][2];
#pragma unroll
    for (int a = 0; a < 2; ++a)
#pragma unroll
        for (int b = 0; b < 2; ++b)
#pragma unroll
            for (int m = 0; m < 4; ++m)
#pragma unroll
                for (int n = 0; n < 2; ++n) acc[a][b][m][n] = (f32x4){0.f, 0.f, 0.f, 0.f};
    constexpr bool MX = FP8 && (MOE_FP8 == 2);
    int mxscale = 0x7F7F7F7F; asm volatile("" : "+v"(mxscale));
    bf16x8 At[4][2], B0[2][2], B1[2][2]; i32x8 At8[4], B08[2], B18[2];
    const char* cA = cur.a; const char* cB = cur.b;
#define PG8_GOFF(unit, dst) do { int _tz = threadIdx.x; asm volatile("" : "+v"(_tz)); int _R0, _C0, _R1, _C1; stage_rc(_tz * 16, _R0, _C0); stage_rc(_tz * 16 + 8192, _R1, _C1); int _r[4]; S.rows(unit, _R0, _R1, _r); \
        dst[0][0] = (unsigned)(_r[0] * lda + _C0) * 2u; dst[0][1] = (unsigned)(_r[1] * lda + _C1) * 2u; dst[1][0] = (unsigned)(_r[2] * lda + _C0) * 2u; dst[1][1] = (unsigned)(_r[3] * lda + _C1) * 2u; } while (0)
    LAS u32x4* noff = (LAS u32x4*)(lds + STAGE_BYTES + 4096) + tid;
    if constexpr (GATHER) { PG8_GOFF(cur, vA); }
    PG8_STAGE(PG8_SB(0, 0), cB, voffB); PG8_STAGE(PG8_SB(0, 1), cB + hstepB, voffB); PG8_STAGE(PG8_SA(0, 0), cA, vA[0]); PG8_STAGE(PG8_SA(0, 1), cA, vA[1]);
    if (wr == 1) PG8_BAR;
    PG8_WAIT_V(2); PG8_BAR;
    PG8_STAGE(PG8_SB(1, 0), cB + kstep, voffB); PG8_STAGE(PG8_SA(1, 0), cA + kstep, vA[0]); PG8_STAGE(PG8_SB(1, 1), cB + hstepB + kstep, voffB);
    PG8_WAIT_V(6); PG8_BAR;
    for (;;) {
        const bool has_next = S.next(ui + 1, nxt);
        const char* nA = has_next ? nxt.a : cA; const char* nB = has_next ? nxt.b : cB;
#pragma unroll 1
        for (int t = 0; t < nt; t += 2) {
            const bool last = (t == nt - 2);
            const char* a1 = cA + (size_t)(t + 1) * kstep;
            const char* a2 = last ? nA : cA + (size_t)(t + 2) * kstep; const char* b2 = last ? nB : cB + (size_t)(t + 2) * kstep;
            const char* a3 = a2 + kstep; const char* b3 = b2 + kstep;
            if constexpr (Mid::KJ > 0) {
                if (t + 1 >= Mid::KJ) a1 += MD.jumpA;
                if (!last && t + 2 >= Mid::KJ) { a2 += MD.jumpA; b2 += MD.jumpB; a3 += MD.jumpA; b3 += MD.jumpB; }
                if (t == Mid::KJ) MD(acc, cur, wr, wc, fr, fq);
            }
            asm volatile("" : "+s"(a1), "+s"(a2), "+s"(a3), "+s"(b2), "+s"(b3));
            unsigned o2[2][2];
            if constexpr (GATHER) {
#pragma unroll
                for (int h = 0; h < 2; ++h)
#pragma unroll
                    for (int i = 0; i < 2; ++i) o2[h][i] = vA[h][i];
                if (last && has_next) { PG8_GOFF(nxt, o2); *noff = (u32x4){o2[0][0], o2[0][1], o2[1][0], o2[1][1]}; }
            } else {
#pragma unroll
                for (int h = 0; h < 2; ++h)
#pragma unroll
                    for (int i = 0; i < 2; ++i) o2[h][i] = vA[h][i];
            }
            PG8_LDB(B0, 0, 0); PG8_LDB(B1, 0, 1); PG8_SCHED; PG8_LDA(At, 0, 0); PG8_STAGE(PG8_SA(1, 1), a1, vA[1]);
            PG8_WAIT_V(8); PG8_WAIT_L(0); PG8_BAR; PG8_MMA(0, 0, At, B0); PG8_MMA(0, 1, At, B1); PG8_BAR; PG8_SCHED;
            PG8_LDA(At, 0, 1); PG8_STAGE(PG8_SB(0, 0), b2, voffB); PG8_STAGE(PG8_SB(0, 1), b2 + hstepB, voffB); PG8_STAGE(PG8_SA(0, 0), a2, o2[0]);
            PG8_WAIT_V(8); PG8_WAIT_L(0); PG8_BAR; PG8_MMA(1, 0, At, B0); PG8_MMA(1, 1, At, B1); PG8_BAR; PG8_SCHED;
            PG8_LDB(B0, 1, 0); PG8_LDB(B1, 1, 1); PG8_SCHED; PG8_LDA(At, 1, 0); PG8_STAGE(PG8_SA(0, 1), a2, o2[1]);
            PG8_WAIT_V(8); PG8_WAIT_L(0); PG8_BAR; PG8_MMA(0, 0, At, B0); PG8_MMA(0, 1, At, B1); PG8_BAR; PG8_SCHED;
            PG8_LDA(At, 1, 1); PG8_STAGE(PG8_SB(1, 0), b3, voffB); PG8_STAGE(PG8_SB(1, 1), b3 + hstepB, voffB); PG8_STAGE(PG8_SA(1, 0), a3, o2[0]);
            PG8_WAIT_V(8); PG8_WAIT_L(0); PG8_BAR; PG8_MMA(1, 0, At, B0); PG8_MMA(1, 1, At, B1); PG8_BAR; PG8_SCHED;
        }
        if constexpr (MX) asm volatile("s_nop 15\n\ts_nop 7" ::: "memory");
        if (wr == 0) PG8_BAR;
        E(acc, cur, wr, wc, fr, fq);
#if defined(DUP_EPI)
        if constexpr (Epi::DUPE) { asm volatile("" ::: "memory"); E(acc, cur, wr, wc, fr, fq); }
#endif
        if constexpr (has_post<Epi>::v) { PG8_WAIT_V(0); PG8_BAR; E.post(cur); }
        if (!has_next) break;
#pragma unroll
        for (int a = 0; a < 2; ++a)
#pragma unroll
            for (int b = 0; b < 2; ++b)
#pragma unroll
                for (int m = 0; m < 4; ++m)
#pragma unroll
                    for (int n = 0; n < 2; ++n) acc[a][b][m][n] = (f32x4){0.f, 0.f, 0.f, 0.f};
        cur = nxt; cA = nA; cB = nB; ++ui;
        if constexpr (GATHER) { const u32x4 nv = *noff; vA[0][0] = nv.x; vA[0][1] = nv.y; vA[1][0] = nv.z; vA[1][1] = nv.w; }
        if (wr == 1) PG8_BAR;
    }
    PG8_WAIT_V(0);
    PG8_BAR;
#undef PG8_GOFF
#undef PG8_SA
#undef PG8_SB
#undef PG8_STAGE
#undef PG8_LDA
#undef PG8_LDB
#undef PG8_MMA
#undef PG8_WAIT_V
#undef PG8_WAIT_L
#undef PG8_BAR
#undef PG8_SCHED
}

struct DenseOrder {
    const char* A; const char* Bt; size_t a_tile, b_tile; int nM, nN, nwg, G, c; int i0 = 0, i1 = 1 << 30;
    __device__ __forceinline__ void init(const void* A_, size_t lda_bytes, const void* Bt_, size_t K_bytes, int M, int N, int G_, int c_) {
        A = (const char*)A_; Bt = (const char*)Bt_; a_tile = 256 * lda_bytes; b_tile = 256 * K_bytes; nM = M / BM; nN = N / BM; nwg = nM * nN; G = G_; c = c_; }
    __device__ __forceinline__ bool next(int i, Unit& u) const {
        if (i0 + i >= i1) return false;
        const long L = (long)(i0 + i) * G + c; if (L >= nwg) return false;
        int wgid = (int)L; { const int q = nwg / NXCD, r = nwg % NXCD, xcd = wgid % NXCD, off = wgid / NXCD; wgid = (xcd < r ? xcd * (q + 1) : r * (q + 1) + (xcd - r) * q) + off; }
        const int nig = WGM * nN, gid = wgid / nig, fm = gid * WGM, gsz = (nM - fm) < WGM ? (nM - fm) : WGM;
        u.pm = fm + ((wgid % nig) % gsz); u.pn = (wgid % nig) / gsz; u.e = 0; u.rows = 256;
        u.a = A + (size_t)u.pm * a_tile; u.b = Bt + (size_t)u.pn * b_tile; return true;
    }
};

struct EpiSeg {
    static constexpr bool PERM = true;
#if defined(DUP_EPI)
    static constexpr bool DUPE = ((DUP_EPI >> 0) & 1) != 0;
#endif
    bf16_t* seg0;
    __device__ __forceinline__ void operator()(const f32x4 (&acc)[2][2][4][2], const Unit& u, int wr, int wc, int fr, int fq) const {
        const int row0 = u.pm * BM + wr * 64 + fr;
        if (u.pn < 24) {
            bf16_t* base = seg0 + (size_t)(u.pn >> 2) * ((size_t)T * 1024);
            const int col0 = (u.pn & 3) * BM + wc * 32 + 8 * fq;
#pragma unroll
            for (int ai = 0; ai < 2; ++ai)
#pragma unroll
                for (int m = 0; m < 4; ++m) { bf16_t* rowp = base + (size_t)(row0 + ai * HALF + m * 16) * 1024 + col0;
#pragma unroll
                    for (int bj = 0; bj < 2; ++bj) { const f32x4 v0 = acc[ai][bj][m][0], v1 = acc[ai][bj][m][1];
                        u32x4 w; w.x = cvt_pk_bf16(v0[0], v0[1]); w.y = cvt_pk_bf16(v0[2], v0[3]); w.z = cvt_pk_bf16(v1[0], v1[1]); w.w = cvt_pk_bf16(v1[2], v1[3]);
                        *(u32x4*)(rowp + bj * HALF) = w; } }
        } else {
            bf16_t* ratio = seg0 + (size_t)6 * ((size_t)T * 1024); bf16_t* sgb = seg0 + (size_t)7 * ((size_t)T * 1024);
            const int col0 = (u.pn - 24) * HALF + wc * 32 + 8 * fq;
#pragma unroll
            for (int ai = 0; ai < 2; ++ai)
#pragma unroll
                for (int m = 0; m < 4; ++m) { const size_t e = (size_t)(row0 + ai * HALF + m * 16) * 1024 + col0; float rt[8], sb[8];
#pragma unroll
                    for (int n = 0; n < 2; ++n)
#pragma unroll
                        for (int k = 0; k < 4; ++k) { const float ea = 1.0f + __expf(-acc[ai][0][m][n][k]), eb = 1.0f + __expf(-acc[ai][1][m][n][k]); const float ib = __builtin_amdgcn_rcpf(eb);
                            sb[4 * n + k] = ib; rt[4 * n + k] = eb * __builtin_amdgcn_rcpf(ea); }
                    u32x4 w1, w2; w1.x = cvt_pk_bf16(rt[0], rt[1]); w1.y = cvt_pk_bf16(rt[2], rt[3]); w1.z = cvt_pk_bf16(rt[4], rt[5]); w1.w = cvt_pk_bf16(rt[6], rt[7]);
                    w2.x = cvt_pk_bf16(sb[0], sb[1]); w2.y = cvt_pk_bf16(sb[2], sb[3]); w2.z = cvt_pk_bf16(sb[4], sb[5]); w2.w = cvt_pk_bf16(sb[6], sb[7]);
                    *(u32x4*)(ratio + e) = w1; *(u32x4*)(sgb + e) = w2; }
        }
    }
};

struct GateOrder {
    const char* XC; const char* W; int G, c;
    __device__ __forceinline__ bool next(int i, Unit& u) const {
        const int L = i * G + c; if (L >= 128 * 8) return false;
        u.pn = L & 1; u.e = (L >> 1) & 3; u.pm = L >> 3; u.rows = 256;
        u.a = XC + (size_t)u.pm * 256 * 2048 + (size_t)u.e * 512; u.b = W + ((size_t)u.e * 512 + (size_t)u.pn * 256) * 512; return true;
    }
};
struct EpiGates {
    static constexpr bool PERM = true;
#if defined(DUP_EPI)
    static constexpr bool DUPE = ((DUP_EPI >> 1) & 1) != 0;
#endif
    static constexpr bool POST = true;
    const bf16_t* XC; const float* ba; const float* bxx; const float* LOGSIG; bf16_t* LA; bf16_t* UU; float* LP; float* LH;
    __device__ __forceinline__ void operator()(const f32x4 (&acc)[2][2][4][2], const Unit& u, int wr, int wc, int fr, int fq) const {
        const int cb = 256 * u.e + 128 * u.pn + 32 * wc + 8 * fq;
        f32x4 va[2], vx[2], ls[2];
#pragma unroll
        for (int n = 0; n < 2; ++n) { va[n] = *(const f32x4*)(ba + cb + 4 * n); vx[n] = *(const f32x4*)(bxx + cb + 4 * n); ls[n] = *(const f32x4*)(LOGSIG + cb + 4 * n); }
        u32x4 xall[2][4];
#pragma unroll
        for (int ai = 0; ai < 2; ++ai)
#pragma unroll
            for (int m = 0; m < 4; ++m) xall[ai][m] = *(const u32x4*)(XC + (size_t)(u.pm * BM + ai * HALF + wr * 64 + m * 16 + fr) * 1024 + cb);
        asm volatile("" ::: "memory");
#pragma unroll
        for (int ai = 0; ai < 2; ++ai)
#pragma unroll
            for (int m = 0; m < 4; ++m) {
                const int t = u.pm * BM + ai * HALF + wr * 64 + m * 16 + fr; const size_t e = (size_t)t * 1024 + cb;
                const u32x4 xw = xall[ai][m]; const unsigned xu[4] = {xw.x, xw.y, xw.z, xw.w};
                const bool first = (t & (SEQ - 1)) == 0;
                float la[8], uu[8];
#pragma unroll
                for (int n = 0; n < 2; ++n)
#pragma unroll
                    for (int k = 0; k < 4; ++k) {
                        const float r = sigmoidf_(acc[ai][0][m][n][k] + va[n][k]), ig = sigmoidf_(acc[ai][1][m][n][k] + vx[n][k]);
                        const float l = 8.0f * r * ls[n][k]; const float mult = first ? 1.0f : __builtin_amdgcn_sqrtf(fmaxf(1.0f - __expf(2.0f * l), 0.f));
                        const int idx = 4 * n + k; const float xc = (idx & 1) ? __uint_as_float(xu[idx >> 1] & 0xffff0000u) : __uint_as_float(xu[idx >> 1] << 16);
                        la[idx] = l; uu[idx] = xc * ig * mult;
                    }
                u32x4 o1, o2; o1.x = cvt_pk_bf16(la[0], la[1]); o1.y = cvt_pk_bf16(la[2], la[3]); o1.z = cvt_pk_bf16(la[4], la[5]); o1.w = cvt_pk_bf16(la[6], la[7]);
                o2.x = cvt_pk_bf16(uu[0], uu[1]); o2.y = cvt_pk_bf16(uu[2], uu[3]); o2.z = cvt_pk_bf16(uu[4], uu[5]); o2.w = cvt_pk_bf16(uu[6], uu[7]);
                *(u32x4*)(LA + e) = o1; *(u32x4*)(UU + e) = o2;
            }
    }
    __device__ __forceinline__ void post(const Unit& u) const {
        int tid = threadIdx.x; asm volatile("" : "+v"(tid));
        const int w = tid >> 6, lane = tid & 63, seg = lane >> 4;
        const int ch = 256 * u.e + 128 * u.pn + 64 * (w & 1) + 4 * (lane & 15), t0 = u.pm * BM + 64 * (w >> 1);
        const size_t e0 = (size_t)(t0 + 16 * seg) * 1024 + ch;
        unsigned long long l[16], x[16];
#pragma unroll
        for (int j = 0; j < 16; ++j) { l[j] = __hip_atomic_load((const unsigned long long*)(LA + e0 + (size_t)j * 1024), __ATOMIC_RELAXED, __HIP_MEMORY_SCOPE_AGENT); x[j] = __hip_atomic_load((const unsigned long long*)(UU + e0 + (size_t)j * 1024), __ATOMIC_RELAXED, __HIP_MEMORY_SCOPE_AGENT); }
        float sl[4] = {0.f, 0.f, 0.f, 0.f}, h[4] = {0.f, 0.f, 0.f, 0.f};
#pragma unroll
        for (int j = 0; j < 16; ++j) { const unsigned lw[2] = {(unsigned)l[j], (unsigned)(l[j] >> 32)}, xw[2] = {(unsigned)x[j], (unsigned)(x[j] >> 32)};
#pragma unroll
            for (int k = 0; k < 2; ++k) { const float la0 = __uint_as_float(lw[k] << 16), la1 = __uint_as_float(lw[k] & 0xffff0000u);
                sl[2 * k] += la0; sl[2 * k + 1] += la1;
                h[2 * k] = __expf(la0) * h[2 * k] + __uint_as_float(xw[k] << 16); h[2 * k + 1] = __expf(la1) * h[2 * k + 1] + __uint_as_float(xw[k] & 0xffff0000u); } }
#pragma unroll
        for (int st = 0; st < 2; ++st) { const bool take = st == 0 ? (seg & 1) != 0 : seg == 3;
#pragma unroll
            for (int k = 0; k < 4; ++k) { const float ps = __shfl_xor(sl[k], 16 << st), ph = __shfl_xor(h[k], 16 << st);
                if (take) { h[k] = ph * __expf(sl[k]) + h[k]; sl[k] += ps; } } }
        if (seg == 3) { const size_t o = (size_t)(t0 >> 6) * 1024 + ch;
            *(f32x4*)(LP + o) = (f32x4){__expf(sl[0]), __expf(sl[1]), __expf(sl[2]), __expf(sl[3])}; *(f32x4*)(LH + o) = (f32x4){h[0], h[1], h[2], h[3]}; }
    }
};

__device__ __forceinline__ void unpack8(const u32x4 w, float (&f)[8]) { const unsigned u[4] = {w.x, w.y, w.z, w.w};
#pragma unroll
    for (int i = 0; i < 4; ++i) { f[2 * i] = __uint_as_float(u[i] << 16); f[2 * i + 1] = __uint_as_float(u[i] & 0xffff0000u); } }
struct MidMerge {
    static constexpr int KJ = 16; size_t jumpA, jumpB; const bf16_t* RATIO;
    __device__ __forceinline__ void operator()(f32x4 (&acc)[2][2][4][2], const Unit& u, int wr, int wc, int fr, int fq) const {
        int row0 = u.pm * BM + wr * 64 + fr; const int col0 = u.pn * BM + wc * 32 + 8 * fq;
        asm volatile("" : "+v"(row0));
#pragma unroll
        for (int ai = 0; ai < 2; ++ai)
#pragma unroll
            for (int mp = 0; mp < 2; ++mp) {
                u32x4 rw[2][2];
#pragma unroll
                for (int mm = 0; mm < 2; ++mm)
#pragma unroll
                    for (int bj = 0; bj < 2; ++bj) rw[mm][bj] = *(const u32x4*)(RATIO + (size_t)(row0 + ai * HALF + (2 * mp + mm) * 16) * 1024 + col0 + bj * HALF);
#pragma unroll
                for (int mm = 0; mm < 2; ++mm)
#pragma unroll
                    for (int bj = 0; bj < 2; ++bj) { float r[8]; unpack8(rw[mm][bj], r); const int m = 2 * mp + mm;
#pragma unroll
                        for (int k = 0; k < 4; ++k) { acc[ai][bj][m][0][k] *= r[k]; acc[ai][bj][m][1][k] *= r[4 + k]; } }
                asm volatile("" ::: "memory"); }
    }
};
struct EpiMerge {
    static constexpr bool PERM = true;
    const bf16_t* SGB; bf16_t* MG;
    __device__ __forceinline__ void operator()(const f32x4 (&acc)[2][2][4][2], const Unit& u, int wr, int wc, int fr, int fq) const {
        const int row0 = u.pm * BM + wr * 64 + fr, col0 = u.pn * BM + wc * 32 + 8 * fq;
#pragma unroll
        for (int ai = 0; ai < 2; ++ai) {
            u32x4 gv[4][2];
#pragma unroll
            for (int m = 0; m < 4; ++m)
#pragma unroll
                for (int bj = 0; bj < 2; ++bj) gv[m][bj] = *(const u32x4*)(SGB + (size_t)(row0 + ai * HALF + m * 16) * 1024 + col0 + bj * HALF);
            asm volatile("" ::: "memory");
#pragma unroll
            for (int m = 0; m < 4; ++m)
#pragma unroll
                for (int bj = 0; bj < 2; ++bj) { const size_t e = (size_t)(row0 + ai * HALF + m * 16) * 1024 + col0 + bj * HALF;
                    float g[8]; unpack8(gv[m][bj], g); float v[8];
#pragma unroll
                    for (int k = 0; k < 4; ++k) { v[k] = g[k] * acc[ai][bj][m][0][k]; v[4 + k] = g[4 + k] * acc[ai][bj][m][1][k]; }
                    u32x4 w; w.x = cvt_pk_bf16(v[0], v[1]); w.y = cvt_pk_bf16(v[2], v[3]); w.z = cvt_pk_bf16(v[4], v[5]); w.w = cvt_pk_bf16(v[6], v[7]);
                    *(u32x4*)(MG + e) = w; }
            asm volatile("" ::: "memory");
        }
    }
};
__device__ __forceinline__ unsigned pk4_fp8(float a, float b, float c, float d);
struct EpiOut2 {
    static constexpr bool PERM = true;
#if defined(DUP_EPI)
    static constexpr bool DUPE = ((DUP_EPI >> 4) & 1) != 0;
#endif
    const float* X; bf16_t* X1B; unsigned char* X1F8;
    __device__ __forceinline__ void operator()(const f32x4 (&acc)[2][2][4][2], const Unit& u, int wr, int wc, int fr, int fq) const {
        const int row0 = u.pm * BM + wr * 64 + fr, col0 = u.pn * BM + wc * 32 + 8 * fq;
#pragma unroll
        for (int ai = 0; ai < 2; ++ai) {
            f32x4 xv[4][2][2];
#pragma unroll
            for (int m = 0; m < 4; ++m)
#pragma unroll
                for (int bj = 0; bj < 2; ++bj) { const size_t e = (size_t)(row0 + ai * HALF + m * 16) * 1024 + col0 + bj * HALF; xv[m][bj][0] = *(const f32x4*)(X + e); xv[m][bj][1] = *(const f32x4*)(X + e + 4); }
            asm volatile("" ::: "memory");
#pragma unroll
            for (int m = 0; m < 4; ++m)
#pragma unroll
                for (int bj = 0; bj < 2; ++bj) { const size_t e = (size_t)(row0 + ai * HALF + m * 16) * 1024 + col0 + bj * HALF;
                    const f32x4 y0 = xv[m][bj][0] + acc[ai][bj][m][0], y1 = xv[m][bj][1] + acc[ai][bj][m][1];
                    u32x4 w; w.x = cvt_pk_bf16(y0[0], y0[1]); w.y = cvt_pk_bf16(y0[2], y0[3]); w.z = cvt_pk_bf16(y1[0], y1[1]); w.w = cvt_pk_bf16(y1[2], y1[3]);
                    *(u32x4*)(X1B + e) = w;
                    if (X1F8) { u32x2 w8; w8.x = pk4_fp8(y0[0], y0[1], y0[2], y0[3]); w8.y = pk4_fp8(y1[0], y1[1], y1[2], y1[3]); *(u32x2*)(X1F8 + e) = w8; } }
            asm volatile("" ::: "memory");
        }
    }
};

struct MoeOrder {
    const LAS int* tp; const LAS int* off; const char* A; const char* W; const int* LIST;
    size_t w_expert_bytes, w_tile_bytes, a_row_bytes; int lg, G, c, gather;
    __device__ __forceinline__ bool next(int i, Unit& u) const {
#if defined(MOE_ORDER_XCD)
        const int nt_all = tp[32], per = (nt_all + 7) >> 3, x = c & 7, lu = i * (G >> 3) + (c >> 3);
        int ti, pn;
        if (lg == 3) { const int g = lu >> 6, r = lu & 63; pn = 4 * (r >> 5) + (r & 3); ti = x * per + 8 * g + ((r & 31) >> 2); if (8 * g + ((r & 31) >> 2) >= per) return false; }
        else { const int g = lu >> 5, r = lu & 31; pn = r & 3; ti = x * per + 8 * g + (r >> 2); if (8 * g + (r >> 2) >= per) return false; }
        if (ti >= nt_all) return false;
#else
        const int L = i * G + c, ti = L >> lg, pn = L & ((1 << lg) - 1);
        if (ti >= tp[32]) return false;
#endif
        int e = 0;
#pragma unroll 8
        for (int j = 1; j < 32; ++j) e += (tp[j] <= ti) ? 1 : 0;
        e = __builtin_amdgcn_readfirstlane(e);
        const int rt = ti - tp[e], cnt = off[e + 1] - off[e], row0 = off[e] + 256 * rt;
        u.e = e; u.pn = pn; u.pm = __builtin_amdgcn_readfirstlane(row0); u.rows = __builtin_amdgcn_readfirstlane(min(256, cnt - 256 * rt));
        u.a = gather ? A : A + (size_t)u.pm * a_row_bytes; u.b = W + (size_t)e * w_expert_bytes + (size_t)pn * w_tile_bytes; return true;
    }
    __device__ __forceinline__ void rows(const Unit& u, int R0, int R1, int (&r)[4]) const {
        const int* l = LIST + u.pm; const int mx = u.rows - 1;
        r[0] = l[min(R0, mx)]; r[1] = l[min(R1, mx)]; r[2] = l[min(R0 + 128, mx)]; r[3] = l[min(R1 + 128, mx)];
    }
};
struct EpiGU2 {
    static constexpr bool PERM = true;
#if defined(DUP_EPI)
    static constexpr bool DUPE = ((DUP_EPI >> 5) & 1) != 0;
#endif
    const float* RS; const float* BGUP; bf16_t* ACT;
    __device__ __forceinline__ void operator()(const f32x4 (&acc)[2][2][4][2], const Unit& u, int wr, int wc, int fr, int fq) const {
        const int cl = 32 * wc + 8 * fq; const float* bp = BGUP + (size_t)u.e * 2048 + 256 * u.pn + cl;
        f32x4 bg[2], bl[2];
#pragma unroll
        for (int n = 0; n < 2; ++n) { bg[n] = *(const f32x4*)(bp + 4 * n); bl[n] = *(const f32x4*)(bp + 128 + 4 * n); }
#pragma unroll
        for (int ai = 0; ai < 2; ++ai)
#pragma unroll
            for (int m = 0; m < 4; ++m) { const int r = ai * HALF + wr * 64 + m * 16 + fr;
                if (r < u.rows) { const size_t p = (size_t)u.pm + r; const float rs = RS[p]; float a[8];
#pragma unroll
                    for (int n = 0; n < 2; ++n)
#pragma unroll
                        for (int k = 0; k < 4; ++k) { const float g = fminf(acc[ai][0][m][n][k] * rs + bg[n][k], 7.0f), l = fminf(fmaxf(acc[ai][1][m][n][k] * rs + bl[n][k], -7.0f), 7.0f);
                            a[4 * n + k] = g * sigmoidf_(1.702f * g) * (l + 1.0f); }
                    u32x4 w; w.x = cvt_pk_bf16(a[0], a[1]); w.y = cvt_pk_bf16(a[2], a[3]); w.z = cvt_pk_bf16(a[4], a[5]); w.w = cvt_pk_bf16(a[6], a[7]);
                    *(u32x4*)(ACT + p * 1024 + 128 * u.pn + cl) = w; } }
    }
};
struct EpiDown2 {
    static constexpr bool PERM = true;
#if defined(DUP_EPI)
    static constexpr bool DUPE = ((DUP_EPI >> 6) & 1) != 0;
#endif
    const float* GW; const float* BD; unsigned char* Y;
    __device__ __forceinline__ void operator()(const f32x4 (&acc)[2][2][4][2], const Unit& u, int wr, int wc, int fr, int fq) const {
        const int col0 = u.pn * BM + 32 * wc + 8 * fq; const float* bp = BD + (size_t)u.e * 1024 + col0;
        f32x4 bv[2][2];
#pragma unroll
        for (int bj = 0; bj < 2; ++bj)
#pragma unroll
            for (int n = 0; n < 2; ++n) bv[bj][n] = *(const f32x4*)(bp + bj * HALF + 4 * n);
#pragma unroll
        for (int ai = 0; ai < 2; ++ai)
#pragma unroll
            for (int m = 0; m < 4; ++m) { const int r = ai * HALF + wr * 64 + m * 16 + fr;
                if (r < u.rows) { const size_t p = (size_t)u.pm + r; const float gw = GW[p];
#pragma unroll
                    for (int bj = 0; bj < 2; ++bj) { const f32x4 v0 = (acc[ai][bj][m][0] + bv[bj][0]) * gw, v1 = (acc[ai][bj][m][1] + bv[bj][1]) * gw;
                        u32x4 w; w.x = cvt_pk_bf16(v0[0], v0[1]); w.y = cvt_pk_bf16(v0[2], v0[3]); w.z = cvt_pk_bf16(v1[0], v1[1]); w.w = cvt_pk_bf16(v1[2], v1[3]);
                        *(u32x4*)(Y + p * 1024 + col0 + bj * HALF) = w; } } }
    }
};

constexpr float F8_SW = 32.0f, F8_SA = 4.0f, F8_SY = 16.0f;
__device__ __forceinline__ unsigned pk4_fp8(float a, float b, float c, float d) {
    a = fminf(fmaxf(a, -448.f), 448.f); b = fminf(fmaxf(b, -448.f), 448.f); c = fminf(fmaxf(c, -448.f), 448.f); d = fminf(fmaxf(d, -448.f), 448.f);
    int w = 0; w = __builtin_amdgcn_cvt_pk_fp8_f32(a, b, w, false); w = __builtin_amdgcn_cvt_pk_fp8_f32(c, d, w, true); return (unsigned)w; }
struct EpiGU8 {
    static constexpr bool PERM = true;
    const float* RS; const float* BGUP; unsigned char* ACT8;
    __device__ __forceinline__ void operator()(const f32x4 (&acc)[2][2][4][2], const Unit& u, int wr, int wc, int fr, int fq) const {
        const int cl = 32 * wc + 8 * fq; const float* bp = BGUP + (size_t)u.e * 2048 + 256 * u.pn + cl;
        f32x4 bg[2], bl[2];
#pragma unroll
        for (int n = 0; n < 2; ++n) { bg[n] = *(const f32x4*)(bp + 4 * n); bl[n] = *(const f32x4*)(bp + 128 + 4 * n); }
        float rsv[2][4];
#pragma unroll
        for (int ai = 0; ai < 2; ++ai)
#pragma unroll
            for (int m = 0; m < 4; ++m) { const int r = ai * HALF + wr * 64 + m * 16 + fr; rsv[ai][m] = RS[(size_t)u.pm + min(r, u.rows - 1)]; }
        asm volatile("" ::: "memory");
#pragma unroll
        for (int ai = 0; ai < 2; ++ai)
#pragma unroll
            for (int m = 0; m < 4; ++m) { const int r = ai * HALF + wr * 64 + m * 16 + fr;
                if (r < u.rows) { const size_t p = (size_t)u.pm + r; const float rs = rsv[ai][m] * (1.0f / F8_SW); float a[8];
#pragma unroll
                    for (int n = 0; n < 2; ++n)
#pragma unroll
                        for (int k = 0; k < 4; k += 2) {
                            const f32x2v rs2 = {rs, rs};
                            f32x2v g = (f32x2v){acc[ai][0][m][n][k], acc[ai][0][m][n][k + 1]} * rs2 + (f32x2v){bg[n][k], bg[n][k + 1]};
                            f32x2v l = (f32x2v){acc[ai][1][m][n][k], acc[ai][1][m][n][k + 1]} * rs2 + (f32x2v){bl[n][k], bl[n][k + 1]};
                            g[0] = fminf(g[0], 7.0f); g[1] = fminf(g[1], 7.0f); l[0] = __builtin_amdgcn_fmed3f(l[0], -7.0f, 7.0f); l[1] = __builtin_amdgcn_fmed3f(l[1], -7.0f, 7.0f);
                            f32x2v e = g * (f32x2v){-1.702f * 1.4426950408889634f, -1.702f * 1.4426950408889634f};
                            e[0] = __builtin_amdgcn_exp2f(e[0]); e[1] = __builtin_amdgcn_exp2f(e[1]);
                            e = e + (f32x2v){1.0f, 1.0f};
                            e[0] = __builtin_amdgcn_rcpf(e[0]); e[1] = __builtin_amdgcn_rcpf(e[1]);
                            const f32x2v o = (g * e) * (l * (f32x2v){F8_SA, F8_SA} + (f32x2v){F8_SA, F8_SA});
                            a[4 * n + k] = o[0]; a[4 * n + k + 1] = o[1]; }
                    u32x2 w; { int w0 = 0, w1 = 0; w0 = __builtin_amdgcn_cvt_pk_fp8_f32(a[0], a[1], w0, false); w0 = __builtin_amdgcn_cvt_pk_fp8_f32(a[2], a[3], w0, true);
                        w1 = __builtin_amdgcn_cvt_pk_fp8_f32(a[4], a[5], w1, false); w1 = __builtin_amdgcn_cvt_pk_fp8_f32(a[6], a[7], w1, true); w.x = (unsigned)w0; w.y = (unsigned)w1; }
                    *(u32x2*)(ACT8 + p * 1024 + 128 * u.pn + cl) = w; } }
    }
};
struct EpiDown8 {
    static constexpr bool PERM = true;
    const float* GW; const float* BD; unsigned char* Y;
    __device__ __forceinline__ void operator()(const f32x4 (&acc)[2][2][4][2], const Unit& u, int wr, int wc, int fr, int fq) const {
        const int col0 = u.pn * BM + 32 * wc + 8 * fq; const float* bp = BD + (size_t)u.e * 1024 + col0;
        f32x4 bv[2][2];
#pragma unroll
        for (int bj = 0; bj < 2; ++bj)
#pragma unroll
            for (int n = 0; n < 2; ++n) bv[bj][n] = *(const f32x4*)(bp + bj * HALF + 4 * n);
        constexpr float inv = 1.0f / (F8_SW * F8_SA);
        float gwv[2][4];
#pragma unroll
        for (int ai = 0; ai < 2; ++ai)
#pragma unroll
            for (int m = 0; m < 4; ++m) { const int r = ai * HALF + wr * 64 + m * 16 + fr; gwv[ai][m] = GW[(size_t)u.pm + min(r, u.rows - 1)]; }
        asm volatile("" ::: "memory");
#pragma unroll
        for (int ai = 0; ai < 2; ++ai)
#pragma unroll
            for (int m = 0; m < 4; ++m) { const int r = ai * HALF + wr * 64 + m * 16 + fr;
                if (r < u.rows) { const size_t p = (size_t)u.pm + r; const float gw = gwv[ai][m];
#pragma unroll
                    for (int bj = 0; bj < 2; ++bj) { const f32x4 v0 = (acc[ai][bj][m][0] * inv + bv[bj][0]) * (gw * F8_SY), v1 = (acc[ai][bj][m][1] * inv + bv[bj][1]) * (gw * F8_SY);
                        u32x2 w; w.x = pk4_fp8(v0[0], v0[1], v0[2], v0[3]); w.y = pk4_fp8(v1[0], v1[1], v1[2], v1[3]);
                        *(u32x2*)(Y + p * 1024 + col0 + bj * HALF) = w; } } }
    }
};
}


__device__ __forceinline__ unsigned pk2(float lo, float hi) { return (unsigned)f2bf(lo) | ((unsigned)f2bf(hi) << 16); }
#define SINK_U(x) asm volatile("" :: "v"(x))
template <bool DRY>
__device__ __forceinline__ void hgrn2_pass_b(int gthread, float* UB, const float* DECB) {
    constexpr int NBH = 64 / HG_NB;
    const int bh = gthread >> 12, rem = gthread & 4095, dv = rem >> 5, dkg = rem & 31;
    f32x4 S = (f32x4){0.f, 0.f, 0.f, 0.f};
    float* p = UB + (size_t)bh * NBH * 16384 + dv * 128 + dkg * 4;
    const float* dp = DECB + (size_t)bh * NBH * 128 + dkg * 4;
    f32x4 u[NBH], d4[NBH];
#pragma unroll
    for (int k = 0; k < NBH; ++k) { u[k] = *(const f32x4*)(p + (size_t)k * 16384); d4[k] = *(const f32x4*)(dp + k * 128); }
#pragma unroll
    for (int k = 0; k < NBH; ++k) { if (!DRY) *(f32x4*)(p + (size_t)k * 16384) = S; else SINK_U(S[0]); S = d4[k] * S + u[k]; }
}

typedef short v4i16_t __attribute__((ext_vector_type(4)));
__device__ __forceinline__ u32x2 vtr64(const LAS unsigned char* p) { return __builtin_bit_cast(u32x2, __builtin_amdgcn_ds_read_tr16_b64_v4i16((LAS v4i16_t*)p)); }
template <bool DRY>
__device__ __forceinline__ void hgrn2_pass_c_phase(LAS unsigned char* lds, int bx, int G, bf16_t* QI, const bf16_t* KI, const bf16_t* Vs, const bf16_t* Gs, const float* SP, const float* gn_w, bf16_t* OA, const float* DEC) {
    constexpr int P = 272, L_Q = 0, L_K = 17408, L_V = 34816, L_G = 52224, L_S = 69632, L_SS = 104448, NCH = BATCH * NH * 64;
    const int tid = threadIdx.x, lane = tid & 63, w = __builtin_amdgcn_readfirstlane(tid >> 6);
    const int it = w >> 1, hv = w & 1, cc = lane & 15, q = lane >> 4;
    const int lrow = tid >> 4, lch = tid & 15;
    u32x4 rq[2], rk[2], rv[2], rg[2];
    f32x4 Sreg[8];
#define PC_LOAD(cid_) do { const int _bh = (cid_) >> 6, _n = (cid_) & 63, _b = _bh >> 3, _h = _bh & 7; \
        const size_t _e = ((size_t)_b * SEQ + (size_t)_n * 64 + lrow) * 1024 + _h * 128 + lch * 8; \
        _Pragma("unroll") for (int _j = 0; _j < 2; ++_j) { rq[_j] = *(const u32x4*)(QI + _e + (size_t)_j * 32 * 1024); rk[_j] = *(const u32x4*)(KI + _e + (size_t)_j * 32 * 1024); \
            rv[_j] = *(const u32x4*)(Vs + _e + (size_t)_j * 32 * 1024); rg[_j] = *(const u32x4*)(Gs + _e + (size_t)_j * 32 * 1024); } \
        } while (0)
    constexpr int NBLK = NCH / HG_NB;
#define PC_CID(li_) (HG_NB * (bx + ((li_) / HG_NB) * G) + ((li_) % HG_NB))
#define PC_OK(li_) (bx + ((li_) / HG_NB) * G < NBLK)
    int li = 0;
    if (PC_OK(0)) PC_LOAD(PC_CID(0));
    for (; PC_OK(li); ++li) {
        const int cid = PC_CID(li);
        __syncthreads();
#pragma unroll
        for (int j = 0; j < 2; ++j) { const int o = (lrow + 32 * j) * P + lch * 16;
            *(LAS u32x4*)(lds + L_Q + o) = rq[j]; *(LAS u32x4*)(lds + L_K + o) = rk[j]; *(LAS u32x4*)(lds + L_V + o) = rv[j]; *(LAS u32x4*)(lds + L_G + o) = rg[j]; }
        if (cid % HG_NB == 0) {
            const float* eb = SP + (size_t)(cid / HG_NB) * 16384;
#pragma unroll
            for (int j = 0; j < 8; ++j)
#pragma unroll
                for (int r = 0; r < 4; ++r) Sreg[j][r] = eb[(16 * w + 4 * q + r) * 128 + 16 * j + cc];
#pragma unroll
            for (int j = 0; j < 8; ++j)
#pragma unroll
                for (int r = 0; r < 4; ++r) *(LAS bf16_t*)(lds + L_S + (16 * w + 4 * q + r) * P + (16 * j + cc) * 2) = f2bf(Sreg[j][r]);
        }
        if (PC_OK(li + 1)) PC_LOAD(PC_CID(li + 1));
        __syncthreads();
        const int bh = cid >> 6, n = cid & 63, b = bh >> 3, h = bh & 7;
        const size_t t0 = (size_t)b * SEQ + (size_t)n * 64;
        bf16x8 qf[4];
#pragma unroll
        for (int ks = 0; ks < 4; ++ks) qf[ks] = *(const LAS bf16x8*)(lds + L_Q + (16 * it + cc) * P + (32 * ks + 8 * q) * 2);
        f32x4 sT[4];
#pragma unroll
        for (int jt = 0; jt < 4; ++jt) {
            sT[jt] = (f32x4){0.f, 0.f, 0.f, 0.f};
            if (jt <= it) {
#pragma unroll
                for (int ks = 0; ks < 4; ++ks) { const bf16x8 kf = *(const LAS bf16x8*)(lds + L_K + (16 * jt + cc) * P + (32 * ks + 8 * q) * 2); sT[jt] = __builtin_amdgcn_mfma_f32_16x16x32_bf16(kf, qf[ks], sT[jt], 0, 0, 0); }
                if (jt == it) {
#pragma unroll
                    for (int r = 0; r < 4; ++r) if (4 * q + r > cc) sT[jt][r] = 0.f;
                }
            }
        }
        bf16x8 pf[2];
#pragma unroll
        for (int s2 = 0; s2 < 2; ++s2) { u32x4 pw; pw.x = pk2(sT[2 * s2][0], sT[2 * s2][1]); pw.y = pk2(sT[2 * s2][2], sT[2 * s2][3]); pw.z = pk2(sT[2 * s2 + 1][0], sT[2 * s2 + 1][1]); pw.w = pk2(sT[2 * s2 + 1][2], sT[2 * s2 + 1][3]); pf[s2] = __builtin_bit_cast(bf16x8, pw); }
        f32x4 acc[4];
#pragma unroll
        for (int dt = 0; dt < 4; ++dt) acc[dt] = (f32x4){0.f, 0.f, 0.f, 0.f};
#pragma unroll
        for (int dt = 0; dt < 4; ++dt) {
            const int dvt = 4 * hv + dt, dv = 16 * dvt + cc;
#pragma unroll
            for (int s2 = 0; s2 < 2; ++s2) {
                if (2 * s2 <= it) {
                    const LAS unsigned char* vp = lds + L_V + (32 * s2 + 4 * q + (cc >> 2)) * P + (16 * dvt + 4 * (cc & 3)) * 2;
                    const u32x2 lo = vtr64(vp), hi2 = vtr64(vp + 16 * P);
                    const bf16x8 vf = __builtin_bit_cast(bf16x8, (u32x4){lo.x, lo.y, hi2.x, hi2.y});
                    acc[dt] = __builtin_amdgcn_mfma_f32_16x16x32_bf16(vf, pf[s2], acc[dt], 0, 0, 0);
                }
            }
#pragma unroll
            for (int ks = 0; ks < 4; ++ks) { const bf16x8 sf = *(const LAS bf16x8*)(lds + L_S + dv * P + (32 * ks + 8 * q) * 2); acc[dt] = __builtin_amdgcn_mfma_f32_16x16x32_bf16(sf, qf[ks], acc[dt], 0, 0, 0); }
        }
        float ss = 0.f;
#pragma unroll
        for (int dt = 0; dt < 4; ++dt) ss += (acc[dt][0] * acc[dt][0] + acc[dt][1] * acc[dt][1]) + (acc[dt][2] * acc[dt][2] + acc[dt][3] * acc[dt][3]);
        ss += __shfl_xor(ss, 16); ss += __shfl_xor(ss, 32);
        LAS float* SS = (LAS float*)(lds + L_SS);
        if (q == 0) SS[(16 * it + cc) * 2 + hv] = ss;
        __syncthreads();
        const float rstd = rsqrtf((SS[(16 * it + cc) * 2] + SS[(16 * it + cc) * 2 + 1]) * (1.0f / DV) + EPS);
#pragma unroll
        for (int dt = 0; dt < 4; ++dt) {
            const int dv0 = 16 * (4 * hv + dt) + 4 * q; const size_t e = (t0 + 16 * it + cc) * 1024 + h * 128 + dv0;
            const u32x2 gw2 = *(const LAS u32x2*)(lds + L_G + (16 * it + cc) * P + dv0 * 2); const f32x4 gn = *(const f32x4*)(gn_w + h * 128 + dv0);
            const float g0 = __uint_as_float(gw2.x << 16), g1 = __uint_as_float(gw2.x & 0xffff0000u), g2 = __uint_as_float(gw2.y << 16), g3 = __uint_as_float(gw2.y & 0xffff0000u);
            u32x2 o; o.x = pk2(acc[dt][0] * rstd * gn[0] * siluf_(g0), acc[dt][1] * rstd * gn[1] * siluf_(g1)); o.y = pk2(acc[dt][2] * rstd * gn[2] * siluf_(g2), acc[dt][3] * rstd * gn[3] * siluf_(g3));
            if (!DRY) *(u32x2*)(OA + e) = o; else { SINK_U(o.x); SINK_U(o.y); }
        }
        if (cid % HG_NB != HG_NB - 1) {
            f32x4 a2[8];
#pragma unroll
            for (int j = 0; j < 8; ++j) a2[j] = (f32x4){0.f, 0.f, 0.f, 0.f};
#pragma unroll
            for (int ks = 0; ks < 2; ++ks) {
                const LAS unsigned char* ap = lds + L_V + (32 * ks + 8 * q + (cc >> 2)) * P + (16 * w + 4 * (cc & 3)) * 2;
                const u32x2 alo = vtr64(ap), ahi = vtr64(ap + 4 * P);
                const bf16x8 av = __builtin_bit_cast(bf16x8, (u32x4){alo.x, alo.y, ahi.x, ahi.y});
#pragma unroll
                for (int j = 0; j < 8; ++j) { const LAS unsigned char* bp = lds + L_K + (32 * ks + 8 * q + (cc >> 2)) * P + (16 * j + 4 * (cc & 3)) * 2;
                    const u32x2 blo = vtr64(bp), bhi = vtr64(bp + 4 * P);
                    a2[j] = __builtin_amdgcn_mfma_f32_16x16x32_bf16(av, __builtin_bit_cast(bf16x8, (u32x4){blo.x, blo.y, bhi.x, bhi.y}), a2[j], 0, 0, 0); }
            }
            const float* dc = DEC + (size_t)cid * 128;
#pragma unroll
            for (int j = 0; j < 8; ++j) { const float dj = dc[16 * j + cc];
#pragma unroll
                for (int r = 0; r < 4; ++r) { Sreg[j][r] = dj * (Sreg[j][r] + a2[j][r]); *(LAS bf16_t*)(lds + L_S + (16 * w + 4 * q + r) * P + (16 * j + cc) * 2) = f2bf(Sreg[j][r]); } }
        }
    }
    __syncthreads();
#undef PC_LOAD
#undef PC_CID
#undef PC_OK
}

template <bool DRY>
__device__ __forceinline__ void hgrn2_pass_a_phase(LAS unsigned char* lds, int bx, int G, bf16_t* Qs, bf16_t* Fs, const bf16_t* Vs, const float* LBV, float* UB, float* DEC, float* DECB) {
    constexpr int P = 272, L_Q = 0, L_F = 17408, L_V = 34816, L_KD = 52224, L_SEG = 69632, NCH = BATCH * NH * 64;
    const int tid = threadIdx.x, lane = tid & 63, w = __builtin_amdgcn_readfirstlane(tid >> 6), d = tid & 127, sg = tid >> 7;
    const int cc = lane & 15, q = lane >> 4, lrow = tid >> 4, lch = tid & 15;
    LAS float* SEGSUM = (LAS float*)(lds + L_SEG);
    u32x4 rq[2], rf[2], rv[2];
#define PA_LOAD(cid_) do { const int _bh = (cid_) >> 6, _n = (cid_) & 63, _b = _bh >> 3, _h = _bh & 7; \
        const size_t _e = ((size_t)_b * SEQ + (size_t)_n * 64 + lrow) * 1024 + _h * 128 + lch * 8; \
        _Pragma("unroll") for (int _j = 0; _j < 2; ++_j) { rq[_j] = *(const u32x4*)(Qs + _e + (size_t)_j * 32 * 1024); rf[_j] = *(const u32x4*)(Fs + _e + (size_t)_j * 32 * 1024); rv[_j] = *(const u32x4*)(Vs + _e + (size_t)_j * 32 * 1024); } } while (0)
    constexpr int NBLK = NCH / HG_NB;
    LAS float* ETOT = (LAS float*)(lds + L_SEG + 2048);
#define PA_CID(li_) (HG_NB * (bx + ((li_) / HG_NB) * G) + ((li_) % HG_NB))
#define PA_OK(li_) (bx + ((li_) / HG_NB) * G < NBLK)
    int li = 0; float prev_etot = 1.f;
    f32x4 acc[8];
    if (PA_OK(0)) PA_LOAD(PA_CID(0));
    for (; PA_OK(li); ++li) {
        const int cid = PA_CID(li);
        __syncthreads();
#pragma unroll
        for (int j = 0; j < 2; ++j) { const int o = (lrow + 32 * j) * P + lch * 16; *(LAS u32x4*)(lds + L_Q + o) = rq[j]; *(LAS u32x4*)(lds + L_F + o) = rf[j]; *(LAS u32x4*)(lds + L_V + o) = rv[j]; }
        if (PA_OK(li + 1)) PA_LOAD(PA_CID(li + 1));
        __syncthreads();
        const int bh = cid >> 6, n = cid & 63, b = bh >> 3, h = bh & 7;
        const size_t t0 = (size_t)b * SEQ + (size_t)n * 64;
        const float lb = LBV[h * 128 + d];
        float kk[16], cum[16], qs[16]; float c = 1.f;
#pragma unroll
        for (int i = 0; i < 16; ++i) {
            const float fl = bf2f(*(const LAS bf16_t*)(lds + L_F + (16 * sg + i) * P + 2 * d)); qs[i] = siluf_(bf2f(*(const LAS bf16_t*)(lds + L_Q + (16 * sg + i) * P + 2 * d)));
            const float f = lb + (1.0f - lb) * sigmoidf_(fl);
            kk[i] = 1.0f - f; c *= f; cum[i] = c;
        }
        SEGSUM[sg * 128 + d] = c;
        __syncthreads();
        float eoffs = 1.f, etot = 1.f;
#pragma unroll
        for (int s2 = 0; s2 < 4; ++s2) { const float v = SEGSUM[s2 * 128 + d]; etot *= v; if (s2 < sg) eoffs *= v; }
#pragma unroll
        for (int i = 0; i < 16; i += 2) {
            const float ex0 = eoffs * cum[i], ex1 = eoffs * cum[i + 1];
            const float ki0 = kk[i] * __builtin_amdgcn_rcpf(ex0), ki1 = kk[i + 1] * __builtin_amdgcn_rcpf(ex1);
            const unsigned wq = pg8::cvt_pk_bf16(qs[i] * ex0, qs[i + 1] * ex1), wk = pg8::cvt_pk_bf16(ki0, ki1), wd = pg8::cvt_pk_bf16(ki0 * etot, ki1 * etot);
            *(LAS bf16_t*)(lds + L_Q + (16 * sg + i) * P + 2 * d) = (bf16_t)(wq & 0xffffu); *(LAS bf16_t*)(lds + L_Q + (16 * sg + i + 1) * P + 2 * d) = (bf16_t)(wq >> 16);
            *(LAS bf16_t*)(lds + L_F + (16 * sg + i) * P + 2 * d) = (bf16_t)(wk & 0xffffu); *(LAS bf16_t*)(lds + L_F + (16 * sg + i + 1) * P + 2 * d) = (bf16_t)(wk >> 16);
            *(LAS bf16_t*)(lds + L_KD + (16 * sg + i) * P + 2 * d) = (bf16_t)(wd & 0xffffu); *(LAS bf16_t*)(lds + L_KD + (16 * sg + i + 1) * P + 2 * d) = (bf16_t)(wd >> 16);
        }
        if (sg == 0) { ETOT[d] = etot; prev_etot = (cid % HG_NB == 0) ? etot : prev_etot * etot; if (!DRY) { DEC[(size_t)cid * 128 + d] = etot; if (cid % HG_NB == HG_NB - 1) DECB[(size_t)(cid / HG_NB) * 128 + d] = prev_etot; } }
        __syncthreads();
#pragma unroll
        for (int j = 0; j < 2; ++j) { const int o = (lrow + 32 * j) * P + lch * 16; const size_t e = (t0 + lrow + 32 * j) * 1024 + h * 128 + lch * 8;
            const u32x4 a = *(const LAS u32x4*)(lds + L_Q + o), b2 = *(const LAS u32x4*)(lds + L_F + o);
            if (!DRY) { *(u32x4*)(Qs + e) = a; *(u32x4*)(Fs + e) = b2; } else { SINK_U(a.x); SINK_U(b2.x); } }
        if (cid % HG_NB == 0) {
#pragma unroll
            for (int j = 0; j < 8; ++j) acc[j] = (f32x4){0.f, 0.f, 0.f, 0.f};
        } else { const f32x4 e4 = *(const LAS f32x4*)(ETOT + 16 * w + 4 * q);
#pragma unroll
            for (int j = 0; j < 8; ++j) acc[j] = acc[j] * e4; }
#pragma unroll
        for (int ks = 0; ks < 2; ++ks) {
            const LAS unsigned char* ap = lds + L_KD + (32 * ks + 8 * q + (cc >> 2)) * P + (16 * w + 4 * (cc & 3)) * 2;
            const u32x2 alo = vtr64(ap), ahi = vtr64(ap + 4 * P);
            const bf16x8 a = __builtin_bit_cast(bf16x8, (u32x4){alo.x, alo.y, ahi.x, ahi.y});
#pragma unroll
            for (int j = 0; j < 8; ++j) { const LAS unsigned char* bp = lds + L_V + (32 * ks + 8 * q + (cc >> 2)) * P + (16 * j + 4 * (cc & 3)) * 2;
                const u32x2 blo = vtr64(bp), bhi = vtr64(bp + 4 * P);
                acc[j] = __builtin_amdgcn_mfma_f32_16x16x32_bf16(a, __builtin_bit_cast(bf16x8, (u32x4){blo.x, blo.y, bhi.x, bhi.y}), acc[j], 0, 0, 0); }
        }
        if (cid % HG_NB == HG_NB - 1) { float* ut = UB + (size_t)(cid / HG_NB) * 16384;
#pragma unroll
            for (int j = 0; j < 8; ++j) { if (!DRY) *(f32x4*)(ut + (16 * j + cc) * 128 + 16 * w + 4 * q) = acc[j]; else { SINK_U(acc[j][0]); SINK_U(acc[j][3]); } } }
    }
    __syncthreads();
#undef PA_LOAD
#undef PA_CID
#undef PA_OK
}

__device__ __forceinline__ float gelu_fast(float x) { const float u = 0.7978845608028654f * (x + 0.044715f * x * x * x); return x * sigmoidf_(2.0f * u); }
template <bool DRY>
__device__ __forceinline__ void lru_s3(int b, int npair, const bf16_t* LA, const bf16_t* UU, const float* LP, const float* LH, bf16_t* GATE_OB) {
    const int tid = threadIdx.x, half = tid >> 8, c0 = 4 * (tid & 255); const int n = half ? 63 - npair : npair;
    const size_t e0 = ((size_t)b * SEQ + (size_t)n * 64) * 1024 + c0;
    float h[4] = {0.f, 0.f, 0.f, 0.f};
    {
        const size_t o = ((size_t)b * 64) * 1024 + c0;
        for (int m0 = 0; m0 < n; m0 += 8) {
            f32x4 p[8], hh[8];
#pragma unroll
            for (int j = 0; j < 8; ++j) { const int mm = (m0 + j < n) ? m0 + j : 0; p[j] = *(const f32x4*)(LP + o + (size_t)mm * 1024); hh[j] = *(const f32x4*)(LH + o + (size_t)mm * 1024); }
#pragma unroll
            for (int j = 0; j < 8; ++j) if (m0 + j < n) {
#pragma unroll
                for (int k = 0; k < 4; ++k) h[k] = p[j][k] * h[k] + hh[j][k]; }
        }
    }
    for (int t0 = 0; t0 < 64; t0 += 8) {
        u32x2 l[8], u[8], g[8];
#pragma unroll
        for (int j = 0; j < 8; ++j) { const size_t e = e0 + (size_t)(t0 + j) * 1024; l[j] = *(const u32x2*)(LA + e); u[j] = *(const u32x2*)(UU + e); g[j] = *(const u32x2*)(GATE_OB + e); }
#pragma unroll
        for (int j = 0; j < 8; ++j) {
            const unsigned lw[2] = {l[j].x, l[j].y}, uw[2] = {u[j].x, u[j].y}, gw[2] = {g[j].x, g[j].y}; float ov[4];
#pragma unroll
            for (int k = 0; k < 2; ++k) {
                h[2 * k] = __expf(__uint_as_float(lw[k] << 16)) * h[2 * k] + __uint_as_float(uw[k] << 16);
                h[2 * k + 1] = __expf(__uint_as_float(lw[k] & 0xffff0000u)) * h[2 * k + 1] + __uint_as_float(uw[k] & 0xffff0000u);
                ov[2 * k] = h[2 * k] * gelu_fast(__uint_as_float(gw[k] << 16)); ov[2 * k + 1] = h[2 * k + 1] * gelu_fast(__uint_as_float(gw[k] & 0xffff0000u)); }
            u32x2 o; o.x = pk2(ov[0], ov[1]); o.y = pk2(ov[2], ov[3]);
            if (!DRY) *(u32x2*)(GATE_OB + e0 + (size_t)(t0 + j) * 1024) = o; else { SINK_U(o.x); SINK_U(o.y); }
        }
    }
}

constexpr int RING_BYTES = 131072, LDSCTL_OFF = RING_BYTES, MISC_OFF = LDSCTL_OFF + 320, LDS_BYTES = 147456;
constexpr int NWAVES = 8;


constexpr size_t WS_ACT = 224 * MiB, WS_Y = 512 * MiB;
constexpr size_t WS_RSTD = 992 * MiB, WS_TOPE = 993 * MiB, WS_TOPW = 994 * MiB, WS_POS = 995 * MiB, WS_LIST = 996 * MiB, WS_GW = 997 * MiB, WS_RS = 998 * MiB, WS_WGH = 999 * MiB;
constexpr int CW_CNT = 512, CW_CUR = 576;
constexpr int MOE_TP = LDSCTL_OFF + 1024, MOE_OFF = LDSCTL_OFF + 1024 + 256, MOE_HIST = LDSCTL_OFF + 1024 + 512, MOE_BASE = LDSCTL_OFF + 1024 + 768, MOE_LCUR = LDSCTL_OFF + 2048;

struct MArgs { const float* in[23]; float* out; unsigned char* ws; int ph_lo, ph_hi; };


template <class RowMap>
__device__ __forceinline__ void p0_transpose_item(const float* W, int K, int N, bf16_t* WT, const RowMap& rowmap, LAS float* scr, int item, int lane, const float* kscale = nullptr) {
    const int nblk = N / 32, kb = item / nblk, nb = item % nblk, k0 = 64 * kb, n0 = 32 * nb;
    {
        const int kr = lane >> 3, nq = lane & 7; f32x4 v[8];
#pragma unroll
        for (int i = 0; i < 8; ++i) v[i] = *(const f32x4*)(W + (size_t)(k0 + 8 * i + kr) * N + n0 + 4 * nq);
#pragma unroll
        for (int i = 0; i < 8; ++i) { LAS float* d = scr + (8 * i + kr) * 33 + 4 * nq; d[0] = v[i][0]; d[1] = v[i][1]; d[2] = v[i][2]; d[3] = v[i][3]; }
    }
    LDS_WAIT(); asm volatile("" ::: "memory");
    const int c = lane & 7;
    f32x4 k0s = (f32x4){1.f, 1.f, 1.f, 1.f}, k1s = k0s;
    if (kscale) { k0s = *(const f32x4*)(kscale + k0 + 8 * c); k1s = *(const f32x4*)(kscale + k0 + 8 * c + 4); }
#pragma unroll
    for (int j = 0; j < 4; ++j) { const int n = (lane >> 3) + 8 * j; const LAS float* s = scr + (8 * c) * 33 + n;
        u32x4 o; o.x = pk2(s[0 * 33] * k0s[0], s[1 * 33] * k0s[1]); o.y = pk2(s[2 * 33] * k0s[2], s[3 * 33] * k0s[3]); o.z = pk2(s[4 * 33] * k1s[0], s[5 * 33] * k1s[1]); o.w = pk2(s[6 * 33] * k1s[2], s[7 * 33] * k1s[3]);
        *(GAS u32x4*)(WT + (size_t)rowmap(n0 + n) * K + k0 + 8 * c) = o; }
    LDS_WAIT(); asm volatile("" ::: "memory");
}

__device__ __forceinline__ void p0_load8(const float* W, int N, int item, int lane, f32x4 (&v)[8]) {
    const int nblk = N / 32, kb = item / nblk, nb = item % nblk, k0 = 64 * kb, n0 = 32 * nb; const int kr = lane >> 3, nq = lane & 7;
#pragma unroll
    for (int i = 0; i < 8; ++i) v[i] = __builtin_nontemporal_load((const f32x4*)(W + (size_t)(k0 + 8 * i + kr) * N + n0 + 4 * nq));
}
template <class RowMap>
__device__ __forceinline__ void p0_finish8(const f32x4 (&v)[8], int K, int N, unsigned char* WT, const RowMap& rowmap, LAS float* scr, int item, int lane, float scale, const float* kscale) {
    const int nblk = N / 32, kb = item / nblk, nb = item % nblk, k0 = 64 * kb, n0 = 32 * nb; const int kr = lane >> 3, nq = lane & 7;
#pragma unroll
    for (int i = 0; i < 8; ++i) { LAS float* d = scr + (8 * i + kr) * 33 + 4 * nq; d[0] = v[i][0]; d[1] = v[i][1]; d[2] = v[i][2]; d[3] = v[i][3]; }
    LDS_WAIT(); asm volatile("" ::: "memory");
    const int c = lane & 7;
    f32x4 k0s = (f32x4){scale, scale, scale, scale}, k1s = k0s;
    if (kscale) { k0s = *(const f32x4*)(kscale + k0 + 8 * c) * scale; k1s = *(const f32x4*)(kscale + k0 + 8 * c + 4) * scale; }
#pragma unroll
    for (int j = 0; j < 4; ++j) { const int n = (lane >> 3) + 8 * j; const LAS float* s = scr + (8 * c) * 33 + n;
        u32x2 o; o.x = pg8::pk4_fp8(s[0 * 33] * k0s[0], s[1 * 33] * k0s[1], s[2 * 33] * k0s[2], s[3 * 33] * k0s[3]); o.y = pg8::pk4_fp8(s[4 * 33] * k1s[0], s[5 * 33] * k1s[1], s[6 * 33] * k1s[2], s[7 * 33] * k1s[3]);
        *(GAS u32x2*)(WT + (size_t)rowmap(n0 + n) * K + k0 + 8 * c) = o; }
    LDS_WAIT(); asm volatile("" ::: "memory");
}
template <class RowMap>
__device__ __forceinline__ void p0_convert_experts8(const float* W, int K, int N, unsigned char* WT, const RowMap& rowmap, LAS float* scr, int gw, int NGW, int lane, float scale, const float* kscale) {
    const int per = (K / 64) * (N / 32), tot = NE * per; const size_t esz = (size_t)K * N;
    f32x4 va[8], vb[8], vc[8], vd[8]; int it = gw;
#define P0_LD(i_, v_) do { if ((i_) < tot) p0_load8(W + (size_t)((i_) / per) * esz, N, (i_) % per, lane, v_); } while (0)
#define P0_FN(i_, v_) do { if ((i_) < tot) p0_finish8(v_, K, N, WT + (size_t)((i_) / per) * esz, rowmap, scr, (i_) % per, lane, scale, kscale); } while (0)
    P0_LD(it, va); P0_LD(it + NGW, vb); P0_LD(it + 2 * NGW, vc);
    for (; it < tot; it += 4 * NGW) {
        P0_LD(it + 3 * NGW, vd); P0_FN(it, va);
        P0_LD(it + 4 * NGW, va); P0_FN(it + NGW, vb);
        P0_LD(it + 5 * NGW, vb); P0_FN(it + 2 * NGW, vc);
        P0_LD(it + 6 * NGW, vc); P0_FN(it + 3 * NGW, vd);
    }
#undef P0_LD
#undef P0_FN
}
struct MapId { int off; __device__ __forceinline__ int operator()(int n) const { return off + n; } };
struct MapIn { __device__ __forceinline__ int operator()(int n) const { if (n < 6144) return n; const int c = (n - 6144) & 1023, isb = (n - 6144) >> 10; return 6144 + 256 * (c >> 7) + 128 * isb + (c & 127); } };
struct MapRG { int off; __device__ __forceinline__ int operator()(int n) const { return 256 * (n >> 7) + (n & 127) + off; } };
struct MapGU { __device__ __forceinline__ int operator()(int n) const { const int f = n >> 1, half = n & 1; return 256 * (f >> 7) + 128 * half + (f & 127); } };

#ifndef DUP_MASK
#define DUP_MASK 0u
#endif

#define NREP(k) (((DUP_MASK >> (k)) & 1u) ? 2 : 1)
__device__ __forceinline__ int hid_tid() { int t = threadIdx.x; asm volatile("" : "+v"(t)); return t; }
#define PHASE_IDS() const int tid = hid_tid(), lane = tid & 63, wave = __builtin_amdgcn_readfirstlane(tid >> 6); (void)lane; (void)wave
__global__ void __launch_bounds__(512, 2) mega(MArgs args) {
    extern __shared__ __attribute__((aligned(16))) unsigned char lds_raw[];
    LAS unsigned char* lds = (LAS unsigned char*)lds_raw;
    volatile LAS unsigned* MISC = (volatile LAS unsigned*)(lds + MISC_OFF);
    const int G = gridDim.x; const int bx = blockIdx.x; const int vcu = (G % 8 == 0) ? (bx % 8) * (G / 8) + bx / 8 : bx;
    unsigned char* ws = args.ws;
    gu32* ctl = (gu32*)(ws + WS_CTL);
    for (int u = threadIdx.x; u < (LDS_BYTES - LDSCTL_OFF) / 4; u += NWAVES * 64) ((LAS unsigned*)(lds + LDSCTL_OFF))[u] = 0u;
    __syncthreads();
    XcdBarrier bar = xcd_barrier_post((unsigned*)(ctl + CW_BAR), MISC + 8);
    const int lo = args.ph_lo, hi = args.ph_hi;
#define IN(k) (lo <= (k) && (k) < hi)
#define BOTH(k) (IN(k) && IN((k) + 1))
#define GRID_BAR() xcd_barrier(bar)
    const float* x = args.in[0];
    bf16_t* XN = (bf16_t*)(ws + WS_XN); bf16_t* SEG0 = (bf16_t*)(ws + WS_SEG);
    bf16_t* WIN_T = (bf16_t*)(ws + WS_WIN_T);

    if (IN(0)) for (int rep = 0; rep < NREP(0); ++rep) {
        if (rep) __syncthreads();
        PHASE_IDS();
        LAS float* scr = (LAS float*)(lds + wave * 16384);
        const int gw = vcu * NWAVES + wave, NGW = G * NWAVES;
        constexpr int I_IN = (D / 64) * (8192 / 32);
        for (int it = gw; it < I_IN; it += NGW) p0_transpose_item(args.in[2], D, 8192, WIN_T, MapIn{}, scr, it, lane);
        {
            bf16_t* WRG_T = (bf16_t*)(ws + WS_WRG_T); constexpr int I_RG = (256 / 64) * (256 / 32);
            for (int it = gw; it < 8 * I_RG; it += NGW) { const int mat = it / I_RG, r = it % I_RG, hh = mat >> 1, ax = mat & 1;
                p0_transpose_item(args.in[ax ? 9 : 7] + (size_t)hh * 65536, 256, 256, WRG_T + (size_t)hh * 512 * 256, MapRG{ax * 128}, scr, r, lane); }
        }
        {
            constexpr int I_SQ = (D / 64) * (D / 32);
            for (int it = gw; it < 3 * I_SQ; it += NGW) { const int mat = it / I_SQ, r = it % I_SQ;
                p0_transpose_item(args.in[12 + mat], D, D, (bf16_t*)(ws + (mat == 0 ? WS_WPA_T : mat == 1 ? WS_WPB_T : WS_WOUT_T)), MapId{0}, scr, r, lane); }
        }
        {
            constexpr int I_GU = (D / 64) * (2048 / 32), I_DN = (DFF / 64) * (D / 32);
            bf16_t* WGU_T = (bf16_t*)(ws + WS_WGU_T); bf16_t* WDN_T = (bf16_t*)(ws + WS_WDN_T);
#if MOE_FP8
#if !MOE_CONV_IN_P1
            p0_convert_experts8(args.in[18], D, 2048, (unsigned char*)WGU_T, MapGU{}, scr, gw, NGW, lane, pg8::F8_SW, args.in[15]);
            p0_convert_experts8(args.in[20], DFF, D, (unsigned char*)WDN_T, MapId{0}, scr, gw, NGW, lane, pg8::F8_SW, (const float*)nullptr);
#endif
            (void)I_GU; (void)I_DN;
#else
            for (int it = gw; it < NE * I_GU; it += NGW) { const int e = it / I_GU, r = it % I_GU; p0_transpose_item(args.in[18] + (size_t)e * D * 2048, D, 2048, WGU_T + (size_t)e * 2048 * D, MapGU{}, scr, r, lane, args.in[15]); }
            for (int it = gw; it < NE * I_DN; it += NGW) { const int e = it / I_DN, r = it % I_DN; p0_transpose_item(args.in[20] + (size_t)e * DFF * D, DFF, D, WDN_T + (size_t)e * D * DFF, MapId{0}, scr, r, lane); }
#endif
            float* BGUP = (float*)(ws + WS_BGUP); const MapGU mg{};
            for (int i = bx * 512 + tid; i < NE * 2048; i += G * 512) { const int e = i >> 11, n = i & 2047; BGUP[e * 2048 + mg(n)] = args.in[19][i]; }
        }
        const float* nm = args.in[1];
        {
            f32x4 wnm[4];
#pragma unroll
            for (int j = 0; j < 4; ++j) wnm[j] = ((const GAS f32x4*)nm)[lane + 64 * j];
            for (int r2 = 0; r2 < NREP(17); ++r2) for (int m0 = gw; m0 < T; m0 += 4 * NGW) {
                f32x4 v[4][4];
#pragma unroll
                for (int a = 0; a < 4; ++a) { const int m = (m0 + a * NGW < T) ? m0 + a * NGW : m0; const GAS f32x4* xr = (const GAS f32x4*)(x + (size_t)m * D) + lane;
#pragma unroll
                    for (int j = 0; j < 4; ++j) v[a][j] = xr[64 * j]; }
#pragma unroll
                for (int a = 0; a < 4; ++a) { const int m = m0 + a * NGW; float s = 0.f;
#pragma unroll
                    for (int j = 0; j < 4; ++j) s += (v[a][j].x * v[a][j].x + v[a][j].y * v[a][j].y) + (v[a][j].z * v[a][j].z + v[a][j].w * v[a][j].w);
                    const float rstd = rsqrtf(wave_sum(s) * (1.f / D) + EPS);
                    if (m < T) { GAS u32x2* o8 = (GAS u32x2*)(XN + (size_t)m * D) + lane;
#pragma unroll
                        for (int j = 0; j < 4; ++j) { const f32x4 w = wnm[j]; u32x2 o; o.x = pk2(v[a][j].x * rstd * w.x, v[a][j].y * rstd * w.y); o.y = pk2(v[a][j].z * rstd * w.z, v[a][j].w * rstd * w.w); o8[64 * j] = o; } } }
            }
        }
        {
            bf16_t* WRH = (bf16_t*)(ws + WS_WRT); bf16_t* WRL = WRH + 32 * 1024;
            for (int i = bx * 512 + tid; i < 32 * 1024; i += G * 512) { const int e2 = i >> 10, k = i & 1023; const float v = args.in[16][k * NE + e2] * args.in[15][k];
                const bf16_t hb = f2bf(v); WRH[i] = hb; WRL[i] = f2bf(v - bf2f(hb)); }
        }
        if (bx == 0) {
            float* LBV = (float*)(ws + WS_LBV); float* LOGSIG = (float*)(ws + WS_LOGSIG);
            for (int i = tid; i < 1024; i += 512) {
                const float a0 = args.in[3][i], a1 = args.in[3][1024 + i]; const float mm = fmaxf(a0, a1); const float e0 = __expf(a0 - mm), e1 = __expf(a1 - mm);
                LBV[i] = e0 / (e0 + e1);
                const float L = args.in[11][i]; LOGSIG[i] = fminf(L, 0.f) - log1pf(__expf(-fabsf(L)));
            }
        }
        if (BOTH(0) && rep == NREP(0) - 1) { GRID_BAR();
#if defined(EXTRA_BARS)
            for (int eb = 0; eb < EXTRA_BARS; ++eb) GRID_BAR();
#endif
        }
    }
    if (IN(1)) {
        pg8::DenseOrder S; S.init(XN, (size_t)D * 2, WIN_T, (size_t)D * 2, T, 8192, G, bx);
        pg8::EpiSeg E{SEG0};
#if MOE_CONV_IN_P1
        {   PHASE_IDS();
            const int ksplit = (bx >> 3) & 15;
            S.i0 = 0; S.i1 = ksplit;
            pg8::gemm_phase<pg8::EpiSeg, pg8::DenseOrder, false>(lds, D, D, S, E);
            {   LAS float* scr = (LAS float*)(lds + wave * 16384); const int gw = vcu * NWAVES + wave, NGW = G * NWAVES;
                p0_convert_experts8(args.in[18], D, 2048, ws + WS_WGU_T, MapGU{}, scr, gw, NGW, lane, pg8::F8_SW, args.in[15]);
                p0_convert_experts8(args.in[20], DFF, D, ws + WS_WDN_T, MapId{0}, scr, gw, NGW, lane, pg8::F8_SW, (const float*)nullptr); }
            __syncthreads();
            S.i0 = ksplit; S.i1 = 1 << 30;
            pg8::gemm_phase<pg8::EpiSeg, pg8::DenseOrder, false>(lds, D, D, S, E); }
#else
        for (int rep = 0; rep < NREP(1); ++rep) pg8::gemm_phase<pg8::EpiSeg, pg8::DenseOrder, false>(lds, D, D, S, E);
#endif
        if (BOTH(1)) GRID_BAR();
    }
    bf16_t* SQ = SEG0; bf16_t* SF = SEG0 + (size_t)T * 1024; bf16_t* SV = SEG0 + (size_t)2 * T * 1024; bf16_t* SG = SEG0 + (size_t)3 * T * 1024;
    bf16_t* USP = (bf16_t*)(ws + WS_USP); float* DEC = (float*)(ws + WS_DEC);
    bf16_t* SXB = SEG0 + (size_t)4 * T * 1024; bf16_t* SGATE = SEG0 + (size_t)5 * T * 1024; bf16_t* XCb = (bf16_t*)(ws + WS_XC); bf16_t* UUb = (bf16_t*)(ws + WS_UU);
    if (IN(2)) {
        PHASE_IDS();
        if (NREP(13) == 2) hgrn2_pass_a_phase<true>(lds, bx, G, SQ, SF, SV, (const float*)(ws + WS_LBV), (float*)USP, DEC, (float*)(ws + WS_DECB));
        hgrn2_pass_a_phase<false>(lds, bx, G, SQ, SF, SV, (const float*)(ws + WS_LBV), (float*)USP, DEC, (float*)(ws + WS_DECB));
        for (int rep = 0; rep < NREP(2); ++rep) {
            const int cg = tid & 127, c0 = cg * 8; const float* cw = args.in[5]; const float* cbv = args.in[6];
            float w[4][8], bb[8];
#pragma unroll
            for (int k = 0; k < 4; ++k)
#pragma unroll
                for (int j = 0; j < 8; ++j) w[k][j] = cw[k * 1024 + c0 + j];
#pragma unroll
            for (int j = 0; j < 8; ++j) bb[j] = cbv[c0 + j];
            for (int rb = bx * 4 + (tid >> 7); rb < T / 8; rb += G * 4) {
                const int t0 = rb * 8; const bool first = (t0 & (SEQ - 1)) == 0;
                u32x4 xr[11];
#pragma unroll
                for (int i = 0; i < 11; ++i) { const int tt = t0 - 3 + i; xr[i] = (i < 3 && first) ? (u32x4){0u, 0u, 0u, 0u} : *(const u32x4*)(SXB + (size_t)tt * 1024 + c0); }
#pragma unroll
                for (int r = 0; r < 8; ++r) {
                    float a[8];
#pragma unroll
                    for (int j = 0; j < 8; ++j) a[j] = bb[j];
#pragma unroll
                    for (int k = 0; k < 4; ++k) { const unsigned xu[4] = {xr[r + k].x, xr[r + k].y, xr[r + k].z, xr[r + k].w};
#pragma unroll
                        for (int j = 0; j < 4; ++j) { a[2 * j] += __uint_as_float(xu[j] << 16) * w[k][2 * j]; a[2 * j + 1] += __uint_as_float(xu[j] & 0xffff0000u) * w[k][2 * j + 1]; } }
                    u32x4 o; o.x = pk2(a[0], a[1]); o.y = pk2(a[2], a[3]); o.z = pk2(a[4], a[5]); o.w = pk2(a[6], a[7]);
                    *(u32x4*)(XCb + (size_t)(t0 + r) * 1024 + c0) = o;
                }
            }
        }
        if (BOTH(2)) GRID_BAR();
    }
    if (IN(3)) {
        PHASE_IDS();
        if (NREP(14) == 2) for (int gt = bx * 512 + tid; gt < BATCH * NH * 4096; gt += G * 512) hgrn2_pass_b<true>(gt, (float*)USP, (const float*)(ws + WS_DECB));
        for (int gt = bx * 512 + tid; gt < BATCH * NH * 4096; gt += G * 512) hgrn2_pass_b<false>(gt, (float*)USP, (const float*)(ws + WS_DECB));
        {
            pg8::GateOrder S{(const char*)XCb, (const char*)(ws + WS_WRG_T), G, bx};
            pg8::EpiGates E{XCb, args.in[8], args.in[10], (const float*)(ws + WS_LOGSIG), SXB, UUb, (float*)(ws + WS_LRUP), (float*)(ws + WS_LRUH)};
            for (int rep = 0; rep < NREP(3); ++rep) pg8::gemm_phase<pg8::EpiGates, pg8::GateOrder, false>(lds, 256, 1024, S, E);
        }
        if (BOTH(3)) GRID_BAR();
    }
    if (IN(4)) {
        if (NREP(15) == 2) hgrn2_pass_c_phase<true>(lds, bx, G, SQ, SF, SV, SG, (const float*)USP, args.in[4], SQ, DEC);
        hgrn2_pass_c_phase<false>(lds, bx, G, SQ, SF, SV, SG, (const float*)USP, args.in[4], SQ, DEC);
        for (int u = bx; u < BATCH * 32; u += G) { const int b = u >> 5, n = u & 31;
            if (NREP(16) == 2) lru_s3<true>(b, n, SXB, UUb, (const float*)(ws + WS_LRUP), (const float*)(ws + WS_LRUH), SGATE);
            lru_s3<false>(b, n, SXB, UUb, (const float*)(ws + WS_LRUP), (const float*)(ws + WS_LRUH), SGATE); }
        if (IN(4) && IN(6)) GRID_BAR();
    }
    bf16_t* MGb = SF; bf16_t* X1Wb = (bf16_t*)(ws + WS_X1W);
    if (IN(6)) {
        {
            pg8::DenseOrder S; S.init(SQ, (size_t)D * 2, ws + WS_WPA_T, (size_t)D * 2, T, D, G, bx);
            pg8::EpiMerge E{SEG0 + (size_t)7 * T * 1024, MGb};
            pg8::MidMerge MD{(size_t)((const char*)SGATE - (const char*)SQ) - 16 * 128, (size_t)(WS_WPB_T - WS_WPA_T) - 16 * 128, SEG0 + (size_t)6 * T * 1024};
            for (int rep = 0; rep < NREP(6); ++rep) pg8::gemm_phase<pg8::EpiMerge, pg8::DenseOrder, false, pg8::MidMerge>(lds, 2 * D, D, S, E, D, MD); }
        if (BOTH(6)) GRID_BAR();
    }
    if (IN(7)) {
        pg8::DenseOrder S; S.init(MGb, (size_t)D * 2, ws + WS_WOUT_T, (size_t)D * 2, T, D, G, bx);
        pg8::EpiOut2 E{x, X1Wb, MOE_FP8 ? (unsigned char*)(ws + WS_X1) : (unsigned char*)nullptr};
        for (int rep = 0; rep < NREP(7); ++rep) pg8::gemm_phase<pg8::EpiOut2, pg8::DenseOrder, false>(lds, D, D, S, E);
        if (BOTH(7)) GRID_BAR();
    }
    float* RSTD = (float*)(ws + WS_RSTD); int* TOPE = (int*)(ws + WS_TOPE); float* TOPW = (float*)(ws + WS_TOPW); int* POS = (int*)(ws + WS_POS);
    int* LIST = (int*)(ws + WS_LIST); float* GWs = (float*)(ws + WS_GW); float* RSs = (float*)(ws + WS_RS); int* WGH = (int*)(ws + WS_WGH);
    bf16_t* ACTb = (bf16_t*)(ws + WS_ACT); bf16_t* Yb = (bf16_t*)(ws + WS_Y);
    LAS int* m_tp = (LAS int*)(lds + MOE_TP); LAS int* m_off = (LAS int*)(lds + MOE_OFF); LAS int* m_hist = (LAS int*)(lds + MOE_HIST); LAS int* m_base = (LAS int*)(lds + MOE_BASE); LAS int* m_lcur = (LAS int*)(lds + MOE_LCUR);
    if (IN(8)) {
        PHASE_IDS();
        constexpr int WP = 1040;
        LAS unsigned char* Lhi = lds; LAS unsigned char* Llo = lds + 32 * WP;
        LAS float* lgt = (LAS float*)(lds + 2 * 32 * WP);
        LAS float* rss_s = lgt + 128 * 32;
        const bf16_t* WRH = (const bf16_t*)(ws + WS_WRT); const bf16_t* WRL = WRH + 32 * 1024;
        const float* br = args.in[17];
        const int cc = lane & 15, q = lane >> 4, e = lane & 31, sub = lane >> 5;
        if (tid < 32) m_hist[tid] = 0;
        for (int tb = bx * 128; tb < T; tb += G * 128) {
            const int tok0 = tb + 16 * wave;
            f32x4 acc[2] = {(f32x4){0.f, 0.f, 0.f, 0.f}, (f32x4){0.f, 0.f, 0.f, 0.f}};
            float ssq = 0.f;
            for (int hh = 0; hh < 2; ++hh) {
                __syncthreads();
#pragma unroll
                for (int j = 0; j < 4; ++j) { const int vi = tid + 512 * j, r = vi >> 6, ch = vi & 63;
                    *(LAS u32x4*)(Lhi + r * WP + ch * 16) = *(const u32x4*)(WRH + r * 1024 + 512 * hh + ch * 8);
                    *(LAS u32x4*)(Llo + r * WP + ch * 16) = *(const u32x4*)(WRL + r * 1024 + 512 * hh + ch * 8); }
                __syncthreads();
                const bf16_t* xa = X1Wb + (size_t)(tok0 + cc) * D + 512 * hh + 8 * q;
#pragma unroll 8
                for (int ks = 0; ks < 16; ++ks) {
                    const u32x4 aw = *(const u32x4*)(xa + 32 * ks); const bf16x8 af = __builtin_bit_cast(bf16x8, aw);
                    { float f[8]; pg8::unpack8(aw, f);
#pragma unroll
                      for (int j = 0; j < 8; ++j) ssq += f[j] * f[j]; }
#pragma unroll
                    for (int tl = 0; tl < 2; ++tl) {
                        const bf16x8 bh = *(const LAS bf16x8*)(Lhi + (16 * tl + cc) * WP + (32 * ks + 8 * q) * 2), bl = *(const LAS bf16x8*)(Llo + (16 * tl + cc) * WP + (32 * ks + 8 * q) * 2);
                        acc[tl] = __builtin_amdgcn_mfma_f32_16x16x32_bf16(af, bh, acc[tl], 0, 0, 0);
                        acc[tl] = __builtin_amdgcn_mfma_f32_16x16x32_bf16(af, bl, acc[tl], 0, 0, 0);
                    }
                }
            }
            ssq += __shfl_xor(ssq, 16); ssq += __shfl_xor(ssq, 32);
            if (q == 0) rss_s[16 * wave + cc] = ssq;
#pragma unroll
            for (int tl = 0; tl < 2; ++tl)
#pragma unroll
                for (int r = 0; r < 4; ++r) lgt[(16 * wave + 4 * q + r) * 32 + 16 * tl + cc] = acc[tl][r];
            __syncthreads();
            for (int it2 = 0; it2 < 8; ++it2) {
                const int tk = 16 * wave + 2 * it2 + sub; const int t = tb + tk;
                const float rstd = rsqrtf(rss_s[tk] * (1.0f / D) + EPS);
                float cur = lgt[tk * 32 + e] * rstd + br[e];
                float val[4]; int idx[4];
#pragma unroll
                for (int k = 0; k < 4; ++k) { float bv = cur; int bi = e;
#pragma unroll
                    for (int o = 1; o < 32; o <<= 1) { const float ov = __shfl_xor(bv, o); const int oi = __shfl_xor(bi, o); if (ov > bv || (ov == bv && oi < bi)) { bv = ov; bi = oi; } }
                    val[k] = bv; idx[k] = bi; if (e == bi) cur = -INFINITY; }
                float w4[4], den = 0.f;
#pragma unroll
                for (int k = 0; k < 4; ++k) { w4[k] = __expf(val[k] - val[0]); den += w4[k]; }
                const float inv = 1.0f / den;
                if (e < 4) { const int ie = e == 0 ? idx[0] : e == 1 ? idx[1] : e == 2 ? idx[2] : idx[3]; const float we = (e == 0 ? w4[0] : e == 1 ? w4[1] : e == 2 ? w4[2] : w4[3]) * inv;
                    TOPE[(size_t)t * 4 + e] = ie; TOPW[(size_t)t * 4 + e] = we; atomicAdd((int*)(m_hist + ie), 1); }
                if (e == 0) RSTD[t] = rstd;
            }
        }
        __syncthreads();
        if (tid < 32) { const int hc = m_hist[tid]; WGH[bx * 32 + tid] = hc; atomicAdd((unsigned*)(ctl + CW_CNT + tid), (unsigned)hc); }
        if (BOTH(8)) GRID_BAR();
    }
    if (IN(9) || IN(10) || IN(11)) {
        PHASE_IDS();
        if (tid == 0) { int tp = 0, of = 0; for (int j = 0; j < 32; ++j) { const int cn = (int)__hip_atomic_load(ctl + CW_CNT + j, __ATOMIC_RELAXED, __HIP_MEMORY_SCOPE_AGENT); m_tp[j] = tp; m_off[j] = of; tp += (cn + 255) >> 8; of += cn; } m_tp[32] = tp; m_off[32] = of; }
        __syncthreads();
    }
    if (IN(9)) {
        PHASE_IDS();
        if (tid < 32) { m_base[tid] = (int)atomicAdd((unsigned*)(ctl + CW_CUR + tid), (unsigned)WGH[bx * 32 + tid]); m_lcur[tid] = 0; }
        __syncthreads();
        for (int tb = bx * 128; tb < T; tb += G * 128) {
            const int t = tb + 16 * wave + (lane >> 2), k = lane & 3; const int ie = TOPE[(size_t)t * 4 + k];
            const int p = m_off[ie] + m_base[ie] + atomicAdd((int*)(m_lcur + ie), 1);
            LIST[p] = t; GWs[p] = TOPW[(size_t)t * 4 + k]; RSs[p] = RSTD[t]; POS[(size_t)t * 4 + k] = p;
        }
        if (BOTH(9)) GRID_BAR();
    }
    if (IN(10)) {
#if MOE_FP8
        pg8::MoeOrder S{m_tp, m_off, (const char*)(ws + WS_X1), (const char*)(ws + WS_WGU_T), LIST, (size_t)2048 * D, (size_t)256 * D, (size_t)D, 3, G, bx, 1};
        pg8::EpiGU8 E{RSs, (const float*)(ws + WS_BGUP), (unsigned char*)ACTb};
        for (int rep = 0; rep < NREP(10); ++rep) pg8::gemm_phase<pg8::EpiGU8, pg8::MoeOrder, true, pg8::NoMid, true>(lds, D / 2, D / 2, S, E);
#else
        pg8::MoeOrder S{m_tp, m_off, (const char*)X1Wb, (const char*)(ws + WS_WGU_T), LIST, (size_t)2048 * D * 2, (size_t)256 * D * 2, (size_t)D * 2, 3, G, bx, 1};
        pg8::EpiGU2 E{RSs, (const float*)(ws + WS_BGUP), ACTb};
        for (int rep = 0; rep < NREP(10); ++rep) pg8::gemm_phase<pg8::EpiGU2, pg8::MoeOrder, true>(lds, D, D, S, E);
#endif
        if (BOTH(10)) GRID_BAR();
    }
    if (IN(11)) {
#if MOE_FP8
        pg8::MoeOrder S{m_tp, m_off, (const char*)ACTb, (const char*)(ws + WS_WDN_T), LIST, (size_t)D * DFF, (size_t)256 * DFF, (size_t)DFF, 2, G, bx, 0};
        pg8::EpiDown8 E{GWs, args.in[21], (unsigned char*)Yb};
        for (int rep = 0; rep < NREP(11); ++rep) pg8::gemm_phase<pg8::EpiDown8, pg8::MoeOrder, false, pg8::NoMid, true>(lds, DFF / 2, DFF / 2, S, E);
#else
        pg8::MoeOrder S{m_tp, m_off, (const char*)ACTb, (const char*)(ws + WS_WDN_T), LIST, (size_t)D * DFF * 2, (size_t)256 * DFF * 2, (size_t)DFF * 2, 2, G, bx, 0};
        pg8::EpiDown2 E{GWs, args.in[21], Yb};
        for (int rep = 0; rep < NREP(11); ++rep) pg8::gemm_phase<pg8::EpiDown2, pg8::MoeOrder, false>(lds, DFF, DFF, S, E);
#endif
        if (BOTH(11)) GRID_BAR();
    }
    if (IN(12)) {
        PHASE_IDS();
        const float* NFIN = args.in[22]; float* out = args.out;
        for (int rep = 0; rep < NREP(12); ++rep) for (int t = bx * 8 + wave; t < T; t += G * 16) {
            const int tt[2] = {t, t + G * 8 < T ? t + G * 8 : t};
            int4 ps[2]; u32x4 xw[2][2], yw[2][4];
#pragma unroll
            for (int a = 0; a < 2; ++a) ps[a] = *(const int4*)(POS + (size_t)tt[a] * 4);
#pragma unroll
            for (int a = 0; a < 2; ++a) { const u32x4* xr = (const u32x4*)(X1Wb + (size_t)tt[a] * D) + lane * 2; xw[a][0] = xr[0]; xw[a][1] = xr[1]; }
#pragma unroll
            for (int a = 0; a < 2; ++a) { const int pp[4] = {ps[a].x, ps[a].y, ps[a].z, ps[a].w};
#pragma unroll
                for (int k = 0; k < 4; ++k) yw[a][k] = *((const u32x4*)((const unsigned char*)Yb + (size_t)pp[k] * 1024) + lane); }
#pragma unroll
            for (int a = 0; a < 2; ++a) {
                float v[16], f[8];
                pg8::unpack8(xw[a][0], f);
#pragma unroll
                for (int j = 0; j < 8; ++j) v[j] = f[j];
                pg8::unpack8(xw[a][1], f);
#pragma unroll
                for (int j = 0; j < 8; ++j) v[8 + j] = f[j];
#pragma unroll
                for (int k = 0; k < 4; ++k) { const unsigned yv[4] = {yw[a][k].x, yw[a][k].y, yw[a][k].z, yw[a][k].w};
#pragma unroll
                    for (int j = 0; j < 4; ++j) { const f32x2v lo = __builtin_amdgcn_cvt_pk_f32_fp8((int)yv[j], false), hi = __builtin_amdgcn_cvt_pk_f32_fp8((int)yv[j], true);
                        v[4 * j] += lo[0] * (1.0f / pg8::F8_SY); v[4 * j + 1] += lo[1] * (1.0f / pg8::F8_SY); v[4 * j + 2] += hi[0] * (1.0f / pg8::F8_SY); v[4 * j + 3] += hi[1] * (1.0f / pg8::F8_SY); } }
                float ss = 0.f;
#pragma unroll
                for (int j = 0; j < 16; ++j) ss += v[j] * v[j];
                const float rstd = rsqrtf(wave_sum(ss) * (1.0f / D) + EPS);
                if (a == 0 || tt[1] != tt[0]) {
                    f32x4* orow = (f32x4*)(out + (size_t)tt[a] * D) + lane * 4; const f32x4* nw = (const f32x4*)NFIN + lane * 4;
#pragma unroll
                    for (int j = 0; j < 4; ++j) { const f32x4 w = nw[j]; orow[j] = (f32x4){v[4 * j] * rstd * w[0], v[4 * j + 1] * rstd * w[1], v[4 * j + 2] * rstd * w[2], v[4 * j + 3] * rstd * w[3]}; }
                }
            }
        }
    }
#undef IN
#undef BOTH
#undef GRID_BAR
}

extern "C" void kernel_launch(void* const* d_in, const int* in_sizes, int n_in, void* d_out, int out_size, void* d_ws, size_t ws_size, hipStream_t stream) {
    (void)in_sizes; (void)n_in; (void)out_size; (void)ws_size;
    unsigned char* ws = (unsigned char*)d_ws;
    static int grid = 0;
    if (grid == 0) {
        int dev = 0, cus = 0;
        (void)hipGetDevice(&dev); (void)hipDeviceGetAttribute(&cus, hipDeviceAttributeMultiprocessorCount, dev);
        (void)hipFuncSetAttribute((const void*)mega, hipFuncAttributeMaxDynamicSharedMemorySize, LDS_BYTES);
        grid = cus > 0 ? cus : 256;
    }
    (void)hipMemsetAsync(ws + WS_CTL, 0, CTL_ZERO_BYTES, stream);
    MArgs ma{};
    for (int i = 0; i < 23; ++i) ma.in[i] = (const float*)d_in[i];
    ma.out = (float*)d_out; ma.ws = ws; ma.ph_lo = 0; ma.ph_hi = 13;
    hipLaunchKernelGGL(mega, dim3(grid), dim3(512), LDS_BYTES, stream, ma);
}
```

```cpp
#include <hip/hip_runtime.h>
#include <cstdio>
#include <cstdint>

#ifndef MOE_FP8
#define MOE_FP8 2
#endif
#ifndef MOE_CONV_IN_P1
#define MOE_CONV_IN_P1 1
#endif
constexpr int HG_NB = 16;
typedef unsigned short bf16_t;
typedef short bf16x8 __attribute__((ext_vector_type(8)));
typedef float f32x4 __attribute__((ext_vector_type(4)));
typedef float f32x2v __attribute__((ext_vector_type(2)));

constexpr int BATCH = 8, SEQ = 4096, D = 1024, T = BATCH * SEQ;
constexpr int NH = 8, DK = 128, DV = 128;
constexpr int LRU_H = 4, LRU_B = 256;
constexpr int NE = 32, TOPK = 4, DFF = 1024;
constexpr float EPS = 1e-5f;
constexpr size_t MiB = 1u << 20;

constexpr size_t WS_XN   = 224 * MiB;
constexpr size_t WS_SEG  = 288 * MiB;
constexpr size_t SEG_BYTES = (size_t)T * 1024 * 2;
constexpr size_t WS_X1   = 800 * MiB;
constexpr size_t WS_X1W  = 928 * MiB;
enum { SG_Q = 0, SG_F = 1, SG_V = 2, SG_G = 3, SG_XB = 4, SG_GATE = 5, SG_GA = 6, SG_GB = 7 };

__device__ __forceinline__ float bf2f(bf16_t v) { return __uint_as_float(((unsigned)v) << 16); }
__device__ __forceinline__ bf16_t f2bf(float f) { unsigned u = __float_as_uint(f); u += 0x7fffu + ((u >> 16) & 1u); return (bf16_t)(u >> 16); }
__device__ __forceinline__ float sigmoidf_(float x) { return __builtin_amdgcn_rcpf(1.0f + __expf(-x)); }
__device__ __forceinline__ float siluf_(float x) { return x * sigmoidf_(x); }
__device__ __forceinline__ float wave_sum(float v) {
#pragma unroll
    for (int o = 1; o < 64; o <<= 1) v += __shfl_xor(v, o);
    return v;
}

#define LAS __attribute__((address_space(3)))
#define GAS __attribute__((address_space(1)))
typedef unsigned u32x4 __attribute__((ext_vector_type(4)));
typedef unsigned u32x2 __attribute__((ext_vector_type(2)));
typedef GAS unsigned gu32;
#define LDS_WAIT() asm volatile("s_waitcnt lgkmcnt(0)" ::: "memory")
#define VM_WAIT() asm volatile("s_waitcnt vmcnt(0)" ::: "memory")

constexpr size_t WS_CTL = 0, CTL_ZERO_BYTES = 64 * 1024;
constexpr size_t WS_LBV = 1 * MiB;
constexpr size_t WS_LOGSIG = 1 * MiB + 8192;
constexpr size_t WS_BGUP = 1 * MiB + 65536;
constexpr size_t WS_WRT = 1 * MiB + 512 * 1024;
constexpr size_t WS_WIN_T = 2 * MiB, WS_WRG_T = 18 * MiB, WS_WPA_T = 19 * MiB, WS_WPB_T = 21 * MiB, WS_WOUT_T = 23 * MiB;
constexpr size_t WS_DEC = 25 * MiB;
constexpr size_t WS_LRUP = 27 * MiB, WS_LRUH = 29 * MiB;
constexpr size_t WS_DECB = 31 * MiB;
constexpr size_t WS_WGU_T = 32 * MiB, WS_WDN_T = 160 * MiB;
constexpr size_t WS_XC = 224 * MiB;
constexpr size_t WS_USP = 800 * MiB;
constexpr size_t WS_UU = 928 * MiB;
constexpr int CW_TMO = 0, CW_BAR = 1024;

#define XB_TMO      128
#define XB_XCNT(j)  (256  + 64 * (j))
#define XB_XSUB(j)  (1280 + 64 * (j))
#define XB_XGEN(j)  (2304 + 64 * (j))
#define XB_TOP      3328
#define XB_TOPGEN   3392
#define XCD_BAR_WORDS 3456
#define XB_SPIN_CAP (1u << 18)
__device__ __forceinline__ unsigned xb_ld(unsigned* p)              { return __hip_atomic_load(p, __ATOMIC_RELAXED, __HIP_MEMORY_SCOPE_AGENT); }
__device__ __forceinline__ unsigned xb_add(unsigned* p, unsigned v) { return __hip_atomic_fetch_add(p, v, __ATOMIC_RELAXED, __HIP_MEMORY_SCOPE_AGENT); }
__device__ __forceinline__ unsigned xb_xcc_id() { return (unsigned)__builtin_amdgcn_s_getreg((3 << 11) | 20) & 0xFu; }
#define XB_SPIN(cond, bar) do { unsigned _sp = 0; while (cond) { __builtin_amdgcn_s_sleep(1); \
    if ((++_sp & 255u) == 0u) { if (xb_ld(&(bar)[XB_TMO])) break; if (_sp > XB_SPIN_CAP) { atomicAdd(&(bar)[XB_TMO], 1u); break; } } } } while (0)
struct XcdBarrier { unsigned* bar; unsigned x; volatile LAS unsigned* st; };
__device__ __forceinline__ XcdBarrier xcd_barrier_post(unsigned* bar, volatile LAS unsigned* st) {
    XcdBarrier b; b.bar = bar; b.x = xb_xcc_id(); b.st = st;
    if (threadIdx.x == 0) (void)xb_add(&bar[XB_XCNT(b.x)], 1u);
    return b;
}
__device__ __forceinline__ void xcd_barrier_complete(unsigned* bar, unsigned x, unsigned& nloc, unsigned& nx) {
    const unsigned G = gridDim.x * gridDim.y * gridDim.z;
    unsigned sum, cnt, mine, sp = 0u;
    for (;;) {
        sum = 0u; cnt = 0u; mine = 0u;
#pragma unroll
        for (unsigned j = 0; j < 16; ++j) { const unsigned c = xb_ld(&bar[XB_XCNT(j)]); sum += c; cnt += (c > 0u) ? 1u : 0u; mine = (j == x) ? c : mine; }
        if (sum == G) break;
        __builtin_amdgcn_s_sleep(1);
        if ((++sp & 255u) == 0u) { if (xb_ld(&bar[XB_TMO])) break; if (sp > XB_SPIN_CAP) { atomicAdd(&bar[XB_TMO], 1u); break; } }
    }
    nloc = mine > 0u ? mine : 1u; nx = cnt > 0u ? cnt : 1u;
}
__device__ __forceinline__ void xcd_barrier(const XcdBarrier& b) {
    asm volatile("s_waitcnt vmcnt(0)" ::: "memory");
    __syncthreads();
    if (threadIdx.x == 0) {
        unsigned* bar = b.bar;
        __builtin_amdgcn_s_waitcnt(0);
        unsigned nloc = b.st[0], nx = b.st[1];
        if (nloc == 0u) { xcd_barrier_complete(bar, b.x, nloc, nx); b.st[0] = nloc; b.st[1] = nx; }
        const unsigned old = xb_add(&bar[XB_XSUB(b.x)], 1u);
        const unsigned gen = old / nloc;
        if (old + 1u == (gen + 1u) * nloc) {
            __builtin_amdgcn_fence(__ATOMIC_RELEASE, "agent");
            asm volatile("s_waitcnt vmcnt(0)" ::: "memory");
            const unsigned og = xb_add(&bar[XB_TOP], 1u);
            const unsigned tg = og / nx;
            if (og + 1u == (tg + 1u) * nx) xb_add(&bar[XB_TOPGEN], 1u);
            else XB_SPIN(xb_ld(&bar[XB_TOPGEN]) == tg, bar);
            __builtin_amdgcn_fence(__ATOMIC_ACQUIRE, "agent");
            xb_add(&bar[XB_XGEN(b.x)], 1u);
            asm volatile("s_waitcnt vmcnt(0)" ::: "memory");
        } else {
            XB_SPIN(xb_ld(&bar[XB_XGEN(b.x)]) == gen, bar);
            __builtin_amdgcn_fence(__ATOMIC_ACQUIRE, "agent");
            asm volatile("s_waitcnt vmcnt(0)" ::: "memory");
        }
    }
    __syncthreads();
}

namespace pg8 {
typedef long i64x2 __attribute__((ext_vector_type(2)));
typedef int i32x4 __attribute__((ext_vector_type(4)));
typedef int i32x8 __attribute__((ext_vector_type(8)));
constexpr int BM = 256, BK = 64, HALF = 128, HTB = HALF * BK * 2, STAGE_BYTES = 8 * HTB, NXCD = 8, WGM = 4;
__host__ __device__ __forceinline__ int lds_byte(int r, int c) { const int st = (r >> 4) * 2 + (c >> 5), rr = r & 15, cc = c & 31, ob = rr * 64 + cc * 2; return st * 1024 + (ob ^ (((ob >> 9) & 1) << 5)); }
__host__ __device__ __forceinline__ void stage_rc(int b, int& R, int& C) { const int st = b / 1024, sb = b % 1024, swz = sb ^ (((sb >> 9) & 1) << 5); R = (st >> 1) * 16 + swz / 64; C = (st & 1) * 32 + (swz % 64) / 2; }
__host__ __device__ __forceinline__ int perm32(int rho) { const int n = rho >> 4, i = rho & 15; return 8 * (i >> 2) + 4 * n + (i & 3); }
__device__ __forceinline__ unsigned cvt_pk_bf16(float lo, float hi) { unsigned r; asm volatile("v_cvt_pk_bf16_f32 %0, %1, %2" : "=v"(r) : "v"(lo), "v"(hi)); return r; }

struct Unit { const char* a; const char* b; int pm, pn, e, rows; };
struct NoMid { static constexpr int KJ = 0; size_t jumpA, jumpB; template <class U> __device__ __forceinline__ void operator()(f32x4 (&)[2][2][4][2], const U&, int, int, int, int) const {} };
template <class E, class = void> struct has_post { static constexpr bool v = false; };
template <class E> struct has_post<E, decltype((void)E::POST)> { static constexpr bool v = true; };
template <class Epi, class Sched, bool GATHER, class Mid = NoMid, bool FP8 = false>
__device__ __forceinline__ void gemm_phase(LAS unsigned char* lds, const int K, const int lda  , const Sched& S, const Epi& E, const int ldb_ = 0, const Mid MD = Mid{}) {
    const int ldb = ldb_ ? ldb_ : K;
    const int tid = threadIdx.x, wid = __builtin_amdgcn_readfirstlane(tid >> 6), lane = tid & 63, wr = wid >> 2, wc = wid & 3, fr = lane & 15, fq = lane >> 4;
    const int nt = K / BK;
    unsigned vA[2][2], voffB[2];
#pragma unroll
    for (int i = 0; i < 2; ++i) { int R, C; stage_rc(tid * 16 + i * 8192, R, C); const int Rb = Epi::PERM ? ((R & ~31) + perm32(R & 31)) : R;
        vA[0][i] = (unsigned)(R * lda + C) * 2u; vA[1][i] = (unsigned)((R + HALF) * lda + C) * 2u; voffB[i] = (unsigned)(Rb * ldb + C) * 2u; }
    const size_t kstep = (size_t)(BK * 2);
    const size_t hstepB = (size_t)HALF * ldb * 2;
    const unsigned ldsw = (unsigned)wid * 1024u;
    const int aoff = lds_byte(wr * 64 + fr, fq * 8), boff = lds_byte(wc * 32 + fr, fq * 8);
#define PG8_SA(b, h) (((b) * 2 + (h)) * HTB)
#define PG8_SB(b, h) ((4 + (b) * 2 + (h)) * HTB)
#define PG8_STAGE(bufoff, gbase, voff) do { _Pragma("unroll") for (int _i = 0; _i < 2; ++_i) \
        __builtin_amdgcn_global_load_lds((const unsigned*)((const char*)(gbase) + (voff)[_i]), (LAS unsigned*)(lds + (bufoff) + ldsw + _i * 8192), 16, 0, 0); } while (0)
#define PG8_LDA(dst, b, h) do { if constexpr (MX) { _Pragma("unroll") for (int m = 0; m < 4; ++m) dst##8[m] = __builtin_shufflevector(*(const LAS i32x4*)(lds + PG8_SA(b, h) + aoff + m * 2048), *(const LAS i32x4*)(lds + PG8_SA(b, h) + aoff + m * 2048 + 1024), 0, 1, 2, 3, 4, 5, 6, 7); } \
        else { _Pragma("unroll") for (int m = 0; m < 4; ++m) _Pragma("unroll") for (int k = 0; k < 2; ++k) dst[m][k] = *(const LAS bf16x8*)(lds + PG8_SA(b, h) + aoff + m * 2048 + k * 1024); } } while (0)
#define PG8_LDB(dst, b, h) do { if constexpr (MX) { _Pragma("unroll") for (int n = 0; n < 2; ++n) dst##8[n] = __builtin_shufflevector(*(const LAS i32x4*)(lds + PG8_SB(b, h) + boff + n * 2048), *(const LAS i32x4*)(lds + PG8_SB(b, h) + boff + n * 2048 + 1024), 0, 1, 2, 3, 4, 5, 6, 7); } \
        else { _Pragma("unroll") for (int n = 0; n < 2; ++n) _Pragma("unroll") for (int k = 0; k < 2; ++k) dst[n][k] = *(const LAS bf16x8*)(lds + PG8_SB(b, h) + boff + n * 2048 + k * 1024); } } while (0)
#define PG8_MMA(ai, bj, At, Bt) do { __builtin_amdgcn_s_setprio(1); _Pragma("unroll") for (int m = 0; m < 4; ++m) _Pragma("unroll") for (int n = 0; n < 2; ++n) { \
        if constexpr (MX) {     \
            asm volatile("v_mfma_scale_f32_16x16x128_f8f6f4 %0, %1, %2, %0, %3, %3 op_sel_hi:[0,0,0]" : "+v"(acc[ai][bj][m][n]) : "v"(Bt##8[n]), "v"(At##8[m]), "v"(mxscale)); \
        } else { _Pragma("unroll") for (int k = 0; k < 2; ++k) { \
        if constexpr (FP8) { const i64x2 _b = __builtin_bit_cast(i64x2, Bt[n][k]), _a = __builtin_bit_cast(i64x2, At[m][k]); \
            acc[ai][bj][m][n] = __builtin_amdgcn_mfma_f32_16x16x32_fp8_fp8(_b[0], _a[0], acc[ai][bj][m][n], 0, 0, 0); acc[ai][bj][m][n] = __builtin_amdgcn_mfma_f32_16x16x32_fp8_fp8(_b[1], _a[1], acc[ai][bj][m][n], 0, 0, 0); } \
        else acc[ai][bj][m][n] = __builtin_amdgcn_mfma_f32_16x16x32_bf16(Bt[n][k], At[m][k], acc[ai][bj][m][n], 0, 0, 0); } } } __builtin_amdgcn_s_setprio(0); } while (0)
#define PG8_WAIT_V(n) asm volatile("s_waitcnt vmcnt(" #n ")" ::: "memory")
#define PG8_WAIT_L(n) asm volatile("s_waitcnt lgkmcnt(" #n ")" ::: "memory")
#define PG8_BAR __builtin_amdgcn_s_barrier()
#define PG8_SCHED __builtin_amdgcn_sched_barrier(0)
    Unit cur, nxt; int ui = 0;
    if (!S.next(0, cur)) return;
    f32x4 acc[2][2][4][2];
#pragma unroll
    for (int a = 0; a < 2; ++a)
#pragma unroll
        for (int b = 0; b < 2; ++b)
#pragma unroll
            for (int m = 0; m < 4; ++m)
#pragma unroll
                for (int n = 0; n < 2; ++n) acc[a][b][m][n] = (f32x4){0.f, 0.f, 0.f, 0.f};
    constexpr bool MX = FP8 && (MOE_FP8 == 2);
    int mxscale = 0x7F7F7F7F; asm volatile("" : "+v"(mxscale));
    bf16x8 At[4][2], B0[2][2], B1[2][2]; i32x8 At8[4], B08[2], B18[2];
    const char* cA = cur.a; const char* cB = cur.b;
#define PG8_GOFF(unit, dst) do { int _tz = threadIdx.x; asm volatile("" : "+v"(_tz)); int _R0, _C0, _R1, _C1; stage_rc(_tz * 16, _R0, _C0); stage_rc(_tz * 16 + 8192, _R1, _C1); int _r[4]; S.rows(unit, _R0, _R1, _r); \
        dst[0][0] = (unsigned)(_r[0] * lda + _C0) * 2u; dst[0][1] = (unsigned)(_r[1] * lda + _C1) * 2u; dst[1][0] = (unsigned)(_r[2] * lda + _C0) * 2u; dst[1][1] = (unsigned)(_r[3] * lda + _C1) * 2u; } while (0)
    LAS u32x4* noff = (LAS u32x4*)(lds + STAGE_BYTES + 4096) + tid;
    if constexpr (GATHER) { PG8_GOFF(cur, vA); }
    PG8_STAGE(PG8_SB(0, 0), cB, voffB); PG8_STAGE(PG8_SB(0, 1), cB + hstepB, voffB); PG8_STAGE(PG8_SA(0, 0), cA, vA[0]); PG8_STAGE(PG8_SA(0, 1), cA, vA[1]);
    if (wr == 1) PG8_BAR;
    PG8_WAIT_V(2); PG8_BAR;
    PG8_STAGE(PG8_SB(1, 0), cB + kstep, voffB); PG8_STAGE(PG8_SA(1, 0), cA + kstep, vA[0]); PG8_STAGE(PG8_SB(1, 1), cB + hstepB + kstep, voffB);
    PG8_WAIT_V(6); PG8_BAR;
    for (;;) {
        const bool has_next = S.next(ui + 1, nxt);
        const char* nA = has_next ? nxt.a : cA; const char* nB = has_next ? nxt.b : cB;
#pragma unroll 1
        for (int t = 0; t < nt; t += 2) {
            const bool last = (t == nt - 2);
            const char* a1 = cA + (size_t)(t + 1) * kstep;
            const char* a2 = last ? nA : cA + (size_t)(t + 2) * kstep; const char* b2 = last ? nB : cB + (size_t)(t + 2) * kstep;
            const char* a3 = a2 + kstep; const char* b3 = b2 + kstep;
            if constexpr (Mid::KJ > 0) {
                if (t + 1 >= Mid::KJ) a1 += MD.jumpA;
                if (!last && t + 2 >= Mid::KJ) { a2 += MD.jumpA; b2 += MD.jumpB; a3 += MD.jumpA; b3 += MD.jumpB; }
                if (t == Mid::KJ) MD(acc, cur, wr, wc, fr, fq);
            }
            asm volatile("" : "+s"(a1), "+s"(a2), "+s"(a3), "+s"(b2), "+s"(b3));
            unsigned o2[2][2];
            if constexpr (GATHER) {
#pragma unroll
                for (int h = 0; h < 2; ++h)
#pragma unroll
                    for (int i = 0; i < 2; ++i) o2[h][i] = vA[h][i];
                if (last && has_next) { PG8_GOFF(nxt, o2); *noff = (u32x4){o2[0][0], o2[0][1], o2[1][0], o2[1][1]}; }
            } else {
#pragma unroll
                for (int h = 0; h < 2; ++h)
#pragma unroll
                    for (int i = 0; i < 2; ++i) o2[h][i] = vA[h][i];
            }
            PG8_LDB(B0, 0, 0); PG8_LDB(B1, 0, 1); PG8_SCHED; PG8_LDA(At, 0, 0); PG8_STAGE(PG8_SA(1, 1), a1, vA[1]);
            PG8_WAIT_V(8); PG8_WAIT_L(0); PG8_BAR; PG8_MMA(0, 0, At, B0); PG8_MMA(0, 1, At, B1); PG8_BAR; PG8_SCHED;
            PG8_LDA(At, 0, 1); PG8_STAGE(PG8_SB(0, 0), b2, voffB); PG8_STAGE(PG8_SB(0, 1), b2 + hstepB, voffB); PG8_STAGE(PG8_SA(0, 0), a2, o2[0]);
            PG8_WAIT_V(8); PG8_WAIT_L(0); PG8_BAR; PG8_MMA(1, 0, At, B0); PG8_MMA(1, 1, At, B1); PG8_BAR; PG8_SCHED;
            PG8_LDB(B0, 1, 0); PG8_LDB(B1, 1, 1); PG8_SCHED; PG8_LDA(At, 1, 0); PG8_STAGE(PG8_SA(0, 1), a2, o2[1]);
            PG8_WAIT_V(8); PG8_WAIT_L(0); PG8_BAR; PG8_MMA(0, 0, At, B0); PG8_MMA(0, 1, At, B1); PG8_BAR; PG8_SCHED;
            PG8_LDA(At, 1, 1); PG8_STAGE(PG8_SB(1, 0), b3, voffB); PG8_STAGE(PG8_SB(1, 1), b3 + hstepB, voffB); PG8_STAGE(PG8_SA(1, 0), a3, o2[0]);
            PG8_WAIT_V(8); PG8_WAIT_L(0); PG8_BAR; PG8_MMA(1, 0, At, B0); PG8_MMA(1, 1, At, B1); PG8_BAR; PG8_SCHED;
        }
        if constexpr (MX) asm volatile("s_nop 15\n\ts_nop 7" ::: "memory");
        if (wr == 0) PG8_BAR;
        E(acc, cur, wr, wc, fr, fq);
#if defined(DUP_EPI)
        if constexpr (Epi::DUPE) { asm volatile("" ::: "memory"); E(acc, cur, wr, wc, fr, fq); }
#endif
        if constexpr (has_post<Epi>::v) { PG8_WAIT_V(0); PG8_BAR; E.post(cur); }
        if (!has_next) break;
#pragma unroll
        for (int a = 0; a < 2; ++a)
#pragma unroll
            for (int b = 0; b < 2; ++b)
#pragma unroll
                for (int m = 0; m < 4; ++m)
#pragma unroll
                    for (int n = 0; n < 2; ++n) acc[a][b][m][n] = (f32x4){0.f, 0.f, 0.f, 0.f};
        cur = nxt; cA = nA; cB = nB; ++ui;
        if constexpr (GATHER) { const u32x4 nv = *noff; vA[0][0] = nv.x; vA[0][1] = nv.y; vA[1][0] = nv.z; vA[1][1] = nv.w; }
        if (wr == 1) PG8_BAR;
    }
    PG8_WAIT_V(0);
    PG8_BAR;
#undef PG8_GOFF
#undef PG8_SA
#undef PG8_SB
#undef PG8_STAGE
#undef PG8_LDA
#undef PG8_LDB
#undef PG8_MMA
#undef PG8_WAIT_V
#undef PG8_WAIT_L
#undef PG8_BAR
#undef PG8_SCHED
}

struct DenseOrder {
    const char* A; const char* Bt; size_t a_tile, b_tile; int nM, nN, nwg, G, c; int i0 = 0, i1 = 1 << 30;
    __device__ __forceinline__ void init(const void* A_, size_t lda_bytes, const void* Bt_, size_t K_bytes, int M, int N, int G_, int c_) {
        A = (const char*)A_; Bt = (const char*)Bt_; a_tile = 256 * lda_bytes; b_tile = 256 * K_bytes; nM = M / BM; nN = N / BM; nwg = nM * nN; G = G_; c = c_; }
    __device__ __forceinline__ bool next(int i, Unit& u) const {
        if (i0 + i >= i1) return false;
        const long L = (long)(i0 + i) * G + c; if (L >= nwg) return false;
        int wgid = (int)L; { const int q = nwg / NXCD, r = nwg % NXCD, xcd = wgid % NXCD, off = wgid / NXCD; wgid = (xcd < r ? xcd * (q + 1) : r * (q + 1) + (xcd - r) * q) + off; }
        const int nig = WGM * nN, gid = wgid / nig, fm = gid * WGM, gsz = (nM - fm) < WGM ? (nM - fm) : WGM;
        u.pm = fm + ((wgid % nig) % gsz); u.pn = (wgid % nig) / gsz; u.e = 0; u.rows = 256;
        u.a = A + (size_t)u.pm * a_tile; u.b = Bt + (size_t)u.pn * b_tile; return true;
    }
};

struct EpiSeg {
    static constexpr bool PERM = true;
#if defined(DUP_EPI)
    static constexpr bool DUPE = ((DUP_EPI >> 0) & 1) != 0;
#endif
    bf16_t* seg0;
    __device__ __forceinline__ void operator()(const f32x4 (&acc)[2][2][4][2], const Unit& u, int wr, int wc, int fr, int fq) const {
        const int row0 = u.pm * BM + wr * 64 + fr;
        if (u.pn < 24) {
            bf16_t* base = seg0 + (size_t)(u.pn >> 2) * ((size_t)T * 1024);
            const int col0 = (u.pn & 3) * BM + wc * 32 + 8 * fq;
#pragma unroll
            for (int ai = 0; ai < 2; ++ai)
#pragma unroll
                for (int m = 0; m < 4; ++m) { bf16_t* rowp = base + (size_t)(row0 + ai * HALF + m * 16) * 1024 + col0;
#pragma unroll
                    for (int bj = 0; bj < 2; ++bj) { const f32x4 v0 = acc[ai][bj][m][0], v1 = acc[ai][bj][m][1];
                        u32x4 w; w.x = cvt_pk_bf16(v0[0], v0[1]); w.y = cvt_pk_bf16(v0[2], v0[3]); w.z = cvt_pk_bf16(v1[0], v1[1]); w.w = cvt_pk_bf16(v1[2], v1[3]);
                        *(u32x4*)(rowp + bj * HALF) = w; } }
        } else {
            bf16_t* ratio = seg0 + (size_t)6 * ((size_t)T * 1024); bf16_t* sgb = seg0 + (size_t)7 * ((size_t)T * 1024);
            const int col0 = (u.pn - 24) * HALF + wc * 32 + 8 * fq;
#pragma unroll
            for (int ai = 0; ai < 2; ++ai)
#pragma unroll
                for (int m = 0; m < 4; ++m) { const size_t e = (size_t)(row0 + ai * HALF + m * 16) * 1024 + col0; float rt[8], sb[8];
#pragma unroll
                    for (int n = 0; n < 2; ++n)
#pragma unroll
                        for (int k = 0; k < 4; ++k) { const float ea = 1.0f + __expf(-acc[ai][0][m][n][k]), eb = 1.0f + __expf(-acc[ai][1][m][n][k]); const float ib = __builtin_amdgcn_rcpf(eb);
                            sb[4 * n + k] = ib; rt[4 * n + k] = eb * __builtin_amdgcn_rcpf(ea); }
                    u32x4 w1, w2; w1.x = cvt_pk_bf16(rt[0], rt[1]); w1.y = cvt_pk_bf16(rt[2], rt[3]); w1.z = cvt_pk_bf16(rt[4], rt[5]); w1.w = cvt_pk_bf16(rt[6], rt[7]);
                    w2.x = cvt_pk_bf16(sb[0], sb[1]); w2.y = cvt_pk_bf16(sb[2], sb[3]); w2.z = cvt_pk_bf16(sb[4], sb[5]); w2.w = cvt_pk_bf16(sb[6], sb[7]);
                    *(u32x4*)(ratio + e) = w1; *(u32x4*)(sgb + e) = w2; }
        }
    }
};

struct GateOrder {
    const char* XC; const char* W; int G, c;
    __device__ __forceinline__ bool next(int i, Unit& u) const {
        const int L = i * G + c; if (L >= 128 * 8) return false;
        u.pn = L & 1; u.e = (L >> 1) & 3; u.pm = L >> 3; u.rows = 256;
        u.a = XC + (size_t)u.pm * 256 * 2048 + (size_t)u.e * 512; u.b = W + ((size_t)u.e * 512 + (size_t)u.pn * 256) * 512; return true;
    }
};
struct EpiGates {
    static constexpr bool PERM = true;
#if defined(DUP_EPI)
    static constexpr bool DUPE = ((DUP_EPI >> 1) & 1) != 0;
#endif
    static constexpr bool POST = true;
    const bf16_t* XC; const float* ba; const float* bxx; const float* LOGSIG; bf16_t* LA; bf16_t* UU; float* LP; float* LH;
    __device__ __forceinline__ void operator()(const f32x4 (&acc)[2][2][4][2], const Unit& u, int wr, int wc, int fr, int fq) const {
        const int cb = 256 * u.e + 128 * u.pn + 32 * wc + 8 * fq;
        f32x4 va[2], vx[2], ls[2];
#pragma unroll
        for (int n = 0; n < 2; ++n) { va[n] = *(const f32x4*)(ba + cb + 4 * n); vx[n] = *(const f32x4*)(bxx + cb + 4 * n); ls[n] = *(const f32x4*)(LOGSIG + cb + 4 * n); }
        u32x4 xall[2][4];
#pragma unroll
        for (int ai = 0; ai < 2; ++ai)
#pragma unroll
            for (int m = 0; m < 4; ++m) xall[ai][m] = *(const u32x4*)(XC + (size_t)(u.pm * BM + ai * HALF + wr * 64 + m * 16 + fr) * 1024 + cb);
        asm volatile("" ::: "memory");
#pragma unroll
        for (int ai = 0; ai < 2; ++ai)
#pragma unroll
            for (int m = 0; m < 4; ++m) {
                const int t = u.pm * BM + ai * HALF + wr * 64 + m * 16 + fr; const size_t e = (size_t)t * 1024 + cb;
                const u32x4 xw = xall[ai][m]; const unsigned xu[4] = {xw.x, xw.y, xw.z, xw.w};
                const bool first = (t & (SEQ - 1)) == 0;
                float la[8], uu[8];
#pragma unroll
                for (int n = 0; n < 2; ++n)
#pragma unroll
                    for (int k = 0; k < 4; ++k) {
                        const float r = sigmoidf_(acc[ai][0][m][n][k] + va[n][k]), ig = sigmoidf_(acc[ai][1][m][n][k] + vx[n][k]);
                        const float l = 8.0f * r * ls[n][k]; const float mult = first ? 1.0f : __builtin_amdgcn_sqrtf(fmaxf(1.0f - __expf(2.0f * l), 0.f));
                        const int idx = 4 * n + k; const float xc = (idx & 1) ? __uint_as_float(xu[idx >> 1] & 0xffff0000u) : __uint_as_float(xu[idx >> 1] << 16);
                        la[idx] = l; uu[idx] = xc * ig * mult;
                    }
                u32x4 o1, o2; o1.x = cvt_pk_bf16(la[0], la[1]); o1.y = cvt_pk_bf16(la[2], la[3]); o1.z = cvt_pk_bf16(la[4], la[5]); o1.w = cvt_pk_bf16(la[6], la[7]);
                o2.x = cvt_pk_bf16(uu[0], uu[1]); o2.y = cvt_pk_bf16(uu[2], uu[3]); o2.z = cvt_pk_bf16(uu[4], uu[5]); o2.w = cvt_pk_bf16(uu[6], uu[7]);
                *(u32x4*)(LA + e) = o1; *(u32x4*)(UU + e) = o2;
            }
    }
    __device__ __forceinline__ void post(const Unit& u) const {
        int tid = threadIdx.x; asm volatile("" : "+v"(tid));
        const int w = tid >> 6, lane = tid & 63, seg = lane >> 4;
        const int ch = 256 * u.e + 128 * u.pn + 64 * (w & 1) + 4 * (lane & 15), t0 = u.pm * BM + 64 * (w >> 1);
        const size_t e0 = (size_t)(t0 + 16 * seg) * 1024 + ch;
        unsigned long long l[16], x[16];
#pragma unroll
        for (int j = 0; j < 16; ++j) { l[j] = __hip_atomic_load((const unsigned long long*)(LA + e0 + (size_t)j * 1024), __ATOMIC_RELAXED, __HIP_MEMORY_SCOPE_AGENT); x[j] = __hip_atomic_load((const unsigned long long*)(UU + e0 + (size_t)j * 1024), __ATOMIC_RELAXED, __HIP_MEMORY_SCOPE_AGENT); }
        float sl[4] = {0.f, 0.f, 0.f, 0.f}, h[4] = {0.f, 0.f, 0.f, 0.f};
#pragma unroll
        for (int j = 0; j < 16; ++j) { const unsigned lw[2] = {(unsigned)l[j], (unsigned)(l[j] >> 32)}, xw[2] = {(unsigned)x[j], (unsigned)(x[j] >> 32)};
#pragma unroll
            for (int k = 0; k < 2; ++k) { const float la0 = __uint_as_float(lw[k] << 16), la1 = __uint_as_float(lw[k] & 0xffff0000u);
                sl[2 * k] += la0; sl[2 * k + 1] += la1;
                h[2 * k] = __expf(la0) * h[2 * k] + __uint_as_float(xw[k] << 16); h[2 * k + 1] = __expf(la1) * h[2 * k + 1] + __uint_as_float(xw[k] & 0xffff0000u); } }
#pragma unroll
        for (int st = 0; st < 2; ++st) { const bool take = st == 0 ? (seg & 1) != 0 : seg == 3;
#pragma unroll
            for (int k = 0; k < 4; ++k) { const float ps = __shfl_xor(sl[k], 16 << st), ph = __shfl_xor(h[k], 16 << st);
                if (take) { h[k] = ph * __expf(sl[k]) + h[k]; sl[k] += ps; } } }
        if (seg == 3) { const size_t o = (size_t)(t0 >> 6) * 1024 + ch;
            *(f32x4*)(LP + o) = (f32x4){__expf(sl[0]), __expf(sl[1]), __expf(sl[2]), __expf(sl[3])}; *(f32x4*)(LH + o) = (f32x4){h[0], h[1], h[2], h[3]}; }
    }
};

__device__ __forceinline__ void unpack8(const u32x4 w, float (&f)[8]) { const unsigned u[4] = {w.x, w.y, w.z, w.w};
#pragma unroll
    for (int i = 0; i < 4; ++i) { f[2 * i] = __uint_as_float(u[i] << 16); f[2 * i + 1] = __uint_as_float(u[i] & 0xffff0000u); } }
struct MidMerge {
    static constexpr int KJ = 16; size_t jumpA, jumpB; const bf16_t* RATIO;
    __device__ __forceinline__ void operator()(f32x4 (&acc)[2][2][4][2], const Unit& u, int wr, int wc, int fr, int fq) const {
        int row0 = u.pm * BM + wr * 64 + fr; const int col0 = u.pn * BM + wc * 32 + 8 * fq;
        asm volatile("" : "+v"(row0));
#pragma unroll
        for (int ai = 0; ai < 2; ++ai)
#pragma unroll
            for (int mp = 0; mp < 2; ++mp) {
                u32x4 rw[2][2];
#pragma unroll
                for (int mm = 0; mm < 2; ++mm)
#pragma unroll
                    for (int bj = 0; bj < 2; ++bj) rw[mm][bj] = *(const u32x4*)(RATIO + (size_t)(row0 + ai * HALF + (2 * mp + mm) * 16) * 1024 + col0 + bj * HALF);
#pragma unroll
                for (int mm = 0; mm < 2; ++mm)
#pragma unroll
                    for (int bj = 0; bj < 2; ++bj) { float r[8]; unpack8(rw[mm][bj], r); const int m = 2 * mp + mm;
#pragma unroll
                        for (int k = 0; k < 4; ++k) { acc[ai][bj][m][0][k] *= r[k]; acc[ai][bj][m][1][k] *= r[4 + k]; } }
                asm volatile("" ::: "memory"); }
    }
};
struct EpiMerge {
    static constexpr bool PERM = true;
    const bf16_t* SGB; bf16_t* MG;
    __device__ __forceinline__ void operator()(const f32x4 (&acc)[2][2][4][2], const Unit& u, int wr, int wc, int fr, int fq) const {
        const int row0 = u.pm * BM + wr * 64 + fr, col0 = u.pn * BM + wc * 32 + 8 * fq;
#pragma unroll
        for (int ai = 0; ai < 2; ++ai) {
            u32x4 gv[4][2];
#pragma unroll
            for (int m = 0; m < 4; ++m)
#pragma unroll
                for (int bj = 0; bj < 2; ++bj) gv[m][bj] = *(const u32x4*)(SGB + (size_t)(row0 + ai * HALF + m * 16) * 1024 + col0 + bj * HALF);
            asm volatile("" ::: "memory");
#pragma unroll
            for (int m = 0; m < 4; ++m)
#pragma unroll
                for (int bj = 0; bj < 2; ++bj) { const size_t e = (size_t)(row0 + ai * HALF + m * 16) * 1024 + col0 + bj * HALF;
                    float g[8]; unpack8(gv[m][bj], g); float v[8];
#pragma unroll
                    for (int k = 0; k < 4; ++k) { v[k] = g[k] * acc[ai][bj][m][0][k]; v[4 + k] = g[4 + k] * acc[ai][bj][m][1][k]; }
                    u32x4 w; w.x = cvt_pk_bf16(v[0], v[1]); w.y = cvt_pk_bf16(v[2], v[3]); w.z = cvt_pk_bf16(v[4], v[5]); w.w = cvt_pk_bf16(v[6], v[7]);
                    *(u32x4*)(MG + e) = w; }
            asm volatile("" ::: "memory");
        }
    }
};
__device__ __forceinline__ unsigned pk4_fp8(float a, float b, float c, float d);
struct EpiOut2 {
    static constexpr bool PERM = true;
#if defined(DUP_EPI)
    static constexpr bool DUPE = ((DUP_EPI >> 4) & 1) != 0;
#endif
    const float* X; bf16_t* X1B; unsigned char* X1F8;
    __device__ __forceinline__ void operator()(const f32x4 (&acc)[2][2][4][2], const Unit& u, int wr, int wc, int fr, int fq) const {
        const int row0 = u.pm * BM + wr * 64 + fr, col0 = u.pn * BM + wc * 32 + 8 * fq;
#pragma unroll
        for (int ai = 0; ai < 2; ++ai) {
            f32x4 xv[4][2][2];
#pragma unroll
            for (int m = 0; m < 4; ++m)
#pragma unroll
                for (int bj = 0; bj < 2; ++bj) { const size_t e = (size_t)(row0 + ai * HALF + m * 16) * 1024 + col0 + bj * HALF; xv[m][bj][0] = *(const f32x4*)(X + e); xv[m][bj][1] = *(const f32x4*)(X + e + 4); }
            asm volatile("" ::: "memory");
#pragma unroll
            for (int m = 0; m < 4; ++m)
#pragma unroll
                for (int bj = 0; bj < 2; ++bj) { const size_t e = (size_t)(row0 + ai * HALF + m * 16) * 1024 + col0 + bj * HALF;
                    const f32x4 y0 = xv[m][bj][0] + acc[ai][bj][m][0], y1 = xv[m][bj][1] + acc[ai][bj][m][1];
                    u32x4 w; w.x = cvt_pk_bf16(y0[0], y0[1]); w.y = cvt_pk_bf16(y0[2], y0[3]); w.z = cvt_pk_bf16(y1[0], y1[1]); w.w = cvt_pk_bf16(y1[2], y1[3]);
                    *(u32x4*)(X1B + e) = w;
                    if (X1F8) { u32x2 w8; w8.x = pk4_fp8(y0[0], y0[1], y0[2], y0[3]); w8.y = pk4_fp8(y1[0], y1[1], y1[2], y1[3]); *(u32x2*)(X1F8 + e) = w8; } }
            asm volatile("" ::: "memory");
        }
    }
};

struct MoeOrder {
    const LAS int* tp; const LAS int* off; const char* A; const char* W; const int* LIST;
    size_t w_expert_bytes, w_tile_bytes, a_row_bytes; int lg, G, c, gather;
    __device__ __forceinline__ bool next(int i, Unit& u) const {
#if defined(MOE_ORDER_XCD)
        const int nt_all = tp[32], per = (nt_all + 7) >> 3, x = c & 7, lu = i * (G >> 3) + (c >> 3);
        int ti, pn;
        if (lg == 3) { const int g = lu >> 6, r = lu & 63; pn = 4 * (r >> 5) + (r & 3); ti = x * per + 8 * g + ((r & 31) >> 2); if (8 * g + ((r & 31) >> 2) >= per) return false; }
        else { const int g = lu >> 5, r = lu & 31; pn = r & 3; ti = x * per + 8 * g + (r >> 2); if (8 * g + (r >> 2) >= per) return false; }
        if (ti >= nt_all) return false;
#else
        const int L = i * G + c, ti = L >> lg, pn = L & ((1 << lg) - 1);
        if (ti >= tp[32]) return false;
#endif
        int e = 0;
#pragma unroll 8
        for (int j = 1; j < 32; ++j) e += (tp[j] <= ti) ? 1 : 0;
        e = __builtin_amdgcn_readfirstlane(e);
        const int rt = ti - tp[e], cnt = off[e + 1] - off[e], row0 = off[e] + 256 * rt;
        u.e = e; u.pn = pn; u.pm = __builtin_amdgcn_readfirstlane(row0); u.rows = __builtin_amdgcn_readfirstlane(min(256, cnt - 256 * rt));
        u.a = gather ? A : A + (size_t)u.pm * a_row_bytes; u.b = W + (size_t)e * w_expert_bytes + (size_t)pn * w_tile_bytes; return true;
    }
    __device__ __forceinline__ void rows(const Unit& u, int R0, int R1, int (&r)[4]) const {
        const int* l = LIST + u.pm; const int mx = u.rows - 1;
        r[0] = l[min(R0, mx)]; r[1] = l[min(R1, mx)]; r[2] = l[min(R0 + 128, mx)]; r[3] = l[min(R1 + 128, mx)];
    }
};
struct EpiGU2 {
    static constexpr bool PERM = true;
#if defined(DUP_EPI)
    static constexpr bool DUPE = ((DUP_EPI >> 5) & 1) != 0;
#endif
    const float* RS; const float* BGUP; bf16_t* ACT;
    __device__ __forceinline__ void operator()(const f32x4 (&acc)[2][2][4][2], const Unit& u, int wr, int wc, int fr, int fq) const {
        const int cl = 32 * wc + 8 * fq; const float* bp = BGUP + (size_t)u.e * 2048 + 256 * u.pn + cl;
        f32x4 bg[2], bl[2];
#pragma unroll
        for (int n = 0; n < 2; ++n) { bg[n] = *(const f32x4*)(bp + 4 * n); bl[n] = *(const f32x4*)(bp + 128 + 4 * n); }
#pragma unroll
        for (int ai = 0; ai < 2; ++ai)
#pragma unroll
            for (int m = 0; m < 4; ++m) { const int r = ai * HALF + wr * 64 + m * 16 + fr;
                if (r < u.rows) { const size_t p = (size_t)u.pm + r; const float rs = RS[p]; float a[8];
#pragma unroll
                    for (int n = 0; n < 2; ++n)
#pragma unroll
                        for (int k = 0; k < 4; ++k) { const float g = fminf(acc[ai][0][m][n][k] * rs + bg[n][k], 7.0f), l = fminf(fmaxf(acc[ai][1][m][n][k] * rs + bl[n][k], -7.0f), 7.0f);
                            a[4 * n + k] = g * sigmoidf_(1.702f * g) * (l + 1.0f); }
                    u32x4 w; w.x = cvt_pk_bf16(a[0], a[1]); w.y = cvt_pk_bf16(a[2], a[3]); w.z = cvt_pk_bf16(a[4], a[5]); w.w = cvt_pk_bf16(a[6], a[7]);
                    *(u32x4*)(ACT + p * 1024 + 128 * u.pn + cl) = w; } }
    }
};
struct EpiDown2 {
    static constexpr bool PERM = true;
#if defined(DUP_EPI)
    static constexpr bool DUPE = ((DUP_EPI >> 6) & 1) != 0;
#endif
    const float* GW; const float* BD; unsigned char* Y;
    __device__ __forceinline__ void operator()(const f32x4 (&acc)[2][2][4][2], const Unit& u, int wr, int wc, int fr, int fq) const {
        const int col0 = u.pn * BM + 32 * wc + 8 * fq; const float* bp = BD + (size_t)u.e * 1024 + col0;
        f32x4 bv[2][2];
#pragma unroll
        for (int bj = 0; bj < 2; ++bj)
#pragma unroll
            for (int n = 0; n < 2; ++n) bv[bj][n] = *(const f32x4*)(bp + bj * HALF + 4 * n);
#pragma unroll
        for (int ai = 0; ai < 2; ++ai)
#pragma unroll
            for (int m = 0; m < 4; ++m) { const int r = ai * HALF + wr * 64 + m * 16 + fr;
                if (r < u.rows) { const size_t p = (size_t)u.pm + r; const float gw = GW[p];
#pragma unroll
                    for (int bj = 0; bj < 2; ++bj) { const f32x4 v0 = (acc[ai][bj][m][0] + bv[bj][0]) * gw, v1 = (acc[ai][bj][m][1] + bv[bj][1]) * gw;
                        u32x4 w; w.x = cvt_pk_bf16(v0[0], v0[1]); w.y = cvt_pk_bf16(v0[2], v0[3]); w.z = cvt_pk_bf16(v1[0], v1[1]); w.w = cvt_pk_bf16(v1[2], v1[3]);
                        *(u32x4*)(Y + p * 1024 + col0 + bj * HALF) = w; } } }
    }
};

constexpr float F8_SW = 32.0f, F8_SA = 4.0f, F8_SY = 16.0f;
__device__ __forceinline__ unsigned pk4_fp8(float a, float b, float c, float d) {
    a = fminf(fmaxf(a, -448.f), 448.f); b = fminf(fmaxf(b, -448.f), 448.f); c = fminf(fmaxf(c, -448.f), 448.f); d = fminf(fmaxf(d, -448.f), 448.f);
    int w = 0; w = __builtin_amdgcn_cvt_pk_fp8_f32(a, b, w, false); w = __builtin_amdgcn_cvt_pk_fp8_f32(c, d, w, true); return (unsigned)w; }
struct EpiGU8 {
    static constexpr bool PERM = true;
    const float* RS; const float* BGUP; unsigned char* ACT8;
    __device__ __forceinline__ void operator()(const f32x4 (&acc)[2][2][4][2], const Unit& u, int wr, int wc, int fr, int fq) const {
        const int cl = 32 * wc + 8 * fq; const float* bp = BGUP + (size_t)u.e * 2048 + 256 * u.pn + cl;
        f32x4 bg[2], bl[2];
#pragma unroll
        for (int n = 0; n < 2; ++n) { bg[n] = *(const f32x4*)(bp + 4 * n); bl[n] = *(const f32x4*)(bp + 128 + 4 * n); }
        float rsv[2][4];
#pragma unroll
        for (int ai = 0; ai < 2; ++ai)
#pragma unroll
            for (int m = 0; m < 4; ++m) { const int r = ai * HALF + wr * 64 + m * 16 + fr; rsv[ai][m] = RS[(size_t)u.pm + min(r, u.rows - 1)]; }
        asm volatile("" ::: "memory");
#pragma unroll
        for (int ai = 0; ai < 2; ++ai)
#pragma unroll
            for (int m = 0; m < 4; ++m) { const int r = ai * HALF + wr * 64 + m * 16 + fr;
                if (r < u.rows) { const size_t p = (size_t)u.pm + r; const float rs = rsv[ai][m] * (1.0f / F8_SW); float a[8];
#pragma unroll
                    for (int n = 0; n < 2; ++n)
#pragma unroll
                        for (int k = 0; k < 4; k += 2) {
                            const f32x2v rs2 = {rs, rs};
                            f32x2v g = (f32x2v){acc[ai][0][m][n][k], acc[ai][0][m][n][k + 1]} * rs2 + (f32x2v){bg[n][k], bg[n][k + 1]};
                            f32x2v l = (f32x2v){acc[ai][1][m][n][k], acc[ai][1][m][n][k + 1]} * rs2 + (f32x2v){bl[n][k], bl[n][k + 1]};
                            g[0] = fminf(g[0], 7.0f); g[1] = fminf(g[1], 7.0f); l[0] = __builtin_amdgcn_fmed3f(l[0], -7.0f, 7.0f); l[1] = __builtin_amdgcn_fmed3f(l[1], -7.0f, 7.0f);
                            f32x2v e = g * (f32x2v){-1.702f * 1.4426950408889634f, -1.702f * 1.4426950408889634f};
                            e[0] = __builtin_amdgcn_exp2f(e[0]); e[1] = __builtin_amdgcn_exp2f(e[1]);
                            e = e + (f32x2v){1.0f, 1.0f};
                            e[0] = __builtin_amdgcn_rcpf(e[0]); e[1] = __builtin_amdgcn_rcpf(e[1]);
                            const f32x2v o = (g * e) * (l * (f32x2v){F8_SA, F8_SA} + (f32x2v){F8_SA, F8_SA});
                            a[4 * n + k] = o[0]; a[4 * n + k + 1] = o[1]; }
                    u32x2 w; { int w0 = 0, w1 = 0; w0 = __builtin_amdgcn_cvt_pk_fp8_f32(a[0], a[1], w0, false); w0 = __builtin_amdgcn_cvt_pk_fp8_f32(a[2], a[3], w0, true);
                        w1 = __builtin_amdgcn_cvt_pk_fp8_f32(a[4], a[5], w1, false); w1 = __builtin_amdgcn_cvt_pk_fp8_f32(a[6], a[7], w1, true); w.x = (unsigned)w0; w.y = (unsigned)w1; }
                    *(u32x2*)(ACT8 + p * 1024 + 128 * u.pn + cl) = w; } }
    }
};
struct EpiDown8 {
    static constexpr bool PERM = true;
    const float* GW; const float* BD; unsigned char* Y;
    __device__ __forceinline__ void operator()(const f32x4 (&acc)[2][2][4][2], const Unit& u, int wr, int wc, int fr, int fq) const {
        const int col0 = u.pn * BM + 32 * wc + 8 * fq; const float* bp = BD + (size_t)u.e * 1024 + col0;
        f32x4 bv[2][2];
#pragma unroll
        for (int bj = 0; bj < 2; ++bj)
#pragma unroll
            for (int n = 0; n < 2; ++n) bv[bj][n] = *(const f32x4*)(bp + bj * HALF + 4 * n);
        constexpr float inv = 1.0f / (F8_SW * F8_SA);
        float gwv[2][4];
#pragma unroll
        for (int ai = 0; ai < 2; ++ai)
#pragma unroll
            for (int m = 0; m < 4; ++m) { const int r = ai * HALF + wr * 64 + m * 16 + fr; gwv[ai][m] = GW[(size_t)u.pm + min(r, u.rows - 1)]; }
        asm volatile("" ::: "memory");
#pragma unroll
        for (int ai = 0; ai < 2; ++ai)
#pragma unroll
            for (int m = 0; m < 4; ++m) { const int r = ai * HALF + wr * 64 + m * 16 + fr;
                if (r < u.rows) { const size_t p = (size_t)u.pm + r; const float gw = gwv[ai][m];
#pragma unroll
                    for (int bj = 0; bj < 2; ++bj) { const f32x4 v0 = (acc[ai][bj][m][0] * inv + bv[bj][0]) * (gw * F8_SY), v1 = (acc[ai][bj][m][1] * inv + bv[bj][1]) * (gw * F8_SY);
                        u32x2 w; w.x = pk4_fp8(v0[0], v0[1], v0[2], v0[3]); w.y = pk4_fp8(v1[0], v1[1], v1[2], v1[3]);
                        *(u32x2*)(Y + p * 1024 + col0 + bj * HALF) = w; } } }
    }
};
}


__device__ __forceinline__ unsigned pk2(float lo, float hi) { return (unsigned)f2bf(lo) | ((unsigned)f2bf(hi) << 16); }
#define SINK_U(x) asm volatile("" :: "v"(x))
template <bool DRY>
__device__ __forceinline__ void hgrn2_pass_b(int gthread, float* UB, const float* DECB) {
    constexpr int NBH = 64 / HG_NB;
    const int bh = gthread >> 12, rem = gthread & 4095, dv = rem >> 5, dkg = rem & 31;
    f32x4 S = (f32x4){0.f, 0.f, 0.f, 0.f};
    float* p = UB + (size_t)bh * NBH * 16384 + dv * 128 + dkg * 4;
    const float* dp = DECB + (size_t)bh * NBH * 128 + dkg * 4;
    f32x4 u[NBH], d4[NBH];
#pragma unroll
    for (int k = 0; k < NBH; ++k) { u[k] = *(const f32x4*)(p + (size_t)k * 16384); d4[k] = *(const f32x4*)(dp + k * 128); }
#pragma unroll
    for (int k = 0; k < NBH; ++k) { if (!DRY) *(f32x4*)(p + (size_t)k * 16384) = S; else SINK_U(S[0]); S = d4[k] * S + u[k]; }
}

typedef short v4i16_t __attribute__((ext_vector_type(4)));
__device__ __forceinline__ u32x2 vtr64(const LAS unsigned char* p) { return __builtin_bit_cast(u32x2, __builtin_amdgcn_ds_read_tr16_b64_v4i16((LAS v4i16_t*)p)); }
template <bool DRY>
__device__ __forceinline__ void hgrn2_pass_c_phase(LAS unsigned char* lds, int bx, int G, bf16_t* QI, const bf16_t* KI, const bf16_t* Vs, const bf16_t* Gs, const float* SP, const float* gn_w, bf16_t* OA, const float* DEC) {
    constexpr int P = 272, L_Q = 0, L_K = 17408, L_V = 34816, L_G = 52224, L_S = 69632, L_SS = 104448, NCH = BATCH * NH * 64;
    const int tid = threadIdx.x, lane = tid & 63, w = __builtin_amdgcn_readfirstlane(tid >> 6);
    const int it = w >> 1, hv = w & 1, cc = lane & 15, q = lane >> 4;
    const int lrow = tid >> 4, lch = tid & 15;
    u32x4 rq[2], rk[2], rv[2], rg[2];
    f32x4 Sreg[8];
#define PC_LOAD(cid_) do { const int _bh = (cid_) >> 6, _n = (cid_) & 63, _b = _bh >> 3, _h = _bh & 7; \
        const size_t _e = ((size_t)_b * SEQ + (size_t)_n * 64 + lrow) * 1024 + _h * 128 + lch * 8; \
        _Pragma("unroll") for (int _j = 0; _j < 2; ++_j) { rq[_j] = *(const u32x4*)(QI + _e + (size_t)_j * 32 * 1024); rk[_j] = *(const u32x4*)(KI + _e + (size_t)_j * 32 * 1024); \
            rv[_j] = *(const u32x4*)(Vs + _e + (size_t)_j * 32 * 1024); rg[_j] = *(const u32x4*)(Gs + _e + (size_t)_j * 32 * 1024); } \
        } while (0)
    constexpr int NBLK = NCH / HG_NB;
#define PC_CID(li_) (HG_NB * (bx + ((li_) / HG_NB) * G) + ((li_) % HG_NB))
#define PC_OK(li_) (bx + ((li_) / HG_NB) * G < NBLK)
    int li = 0;
    if (PC_OK(0)) PC_LOAD(PC_CID(0));
    for (; PC_OK(li); ++li) {
        const int cid = PC_CID(li);
        __syncthreads();
#pragma unroll
        for (int j = 0; j < 2; ++j) { const int o = (lrow + 32 * j) * P + lch * 16;
            *(LAS u32x4*)(lds + L_Q + o) = rq[j]; *(LAS u32x4*)(lds + L_K + o) = rk[j]; *(LAS u32x4*)(lds + L_V + o) = rv[j]; *(LAS u32x4*)(lds + L_G + o) = rg[j]; }
        if (cid % HG_NB == 0) {
            const float* eb = SP + (size_t)(cid / HG_NB) * 16384;
#pragma unroll
            for (int j = 0; j < 8; ++j)
#pragma unroll
                for (int r = 0; r < 4; ++r) Sreg[j][r] = eb[(16 * w + 4 * q + r) * 128 + 16 * j + cc];
#pragma unroll
            for (int j = 0; j < 8; ++j)
#pragma unroll
                for (int r = 0; r < 4; ++r) *(LAS bf16_t*)(lds + L_S + (16 * w + 4 * q + r) * P + (16 * j + cc) * 2) = f2bf(Sreg[j][r]);
        }
        if (PC_OK(li + 1)) PC_LOAD(PC_CID(li + 1));
        __syncthreads();
        const int bh = cid >> 6, n = cid & 63, b = bh >> 3, h = bh & 7;
        const size_t t0 = (size_t)b * SEQ + (size_t)n * 64;
        bf16x8 qf[4];
#pragma unroll
        for (int ks = 0; ks < 4; ++ks) qf[ks] = *(const LAS bf16x8*)(lds + L_Q + (16 * it + cc) * P + (32 * ks + 8 * q) * 2);
        f32x4 sT[4];
#pragma unroll
        for (int jt = 0; jt < 4; ++jt) {
            sT[jt] = (f32x4){0.f, 0.f, 0.f, 0.f};
            if (jt <= it) {
#pragma unroll
                for (int ks = 0; ks < 4; ++ks) { const bf16x8 kf = *(const LAS bf16x8*)(lds + L_K + (16 * jt + cc) * P + (32 * ks + 8 * q) * 2); sT[jt] = __builtin_amdgcn_mfma_f32_16x16x32_bf16(kf, qf[ks], sT[jt], 0, 0, 0); }
                if (jt == it) {
#pragma unroll
                    for (int r = 0; r < 4; ++r) if (4 * q + r > cc) sT[jt][r] = 0.f;
                }
            }
        }
        bf16x8 pf[2];
#pragma unroll
        for (int s2 = 0; s2 < 2; ++s2) { u32x4 pw; pw.x = pk2(sT[2 * s2][0], sT[2 * s2][1]); pw.y = pk2(sT[2 * s2][2], sT[2 * s2][3]); pw.z = pk2(sT[2 * s2 + 1][0], sT[2 * s2 + 1][1]); pw.w = pk2(sT[2 * s2 + 1][2], sT[2 * s2 + 1][3]); pf[s2] = __builtin_bit_cast(bf16x8, pw); }
        f32x4 acc[4];
#pragma unroll
        for (int dt = 0; dt < 4; ++dt) acc[dt] = (f32x4){0.f, 0.f, 0.f, 0.f};
#pragma unroll
        for (int dt = 0; dt < 4; ++dt) {
            const int dvt = 4 * hv + dt, dv = 16 * dvt + cc;
#pragma unroll
            for (int s2 = 0; s2 < 2; ++s2) {
                if (2 * s2 <= it) {
                    const LAS unsigned char* vp = lds + L_V + (32 * s2 + 4 * q + (cc >> 2)) * P + (16 * dvt + 4 * (cc & 3)) * 2;
                    const u32x2 lo = vtr64(vp), hi2 = vtr64(vp + 16 * P);
                    const bf16x8 vf = __builtin_bit_cast(bf16x8, (u32x4){lo.x, lo.y, hi2.x, hi2.y});
                    acc[dt] = __builtin_amdgcn_mfma_f32_16x16x32_bf16(vf, pf[s2], acc[dt], 0, 0, 0);
                }
            }
#pragma unroll
            for (int ks = 0; ks < 4; ++ks) { const bf16x8 sf = *(const LAS bf16x8*)(lds + L_S + dv * P + (32 * ks + 8 * q) * 2); acc[dt] = __builtin_amdgcn_mfma_f32_16x16x32_bf16(sf, qf[ks], acc[dt], 0, 0, 0); }
        }
        float ss = 0.f;
#pragma unroll
        for (int dt = 0; dt < 4; ++dt) ss += (acc[dt][0] * acc[dt][0] + acc[dt][1] * acc[dt][1]) + (acc[dt][2] * acc[dt][2] + acc[dt][3] * acc[dt][3]);
        ss += __shfl_xor(ss, 16); ss += __shfl_xor(ss, 32);
        LAS float* SS = (LAS float*)(lds + L_SS);
        if (q == 0) SS[(16 * it + cc) * 2 + hv] = ss;
        __syncthreads();
        const float rstd = rsqrtf((SS[(16 * it + cc) * 2] + SS[(16 * it + cc) * 2 + 1]) * (1.0f / DV) + EPS);
#pragma unroll
        for (int dt = 0; dt < 4; ++dt) {
            const int dv0 = 16 * (4 * hv + dt) + 4 * q; const size_t e = (t0 + 16 * it + cc) * 1024 + h * 128 + dv0;
            const u32x2 gw2 = *(const LAS u32x2*)(lds + L_G + (16 * it + cc) * P + dv0 * 2); const f32x4 gn = *(const f32x4*)(gn_w + h * 128 + dv0);
            const float g0 = __uint_as_float(gw2.x << 16), g1 = __uint_as_float(gw2.x & 0xffff0000u), g2 = __uint_as_float(gw2.y << 16), g3 = __uint_as_float(gw2.y & 0xffff0000u);
            u32x2 o; o.x = pk2(acc[dt][0] * rstd * gn[0] * siluf_(g0), acc[dt][1] * rstd * gn[1] * siluf_(g1)); o.y = pk2(acc[dt][2] * rstd * gn[2] * siluf_(g2), acc[dt][3] * rstd * gn[3] * siluf_(g3));
            if (!DRY) *(u32x2*)(OA + e) = o; else { SINK_U(o.x); SINK_U(o.y); }
        }
        if (cid % HG_NB != HG_NB - 1) {
            f32x4 a2[8];
#pragma unroll
            for (int j = 0; j < 8; ++j) a2[j] = (f32x4){0.f, 0.f, 0.f, 0.f};
#pragma unroll
            for (int ks = 0; ks < 2; ++ks) {
                const LAS unsigned char* ap = lds + L_V + (32 * ks + 8 * q + (cc >> 2)) * P + (16 * w + 4 * (cc & 3)) * 2;
                const u32x2 alo = vtr64(ap), ahi = vtr64(ap + 4 * P);
                const bf16x8 av = __builtin_bit_cast(bf16x8, (u32x4){alo.x, alo.y, ahi.x, ahi.y});
#pragma unroll
                for (int j = 0; j < 8; ++j) { const LAS unsigned char* bp = lds + L_K + (32 * ks + 8 * q + (cc >> 2)) * P + (16 * j + 4 * (cc & 3)) * 2;
                    const u32x2 blo = vtr64(bp), bhi = vtr64(bp + 4 * P);
                    a2[j] = __builtin_amdgcn_mfma_f32_16x16x32_bf16(av, __builtin_bit_cast(bf16x8, (u32x4){blo.x, blo.y, bhi.x, bhi.y}), a2[j], 0, 0, 0); }
            }
            const float* dc = DEC + (size_t)cid * 128;
#pragma unroll
            for (int j = 0; j < 8; ++j) { const float dj = dc[16 * j + cc];
#pragma unroll
                for (int r = 0; r < 4; ++r) { Sreg[j][r] = dj * (Sreg[j][r] + a2[j][r]); *(LAS bf16_t*)(lds + L_S + (16 * w + 4 * q + r) * P + (16 * j + cc) * 2) = f2bf(Sreg[j][r]); } }
        }
    }
    __syncthreads();
#undef PC_LOAD
#undef PC_CID
#undef PC_OK
}

template <bool DRY>
__device__ __forceinline__ void hgrn2_pass_a_phase(LAS unsigned char* lds, int bx, int G, bf16_t* Qs, bf16_t* Fs, const bf16_t* Vs, const float* LBV, float* UB, float* DEC, float* DECB) {
    constexpr int P = 272, L_Q = 0, L_F = 17408, L_V = 34816, L_KD = 52224, L_SEG = 69632, NCH = BATCH * NH * 64;
    const int tid = threadIdx.x, lane = tid & 63, w = __builtin_amdgcn_readfirstlane(tid >> 6), d = tid & 127, sg = tid >> 7;
    const int cc = lane & 15, q = lane >> 4, lrow = tid >> 4, lch = tid & 15;
    LAS float* SEGSUM = (LAS float*)(lds + L_SEG);
    u32x4 rq[2], rf[2], rv[2];
#define PA_LOAD(cid_) do { const int _bh = (cid_) >> 6, _n = (cid_) & 63, _b = _bh >> 3, _h = _bh & 7; \
        const size_t _e = ((size_t)_b * SEQ + (size_t)_n * 64 + lrow) * 1024 + _h * 128 + lch * 8; \
        _Pragma("unroll") for (int _j = 0; _j < 2; ++_j) { rq[_j] = *(const u32x4*)(Qs + _e + (size_t)_j * 32 * 1024); rf[_j] = *(const u32x4*)(Fs + _e + (size_t)_j * 32 * 1024); rv[_j] = *(const u32x4*)(Vs + _e + (size_t)_j * 32 * 1024); } } while (0)
    constexpr int NBLK = NCH / HG_NB;
    LAS float* ETOT = (LAS float*)(lds + L_SEG + 2048);
#define PA_CID(li_) (HG_NB * (bx + ((li_) / HG_NB) * G) + ((li_) % HG_NB))
#define PA_OK(li_) (bx + ((li_) / HG_NB) * G < NBLK)
    int li = 0; float prev_etot = 1.f;
    f32x4 acc[8];
    if (PA_OK(0)) PA_LOAD(PA_CID(0));
    for (; PA_OK(li); ++li) {
        const int cid = PA_CID(li);
        __syncthreads();
#pragma unroll
        for (int j = 0; j < 2; ++j) { const int o = (lrow + 32 * j) * P + lch * 16; *(LAS u32x4*)(lds + L_Q + o) = rq[j]; *(LAS u32x4*)(lds + L_F + o) = rf[j]; *(LAS u32x4*)(lds + L_V + o) = rv[j]; }
        if (PA_OK(li + 1)) PA_LOAD(PA_CID(li + 1));
        __syncthreads();
        const int bh = cid >> 6, n = cid & 63, b = bh >> 3, h = bh & 7;
        const size_t t0 = (size_t)b * SEQ + (size_t)n * 64;
        const float lb = LBV[h * 128 + d];
        float kk[16], cum[16], qs[16]; float c = 1.f;
#pragma unroll
        for (int i = 0; i < 16; ++i) {
            const float fl = bf2f(*(const LAS bf16_t*)(lds + L_F + (16 * sg + i) * P + 2 * d)); qs[i] = siluf_(bf2f(*(const LAS bf16_t*)(lds + L_Q + (16 * sg + i) * P + 2 * d)));
            const float f = lb + (1.0f - lb) * sigmoidf_(fl);
            kk[i] = 1.0f - f; c *= f; cum[i] = c;
        }
        SEGSUM[sg * 128 + d] = c;
        __syncthreads();
        float eoffs = 1.f, etot = 1.f;
#pragma unroll
        for (int s2 = 0; s2 < 4; ++s2) { const float v = SEGSUM[s2 * 128 + d]; etot *= v; if (s2 < sg) eoffs *= v; }
#pragma unroll
        for (int i = 0; i < 16; i += 2) {
            const float ex0 = eoffs * cum[i], ex1 = eoffs * cum[i + 1];
            const float ki0 = kk[i] * __builtin_amdgcn_rcpf(ex0), ki1 = kk[i + 1] * __builtin_amdgcn_rcpf(ex1);
            const unsigned wq = pg8::cvt_pk_bf16(qs[i] * ex0, qs[i + 1] * ex1), wk = pg8::cvt_pk_bf16(ki0, ki1), wd = pg8::cvt_pk_bf16(ki0 * etot, ki1 * etot);
            *(LAS bf16_t*)(lds + L_Q + (16 * sg + i) * P + 2 * d) = (bf16_t)(wq & 0xffffu); *(LAS bf16_t*)(lds + L_Q + (16 * sg + i + 1) * P + 2 * d) = (bf16_t)(wq >> 16);
            *(LAS bf16_t*)(lds + L_F + (16 * sg + i) * P + 2 * d) = (bf16_t)(wk & 0xffffu); *(LAS bf16_t*)(lds + L_F + (16 * sg + i + 1) * P + 2 * d) = (bf16_t)(wk >> 16);
            *(LAS bf16_t*)(lds + L_KD + (16 * sg + i) * P + 2 * d) = (bf16_t)(wd & 0xffffu); *(LAS bf16_t*)(lds + L_KD + (16 * sg + i + 1) * P + 2 * d) = (bf16_t)(wd >> 16);
        }
        if (sg == 0) { ETOT[d] = etot; prev_etot = (cid % HG_NB == 0) ? etot : prev_etot * etot; if (!DRY) { DEC[(size_t)cid * 128 + d] = etot; if (cid % HG_NB == HG_NB - 1) DECB[(size_t)(cid / HG_NB) * 128 + d] = prev_etot; } }
        __syncthreads();
#pragma unroll
        for (int j = 0; j < 2; ++j) { const int o = (lrow + 32 * j) * P + lch * 16; const size_t e = (t0 + lrow + 32 * j) * 1024 + h * 128 + lch * 8;
            const u32x4 a = *(const LAS u32x4*)(lds + L_Q + o), b2 = *(const LAS u32x4*)(lds + L_F + o);
            if (!DRY) { *(u32x4*)(Qs + e) = a; *(u32x4*)(Fs + e) = b2; } else { SINK_U(a.x); SINK_U(b2.x); } }
        if (cid % HG_NB == 0) {
#pragma unroll
            for (int j = 0; j < 8; ++j) acc[j] = (f32x4){0.f, 0.f, 0.f, 0.f};
        } else { const f32x4 e4 = *(const LAS f32x4*)(ETOT + 16 * w + 4 * q);
#pragma unroll
            for (int j = 0; j < 8; ++j) acc[j] = acc[j] * e4; }
#pragma unroll
        for (int ks = 0; ks < 2; ++ks) {
            const LAS unsigned char* ap = lds + L_KD + (32 * ks + 8 * q + (cc >> 2)) * P + (16 * w + 4 * (cc & 3)) * 2;
            const u32x2 alo = vtr64(ap), ahi = vtr64(ap + 4 * P);
            const bf16x8 a = __builtin_bit_cast(bf16x8, (u32x4){alo.x, alo.y, ahi.x, ahi.y});
#pragma unroll
            for (int j = 0; j < 8; ++j) { const LAS unsigned char* bp = lds + L_V + (32 * ks + 8 * q + (cc >> 2)) * P + (16 * j + 4 * (cc & 3)) * 2;
                const u32x2 blo = vtr64(bp), bhi = vtr64(bp + 4 * P);
                acc[j] = __builtin_amdgcn_mfma_f32_16x16x32_bf16(a, __builtin_bit_cast(bf16x8, (u32x4){blo.x, blo.y, bhi.x, bhi.y}), acc[j], 0, 0, 0); }
        }
        if (cid % HG_NB == HG_NB - 1) { float* ut = UB + (size_t)(cid / HG_NB) * 16384;
#pragma unroll
            for (int j = 0; j < 8; ++j) { if (!DRY) *(f32x4*)(ut + (16 * j + cc) * 128 + 16 * w + 4 * q) = acc[j]; else { SINK_U(acc[j][0]); SINK_U(acc[j][3]); } } }
    }
    __syncthreads();
#undef PA_LOAD
#undef PA_CID
#undef PA_OK
}

__device__ __forceinline__ float gelu_fast(float x) { const float u = 0.7978845608028654f * (x + 0.044715f * x * x * x); return x * sigmoidf_(2.0f * u); }
template <bool DRY>
__device__ __forceinline__ void lru_s3(int b, int npair, const bf16_t* LA, const bf16_t* UU, const float* LP, const float* LH, bf16_t* GATE_OB) {
    const int tid = threadIdx.x, half = tid >> 8, c0 = 4 * (tid & 255); const int n = half ? 63 - npair : npair;
    const size_t e0 = ((size_t)b * SEQ + (size_t)n * 64) * 1024 + c0;
    float h[4] = {0.f, 0.f, 0.f, 0.f};
    {
        const size_t o = ((size_t)b * 64) * 1024 + c0;
        for (int m0 = 0; m0 < n; m0 += 8) {
            f32x4 p[8], hh[8];
#pragma unroll
            for (int j = 0; j < 8; ++j) { const int mm = (m0 + j < n) ? m0 + j : 0; p[j] = *(const f32x4*)(LP + o + (size_t)mm * 1024); hh[j] = *(const f32x4*)(LH + o + (size_t)mm * 1024); }
#pragma unroll
            for (int j = 0; j < 8; ++j) if (m0 + j < n) {
#pragma unroll
                for (int k = 0; k < 4; ++k) h[k] = p[j][k] * h[k] + hh[j][k]; }
        }
    }
    for (int t0 = 0; t0 < 64; t0 += 8) {
        u32x2 l[8], u[8], g[8];
#pragma unroll
        for (int j = 0; j < 8; ++j) { const size_t e = e0 + (size_t)(t0 + j) * 1024; l[j] = *(const u32x2*)(LA + e); u[j] = *(const u32x2*)(UU + e); g[j] = *(const u32x2*)(GATE_OB + e); }
#pragma unroll
        for (int j = 0; j < 8; ++j) {
            const unsigned lw[2] = {l[j].x, l[j].y}, uw[2] = {u[j].x, u[j].y}, gw[2] = {g[j].x, g[j].y}; float ov[4];
#pragma unroll
            for (int k = 0; k < 2; ++k) {
                h[2 * k] = __expf(__uint_as_float(lw[k] << 16)) * h[2 * k] + __uint_as_float(uw[k] << 16);
                h[2 * k + 1] = __expf(__uint_as_float(lw[k] & 0xffff0000u)) * h[2 * k + 1] + __uint_as_float(uw[k] & 0xffff0000u);
                ov[2 * k] = h[2 * k] * gelu_fast(__uint_as_float(gw[k] << 16)); ov[2 * k + 1] = h[2 * k + 1] * gelu_fast(__uint_as_float(gw[k] & 0xffff0000u)); }
            u32x2 o; o.x = pk2(ov[0], ov[1]); o.y = pk2(ov[2], ov[3]);
            if (!DRY) *(u32x2*)(GATE_OB + e0 + (size_t)(t0 + j) * 1024) = o; else { SINK_U(o.x); SINK_U(o.y); }
        }
    }
}

constexpr int RING_BYTES = 131072, LDSCTL_OFF = RING_BYTES, MISC_OFF = LDSCTL_OFF + 320, LDS_BYTES = 147456;
constexpr int NWAVES = 8;


constexpr size_t WS_ACT = 224 * MiB, WS_Y = 512 * MiB;
constexpr size_t WS_RSTD = 992 * MiB, WS_TOPE = 993 * MiB, WS_TOPW = 994 * MiB, WS_POS = 995 * MiB, WS_LIST = 996 * MiB, WS_GW = 997 * MiB, WS_RS = 998 * MiB, WS_WGH = 999 * MiB;
constexpr int CW_CNT = 512, CW_CUR = 576;
constexpr int MOE_TP = LDSCTL_OFF + 1024, MOE_OFF = LDSCTL_OFF + 1024 + 256, MOE_HIST = LDSCTL_OFF + 1024 + 512, MOE_BASE = LDSCTL_OFF + 1024 + 768, MOE_LCUR = LDSCTL_OFF + 2048;

struct MArgs { const float* in[23]; float* out; unsigned char* ws; int ph_lo, ph_hi; };


template <class RowMap>
__device__ __forceinline__ void p0_transpose_item(const float* W, int K, int N, bf16_t* WT, const RowMap& rowmap, LAS float* scr, int item, int lane, const float* kscale = nullptr) {
    const int nblk = N / 32, kb = item / nblk, nb = item % nblk, k0 = 64 * kb, n0 = 32 * nb;
    {
        const int kr = lane >> 3, nq = lane & 7; f32x4 v[8];
#pragma unroll
        for (int i = 0; i < 8; ++i) v[i] = *(const f32x4*)(W + (size_t)(k0 + 8 * i + kr) * N + n0 + 4 * nq);
#pragma unroll
        for (int i = 0; i < 8; ++i) { LAS float* d = scr + (8 * i + kr) * 33 + 4 * nq; d[0] = v[i][0]; d[1] = v[i][1]; d[2] = v[i][2]; d[3] = v[i][3]; }
    }
    LDS_WAIT(); asm volatile("" ::: "memory");
    const int c = lane & 7;
    f32x4 k0s = (f32x4){1.f, 1.f, 1.f, 1.f}, k1s = k0s;
    if (kscale) { k0s = *(const f32x4*)(kscale + k0 + 8 * c); k1s = *(const f32x4*)(kscale + k0 + 8 * c + 4); }
#pragma unroll
    for (int j = 0; j < 4; ++j) { const int n = (lane >> 3) + 8 * j; const LAS float* s = scr + (8 * c) * 33 + n;
        u32x4 o; o.x = pk2(s[0 * 33] * k0s[0], s[1 * 33] * k0s[1]); o.y = pk2(s[2 * 33] * k0s[2], s[3 * 33] * k0s[3]); o.z = pk2(s[4 * 33] * k1s[0], s[5 * 33] * k1s[1]); o.w = pk2(s[6 * 33] * k1s[2], s[7 * 33] * k1s[3]);
        *(GAS u32x4*)(WT + (size_t)rowmap(n0 + n) * K + k0 + 8 * c) = o; }
    LDS_WAIT(); asm volatile("" ::: "memory");
}

__device__ __forceinline__ void p0_load8(const float* W, int N, int item, int lane, f32x4 (&v)[8]) {
    const int nblk = N / 32, kb = item / nblk, nb = item % nblk, k0 = 64 * kb, n0 = 32 * nb; const int kr = lane >> 3, nq = lane & 7;
#pragma unroll
    for (int i = 0; i < 8; ++i) v[i] = __builtin_nontemporal_load((const f32x4*)(W + (size_t)(k0 + 8 * i + kr) * N + n0 + 4 * nq));
}
template <class RowMap>
__device__ __forceinline__ void p0_finish8(const f32x4 (&v)[8], int K, int N, unsigned char* WT, const RowMap& rowmap, LAS float* scr, int item, int lane, float scale, const LAS float* kscale  ) {
    const int nblk = N / 32, kb = item / nblk, nb = item % nblk, k0 = 64 * kb, n0 = 32 * nb; const int kr = lane >> 3, nq = lane & 7;
#pragma unroll
    for (int i = 0; i < 8; ++i) { LAS float* d = scr + (8 * i + kr) * 33 + 4 * nq; d[0] = v[i][0]; d[1] = v[i][1]; d[2] = v[i][2]; d[3] = v[i][3]; }
    const int c = lane & 7;
    f32x4 k0s = (f32x4){scale, scale, scale, scale}, k1s = k0s;
    if (kscale) { k0s = *(const LAS f32x4*)(kscale + k0 + 8 * c) * scale; k1s = *(const LAS f32x4*)(kscale + k0 + 8 * c + 4) * scale; }
    LDS_WAIT(); asm volatile("" ::: "memory");
#pragma unroll
    for (int j = 0; j < 4; ++j) { const int n = (lane >> 3) + 8 * j; const LAS float* s = scr + (8 * c) * 33 + n;
        u32x2 o; o.x = pg8::pk4_fp8(s[0 * 33] * k0s[0], s[1 * 33] * k0s[1], s[2 * 33] * k0s[2], s[3 * 33] * k0s[3]); o.y = pg8::pk4_fp8(s[4 * 33] * k1s[0], s[5 * 33] * k1s[1], s[6 * 33] * k1s[2], s[7 * 33] * k1s[3]);
        *(GAS u32x2*)(WT + (size_t)rowmap(n0 + n) * K + k0 + 8 * c) = o; }
    LDS_WAIT(); asm volatile("" ::: "memory");
}
template <class RowMap>
__device__ __forceinline__ void p0_convert_experts8(const float* W, int K, int N, unsigned char* WT, const RowMap& rowmap, LAS float* scr, int gw, int NGW, int lane, float scale, const LAS float* kscale) {
    const int per = (K / 64) * (N / 32), tot = NE * per; const size_t esz = (size_t)K * N;
    f32x4 va[8], vb[8], vc[8], vd[8]; int it = gw;
#define P0_LDU(i_, v_) p0_load8(W + (size_t)((i_) / per) * esz, N, (i_) % per, lane, v_)
#define P0_FNU(i_, v_) p0_finish8(v_, K, N, WT + (size_t)((i_) / per) * esz, rowmap, scr, (i_) % per, lane, scale, kscale)
#define P0_LD(i_, v_) do { if ((i_) < tot) P0_LDU(i_, v_); } while (0)
#define P0_FN(i_, v_) do { if ((i_) < tot) P0_FNU(i_, v_); } while (0)
    if (tot % (4 * NGW) == 0) {
        P0_LDU(it, va); P0_LDU(it + NGW, vb); P0_LDU(it + 2 * NGW, vc);
        for (; it + 4 * NGW < tot; it += 4 * NGW) {
            P0_LDU(it + 3 * NGW, vd); P0_FNU(it, va);
            P0_LDU(it + 4 * NGW, va); P0_FNU(it + NGW, vb);
            P0_LDU(it + 5 * NGW, vb); P0_FNU(it + 2 * NGW, vc);
            P0_LDU(it + 6 * NGW, vc); P0_FNU(it + 3 * NGW, vd);
        }
        P0_LDU(it + 3 * NGW, vd); P0_FNU(it, va); P0_FNU(it + NGW, vb); P0_FNU(it + 2 * NGW, vc); P0_FNU(it + 3 * NGW, vd);
    } else {
        P0_LD(it, va); P0_LD(it + NGW, vb); P0_LD(it + 2 * NGW, vc);
        for (; it < tot; it += 4 * NGW) {
            P0_LD(it + 3 * NGW, vd); P0_FN(it, va);
            P0_LD(it + 4 * NGW, va); P0_FN(it + NGW, vb);
            P0_LD(it + 5 * NGW, vb); P0_FN(it + 2 * NGW, vc);
            P0_LD(it + 6 * NGW, vc); P0_FN(it + 3 * NGW, vd);
        }
    }
#undef P0_LD
#undef P0_FN
#undef P0_LDU
#undef P0_FNU
}
struct MapId { int off; __device__ __forceinline__ int operator()(int n) const { return off + n; } };
struct MapIn { __device__ __forceinline__ int operator()(int n) const { if (n < 6144) return n; const int c = (n - 6144) & 1023, isb = (n - 6144) >> 10; return 6144 + 256 * (c >> 7) + 128 * isb + (c & 127); } };
struct MapRG { int off; __device__ __forceinline__ int operator()(int n) const { return 256 * (n >> 7) + (n & 127) + off; } };
struct MapGU { __device__ __forceinline__ int operator()(int n) const { const int f = n >> 1, half = n & 1; return 256 * (f >> 7) + 128 * half + (f & 127); } };

#ifndef DUP_MASK
#define DUP_MASK 0u
#endif

#define NREP(k) (((DUP_MASK >> (k)) & 1u) ? 2 : 1)
__device__ __forceinline__ int hid_tid() { int t = threadIdx.x; asm volatile("" : "+v"(t)); return t; }
#define PHASE_IDS() const int tid = hid_tid(), lane = tid & 63, wave = __builtin_amdgcn_readfirstlane(tid >> 6); (void)lane; (void)wave
__global__ void __launch_bounds__(512, 2) mega(MArgs args) {
    extern __shared__ __attribute__((aligned(16))) unsigned char lds_raw[];
    LAS unsigned char* lds = (LAS unsigned char*)lds_raw;
    volatile LAS unsigned* MISC = (volatile LAS unsigned*)(lds + MISC_OFF);
    const int G = gridDim.x; const int bx = blockIdx.x; const int vcu = (G % 8 == 0) ? (bx % 8) * (G / 8) + bx / 8 : bx;
    unsigned char* ws = args.ws;
    gu32* ctl = (gu32*)(ws + WS_CTL);
    for (int u = threadIdx.x; u < (LDS_BYTES - LDSCTL_OFF) / 4; u += NWAVES * 64) ((LAS unsigned*)(lds + LDSCTL_OFF))[u] = 0u;
    __syncthreads();
    XcdBarrier bar = xcd_barrier_post((unsigned*)(ctl + CW_BAR), MISC + 8);
    const int lo = args.ph_lo, hi = args.ph_hi;
#define IN(k) (lo <= (k) && (k) < hi)
#define BOTH(k) (IN(k) && IN((k) + 1))
#define GRID_BAR() xcd_barrier(bar)
    const float* x = args.in[0];
    bf16_t* XN = (bf16_t*)(ws + WS_XN); bf16_t* SEG0 = (bf16_t*)(ws + WS_SEG);
    bf16_t* WIN_T = (bf16_t*)(ws + WS_WIN_T);

    if (IN(0)) for (int rep = 0; rep < NREP(0); ++rep) {
        if (rep) __syncthreads();
        PHASE_IDS();
        LAS float* scr = (LAS float*)(lds + wave * 16384);
        const int gw = vcu * NWAVES + wave, NGW = G * NWAVES;
        constexpr int I_IN = (D / 64) * (8192 / 32);
        for (int it = gw; it < I_IN; it += NGW) p0_transpose_item(args.in[2], D, 8192, WIN_T, MapIn{}, scr, it, lane);
        {
            bf16_t* WRG_T = (bf16_t*)(ws + WS_WRG_T); constexpr int I_RG = (256 / 64) * (256 / 32);
            for (int it = gw; it < 8 * I_RG; it += NGW) { const int mat = it / I_RG, r = it % I_RG, hh = mat >> 1, ax = mat & 1;
                p0_transpose_item(args.in[ax ? 9 : 7] + (size_t)hh * 65536, 256, 256, WRG_T + (size_t)hh * 512 * 256, MapRG{ax * 128}, scr, r, lane); }
        }
        {
            constexpr int I_SQ = (D / 64) * (D / 32);
            for (int it = gw; it < 3 * I_SQ; it += NGW) { const int mat = it / I_SQ, r = it % I_SQ;
                p0_transpose_item(args.in[12 + mat], D, D, (bf16_t*)(ws + (mat == 0 ? WS_WPA_T : mat == 1 ? WS_WPB_T : WS_WOUT_T)), MapId{0}, scr, r, lane); }
        }
        {
            constexpr int I_GU = (D / 64) * (2048 / 32), I_DN = (DFF / 64) * (D / 32);
            bf16_t* WGU_T = (bf16_t*)(ws + WS_WGU_T); bf16_t* WDN_T = (bf16_t*)(ws + WS_WDN_T);
#if MOE_FP8
            (void)I_GU; (void)I_DN;
#else
            for (int it = gw; it < NE * I_GU; it += NGW) { const int e = it / I_GU, r = it % I_GU; p0_transpose_item(args.in[18] + (size_t)e * D * 2048, D, 2048, WGU_T + (size_t)e * 2048 * D, MapGU{}, scr, r, lane, args.in[15]); }
            for (int it = gw; it < NE * I_DN; it += NGW) { const int e = it / I_DN, r = it % I_DN; p0_transpose_item(args.in[20] + (size_t)e * DFF * D, DFF, D, WDN_T + (size_t)e * D * DFF, MapId{0}, scr, r, lane); }
#endif
            float* BGUP = (float*)(ws + WS_BGUP); const MapGU mg{};
            for (int i = bx * 512 + tid; i < NE * 2048; i += G * 512) { const int e = i >> 11, n = i & 2047; BGUP[e * 2048 + mg(n)] = args.in[19][i]; }
        }
        const float* nm = args.in[1];
        {
            f32x4 wnm[4];
#pragma unroll
            for (int j = 0; j < 4; ++j) wnm[j] = ((const GAS f32x4*)nm)[lane + 64 * j];
            for (int r2 = 0; r2 < NREP(17); ++r2) for (int m0 = gw; m0 < T; m0 += 4 * NGW) {
                f32x4 v[4][4];
#pragma unroll
                for (int a = 0; a < 4; ++a) { const int m = (m0 + a * NGW < T) ? m0 + a * NGW : m0; const GAS f32x4* xr = (const GAS f32x4*)(x + (size_t)m * D) + lane;
#pragma unroll
                    for (int j = 0; j < 4; ++j) v[a][j] = xr[64 * j]; }
#pragma unroll
                for (int a = 0; a < 4; ++a) { const int m = m0 + a * NGW; float s = 0.f;
#pragma unroll
                    for (int j = 0; j < 4; ++j) s += (v[a][j].x * v[a][j].x + v[a][j].y * v[a][j].y) + (v[a][j].z * v[a][j].z + v[a][j].w * v[a][j].w);
                    const float rstd = rsqrtf(wave_sum(s) * (1.f / D) + EPS);
                    if (m < T) { GAS u32x2* o8 = (GAS u32x2*)(XN + (size_t)m * D) + lane;
#pragma unroll
                        for (int j = 0; j < 4; ++j) { const f32x4 w = wnm[j]; u32x2 o; o.x = pk2(v[a][j].x * rstd * w.x, v[a][j].y * rstd * w.y); o.y = pk2(v[a][j].z * rstd * w.z, v[a][j].w * rstd * w.w); o8[64 * j] = o; } } }
            }
        }
        {
            bf16_t* WRH = (bf16_t*)(ws + WS_WRT); bf16_t* WRL = WRH + 32 * 1024;
            for (int i = bx * 512 + tid; i < 32 * 1024; i += G * 512) { const int e2 = i >> 10, k = i & 1023; const float v = args.in[16][k * NE + e2] * args.in[15][k];
                const bf16_t hb = f2bf(v); WRH[i] = hb; WRL[i] = f2bf(v - bf2f(hb)); }
        }
        if (bx == 0) {
            float* LBV = (float*)(ws + WS_LBV); float* LOGSIG = (float*)(ws + WS_LOGSIG);
            for (int i = tid; i < 1024; i += 512) {
                const float a0 = args.in[3][i], a1 = args.in[3][1024 + i]; const float mm = fmaxf(a0, a1); const float e0 = __expf(a0 - mm), e1 = __expf(a1 - mm);
                LBV[i] = e0 / (e0 + e1);
                const float L = args.in[11][i]; LOGSIG[i] = fminf(L, 0.f) - log1pf(__expf(-fabsf(L)));
            }
        }
        if (BOTH(0) && rep == NREP(0) - 1) { GRID_BAR();
#if defined(EXTRA_BARS)
            for (int eb = 0; eb < EXTRA_BARS; ++eb) GRID_BAR();
#endif
        }
    }
    if (IN(1)) {
        pg8::DenseOrder S; S.init(XN, (size_t)D * 2, WIN_T, (size_t)D * 2, T, 8192, G, bx);
        pg8::EpiSeg E{SEG0};
#if MOE_CONV_IN_P1
        {   PHASE_IDS();
            const int ksplit = (bx >> 3) & 15;
            S.i0 = 0; S.i1 = ksplit;
            pg8::gemm_phase<pg8::EpiSeg, pg8::DenseOrder, false>(lds, D, D, S, E);
            {   LAS float* scr = (LAS float*)(lds + wave * 16384); const int gw = vcu * NWAVES + wave, NGW = G * NWAVES;
                LAS float* nfl = scr + 2176;
#pragma unroll
                for (int i = 0; i < 4; ++i) *(LAS f32x4*)(nfl + 256 * i + 4 * lane) = *(const f32x4*)(args.in[15] + 256 * i + 4 * lane);
                LDS_WAIT(); asm volatile("" ::: "memory");
                p0_convert_experts8(args.in[18], D, 2048, ws + WS_WGU_T, MapGU{}, scr, gw, NGW, lane, pg8::F8_SW, nfl);
                p0_convert_experts8(args.in[20], DFF, D, ws + WS_WDN_T, MapId{0}, scr, gw, NGW, lane, pg8::F8_SW, (const LAS float*)nullptr); }
            __syncthreads();
            S.i0 = ksplit; S.i1 = 1 << 30;
            pg8::gemm_phase<pg8::EpiSeg, pg8::DenseOrder, false>(lds, D, D, S, E); }
#else
        for (int rep = 0; rep < NREP(1); ++rep) pg8::gemm_phase<pg8::EpiSeg, pg8::DenseOrder, false>(lds, D, D, S, E);
#endif
        if (BOTH(1)) GRID_BAR();
    }
    bf16_t* SQ = SEG0; bf16_t* SF = SEG0 + (size_t)T * 1024; bf16_t* SV = SEG0 + (size_t)2 * T * 1024; bf16_t* SG = SEG0 + (size_t)3 * T * 1024;
    bf16_t* USP = (bf16_t*)(ws + WS_USP); float* DEC = (float*)(ws + WS_DEC);
    bf16_t* SXB = SEG0 + (size_t)4 * T * 1024; bf16_t* SGATE = SEG0 + (size_t)5 * T * 1024; bf16_t* XCb = (bf16_t*)(ws + WS_XC); bf16_t* UUb = (bf16_t*)(ws + WS_UU);
    if (IN(2)) {
        PHASE_IDS();
        if (NREP(13) == 2) hgrn2_pass_a_phase<true>(lds, bx, G, SQ, SF, SV, (const float*)(ws + WS_LBV), (float*)USP, DEC, (float*)(ws + WS_DECB));
        hgrn2_pass_a_phase<false>(lds, bx, G, SQ, SF, SV, (const float*)(ws + WS_LBV), (float*)USP, DEC, (float*)(ws + WS_DECB));
        for (int rep = 0; rep < NREP(2); ++rep) {
            const int cg = tid & 127, c0 = cg * 8; const float* cw = args.in[5]; const float* cbv = args.in[6];
            float w[4][8], bb[8];
#pragma unroll
            for (int k = 0; k < 4; ++k)
#pragma unroll
                for (int j = 0; j < 8; ++j) w[k][j] = cw[k * 1024 + c0 + j];
#pragma unroll
            for (int j = 0; j < 8; ++j) bb[j] = cbv[c0 + j];
            for (int rb = bx * 4 + (tid >> 7); rb < T / 8; rb += G * 4) {
                const int t0 = rb * 8; const bool first = (t0 & (SEQ - 1)) == 0;
                u32x4 xr[11];
#pragma unroll
                for (int i = 0; i < 11; ++i) { const int tt = t0 - 3 + i; xr[i] = (i < 3 && first) ? (u32x4){0u, 0u, 0u, 0u} : *(const u32x4*)(SXB + (size_t)tt * 1024 + c0); }
#pragma unroll
                for (int r = 0; r < 8; ++r) {
                    float a[8];
#pragma unroll
                    for (int j = 0; j < 8; ++j) a[j] = bb[j];
#pragma unroll
                    for (int k = 0; k < 4; ++k) { const unsigned xu[4] = {xr[r + k].x, xr[r + k].y, xr[r + k].z, xr[r + k].w};
#pragma unroll
                        for (int j = 0; j < 4; ++j) { a[2 * j] += __uint_as_float(xu[j] << 16) * w[k][2 * j]; a[2 * j + 1] += __uint_as_float(xu[j] & 0xffff0000u) * w[k][2 * j + 1]; } }
                    u32x4 o; o.x = pk2(a[0], a[1]); o.y = pk2(a[2], a[3]); o.z = pk2(a[4], a[5]); o.w = pk2(a[6], a[7]);
                    *(u32x4*)(XCb + (size_t)(t0 + r) * 1024 + c0) = o;
                }
            }
        }
        if (BOTH(2)) GRID_BAR();
    }
    if (IN(3)) {
        PHASE_IDS();
        if (NREP(14) == 2) for (int gt = bx * 512 + tid; gt < BATCH * NH * 4096; gt += G * 512) hgrn2_pass_b<true>(gt, (float*)USP, (const float*)(ws + WS_DECB));
        for (int gt = bx * 512 + tid; gt < BATCH * NH * 4096; gt += G * 512) hgrn2_pass_b<false>(gt, (float*)USP, (const float*)(ws + WS_DECB));
        {
            pg8::GateOrder S{(const char*)XCb, (const char*)(ws + WS_WRG_T), G, bx};
            pg8::EpiGates E{XCb, args.in[8], args.in[10], (const float*)(ws + WS_LOGSIG), SXB, UUb, (float*)(ws + WS_LRUP), (float*)(ws + WS_LRUH)};
            for (int rep = 0; rep < NREP(3); ++rep) pg8::gemm_phase<pg8::EpiGates, pg8::GateOrder, false>(lds, 256, 1024, S, E);
        }
        if (BOTH(3)) GRID_BAR();
    }
    if (IN(4)) {
        if (NREP(15) == 2) hgrn2_pass_c_phase<true>(lds, bx, G, SQ, SF, SV, SG, (const float*)USP, args.in[4], SQ, DEC);
        hgrn2_pass_c_phase<false>(lds, bx, G, SQ, SF, SV, SG, (const float*)USP, args.in[4], SQ, DEC);
        for (int u = bx; u < BATCH * 32; u += G) { const int b = u >> 5, n = u & 31;
            if (NREP(16) == 2) lru_s3<true>(b, n, SXB, UUb, (const float*)(ws + WS_LRUP), (const float*)(ws + WS_LRUH), SGATE);
            lru_s3<false>(b, n, SXB, UUb, (const float*)(ws + WS_LRUP), (const float*)(ws + WS_LRUH), SGATE); }
        if (IN(4) && IN(6)) GRID_BAR();
    }
    bf16_t* MGb = SF; bf16_t* X1Wb = (bf16_t*)(ws + WS_X1W);
    if (IN(6)) {
        {
            pg8::DenseOrder S; S.init(SQ, (size_t)D * 2, ws + WS_WPA_T, (size_t)D * 2, T, D, G, bx);
            pg8::EpiMerge E{SEG0 + (size_t)7 * T * 1024, MGb};
            pg8::MidMerge MD{(size_t)((const char*)SGATE - (const char*)SQ) - 16 * 128, (size_t)(WS_WPB_T - WS_WPA_T) - 16 * 128, SEG0 + (size_t)6 * T * 1024};
            for (int rep = 0; rep < NREP(6); ++rep) pg8::gemm_phase<pg8::EpiMerge, pg8::DenseOrder, false, pg8::MidMerge>(lds, 2 * D, D, S, E, D, MD); }
        if (BOTH(6)) GRID_BAR();
    }
    if (IN(7)) {
        pg8::DenseOrder S; S.init(MGb, (size_t)D * 2, ws + WS_WOUT_T, (size_t)D * 2, T, D, G, bx);
        pg8::EpiOut2 E{x, X1Wb, MOE_FP8 ? (unsigned char*)(ws + WS_X1) : (unsigned char*)nullptr};
        for (int rep = 0; rep < NREP(7); ++rep) pg8::gemm_phase<pg8::EpiOut2, pg8::DenseOrder, false>(lds, D, D, S, E);
        if (BOTH(7)) GRID_BAR();
    }
    float* RSTD = (float*)(ws + WS_RSTD); int* TOPE = (int*)(ws + WS_TOPE); float* TOPW = (float*)(ws + WS_TOPW); int* POS = (int*)(ws + WS_POS);
    int* LIST = (int*)(ws + WS_LIST); float* GWs = (float*)(ws + WS_GW); float* RSs = (float*)(ws + WS_RS); int* WGH = (int*)(ws + WS_WGH);
    bf16_t* ACTb = (bf16_t*)(ws + WS_ACT); bf16_t* Yb = (bf16_t*)(ws + WS_Y);
    LAS int* m_tp = (LAS int*)(lds + MOE_TP); LAS int* m_off = (LAS int*)(lds + MOE_OFF); LAS int* m_hist = (LAS int*)(lds + MOE_HIST); LAS int* m_base = (LAS int*)(lds + MOE_BASE); LAS int* m_lcur = (LAS int*)(lds + MOE_LCUR);
    if (IN(8)) {
        PHASE_IDS();
        constexpr int WP = 1040;
        LAS unsigned char* Lhi = lds; LAS unsigned char* Llo = lds + 32 * WP;
        LAS float* lgt = (LAS float*)(lds + 2 * 32 * WP);
        LAS float* rss_s = lgt + 128 * 32;
        const bf16_t* WRH = (const bf16_t*)(ws + WS_WRT); const bf16_t* WRL = WRH + 32 * 1024;
        const float* br = args.in[17];
        const int cc = lane & 15, q = lane >> 4, e = lane & 31, sub = lane >> 5;
        if (tid < 32) m_hist[tid] = 0;
        for (int tb = bx * 128; tb < T; tb += G * 128) {
            const int tok0 = tb + 16 * wave;
            f32x4 acc[2] = {(f32x4){0.f, 0.f, 0.f, 0.f}, (f32x4){0.f, 0.f, 0.f, 0.f}};
            float ssq = 0.f;
            for (int hh = 0; hh < 2; ++hh) {
                __syncthreads();
#pragma unroll
                for (int j = 0; j < 4; ++j) { const int vi = tid + 512 * j, r = vi >> 6, ch = vi & 63;
                    *(LAS u32x4*)(Lhi + r * WP + ch * 16) = *(const u32x4*)(WRH + r * 1024 + 512 * hh + ch * 8);
                    *(LAS u32x4*)(Llo + r * WP + ch * 16) = *(const u32x4*)(WRL + r * 1024 + 512 * hh + ch * 8); }
                __syncthreads();
                const bf16_t* xa = X1Wb + (size_t)(tok0 + cc) * D + 512 * hh + 8 * q;
#pragma unroll 8
                for (int ks = 0; ks < 16; ++ks) {
                    const u32x4 aw = *(const u32x4*)(xa + 32 * ks); const bf16x8 af = __builtin_bit_cast(bf16x8, aw);
                    { float f[8]; pg8::unpack8(aw, f);
#pragma unroll
                      for (int j = 0; j < 8; ++j) ssq += f[j] * f[j]; }
#pragma unroll
                    for (int tl = 0; tl < 2; ++tl) {
                        const bf16x8 bh = *(const LAS bf16x8*)(Lhi + (16 * tl + cc) * WP + (32 * ks + 8 * q) * 2), bl = *(const LAS bf16x8*)(Llo + (16 * tl + cc) * WP + (32 * ks + 8 * q) * 2);
                        acc[tl] = __builtin_amdgcn_mfma_f32_16x16x32_bf16(af, bh, acc[tl], 0, 0, 0);
                        acc[tl] = __builtin_amdgcn_mfma_f32_16x16x32_bf16(af, bl, acc[tl], 0, 0, 0);
                    }
                }
            }
            ssq += __shfl_xor(ssq, 16); ssq += __shfl_xor(ssq, 32);
            if (q == 0) rss_s[16 * wave + cc] = ssq;
#pragma unroll
            for (int tl = 0; tl < 2; ++tl)
#pragma unroll
                for (int r = 0; r < 4; ++r) lgt[(16 * wave + 4 * q + r) * 32 + 16 * tl + cc] = acc[tl][r];
            __syncthreads();
            for (int it2 = 0; it2 < 8; ++it2) {
                const int tk = 16 * wave + 2 * it2 + sub; const int t = tb + tk;
                const float rstd = rsqrtf(rss_s[tk] * (1.0f / D) + EPS);
                float cur = lgt[tk * 32 + e] * rstd + br[e];
                float val[4]; int idx[4];
#pragma unroll
                for (int k = 0; k < 4; ++k) { float bv = cur; int bi = e;
#pragma unroll
                    for (int o = 1; o < 32; o <<= 1) { const float ov = __shfl_xor(bv, o); const int oi = __shfl_xor(bi, o); if (ov > bv || (ov == bv && oi < bi)) { bv = ov; bi = oi; } }
                    val[k] = bv; idx[k] = bi; if (e == bi) cur = -INFINITY; }
                float w4[4], den = 0.f;
#pragma unroll
                for (int k = 0; k < 4; ++k) { w4[k] = __expf(val[k] - val[0]); den += w4[k]; }
                const float inv = 1.0f / den;
                if (e < 4) { const int ie = e == 0 ? idx[0] : e == 1 ? idx[1] : e == 2 ? idx[2] : idx[3]; const float we = (e == 0 ? w4[0] : e == 1 ? w4[1] : e == 2 ? w4[2] : w4[3]) * inv;
                    TOPE[(size_t)t * 4 + e] = ie; TOPW[(size_t)t * 4 + e] = we; atomicAdd((int*)(m_hist + ie), 1); }
                if (e == 0) RSTD[t] = rstd;
            }
        }
        __syncthreads();
        if (tid < 32) { const int hc = m_hist[tid]; WGH[bx * 32 + tid] = hc; atomicAdd((unsigned*)(ctl + CW_CNT + tid), (unsigned)hc); }
        if (BOTH(8)) GRID_BAR();
    }
    if (IN(9) || IN(10) || IN(11)) {
        PHASE_IDS();
        if (tid == 0) { int tp = 0, of = 0; for (int j = 0; j < 32; ++j) { const int cn = (int)__hip_atomic_load(ctl + CW_CNT + j, __ATOMIC_RELAXED, __HIP_MEMORY_SCOPE_AGENT); m_tp[j] = tp; m_off[j] = of; tp += (cn + 255) >> 8; of += cn; } m_tp[32] = tp; m_off[32] = of; }
        __syncthreads();
    }
    if (IN(9)) {
        PHASE_IDS();
        if (tid < 32) { m_base[tid] = (int)atomicAdd((unsigned*)(ctl + CW_CUR + tid), (unsigned)WGH[bx * 32 + tid]); m_lcur[tid] = 0; }
        __syncthreads();
        for (int tb = bx * 128; tb < T; tb += G * 128) {
            const int t = tb + 16 * wave + (lane >> 2), k = lane & 3; const int ie = TOPE[(size_t)t * 4 + k];
            const int p = m_off[ie] + m_base[ie] + atomicAdd((int*)(m_lcur + ie), 1);
            LIST[p] = t; GWs[p] = TOPW[(size_t)t * 4 + k]; RSs[p] = RSTD[t]; POS[(size_t)t * 4 + k] = p;
        }
        if (BOTH(9)) GRID_BAR();
    }
    if (IN(10)) {
#if MOE_FP8
        pg8::MoeOrder S{m_tp, m_off, (const char*)(ws + WS_X1), (const char*)(ws + WS_WGU_T), LIST, (size_t)2048 * D, (size_t)256 * D, (size_t)D, 3, G, bx, 1};
        pg8::EpiGU8 E{RSs, (const float*)(ws + WS_BGUP), (unsigned char*)ACTb};
        for (int rep = 0; rep < NREP(10); ++rep) pg8::gemm_phase<pg8::EpiGU8, pg8::MoeOrder, true, pg8::NoMid, true>(lds, D / 2, D / 2, S, E);
#else
        pg8::MoeOrder S{m_tp, m_off, (const char*)X1Wb, (const char*)(ws + WS_WGU_T), LIST, (size_t)2048 * D * 2, (size_t)256 * D * 2, (size_t)D * 2, 3, G, bx, 1};
        pg8::EpiGU2 E{RSs, (const float*)(ws + WS_BGUP), ACTb};
        for (int rep = 0; rep < NREP(10); ++rep) pg8::gemm_phase<pg8::EpiGU2, pg8::MoeOrder, true>(lds, D, D, S, E);
#endif
        if (BOTH(10)) GRID_BAR();
    }
    if (IN(11)) {
#if MOE_FP8
        pg8::MoeOrder S{m_tp, m_off, (const char*)ACTb, (const char*)(ws + WS_WDN_T), LIST, (size_t)D * DFF, (size_t)256 * DFF, (size_t)DFF, 2, G, bx, 0};
        pg8::EpiDown8 E{GWs, args.in[21], (unsigned char*)Yb};
        for (int rep = 0; rep < NREP(11); ++rep) pg8::gemm_phase<pg8::EpiDown8, pg8::MoeOrder, false, pg8::NoMid, true>(lds, DFF / 2, DFF / 2, S, E);
#else
        pg8::MoeOrder S{m_tp, m_off, (const char*)ACTb, (const char*)(ws + WS_WDN_T), LIST, (size_t)D * DFF * 2, (size_t)256 * DFF * 2, (size_t)DFF * 2, 2, G, bx, 0};
        pg8::EpiDown2 E{GWs, args.in[21], Yb};
        for (int rep = 0; rep < NREP(11); ++rep) pg8::gemm_phase<pg8::EpiDown2, pg8::MoeOrder, false>(lds, DFF, DFF, S, E);
#endif
        if (BOTH(11)) GRID_BAR();
    }
    if (IN(12)) {
        PHASE_IDS();
        const float* NFIN = args.in[22]; float* out = args.out;
        for (int rep = 0; rep < NREP(12); ++rep) for (int t = bx * 8 + wave; t < T; t += G * 16) {
            const int tt[2] = {t, t + G * 8 < T ? t + G * 8 : t};
            int4 ps[2]; u32x4 xw[2][2], yw[2][4];
#pragma unroll
            for (int a = 0; a < 2; ++a) ps[a] = *(const int4*)(POS + (size_t)tt[a] * 4);
#pragma unroll
            for (int a = 0; a < 2; ++a) { const u32x4* xr = (const u32x4*)(X1Wb + (size_t)tt[a] * D) + lane * 2; xw[a][0] = xr[0]; xw[a][1] = xr[1]; }
#pragma unroll
            for (int a = 0; a < 2; ++a) { const int pp[4] = {ps[a].x, ps[a].y, ps[a].z, ps[a].w};
#pragma unroll
                for (int k = 0; k < 4; ++k) yw[a][k] = *((const u32x4*)((const unsigned char*)Yb + (size_t)pp[k] * 1024) + lane); }
#pragma unroll
            for (int a = 0; a < 2; ++a) {
                float v[16], f[8];
                pg8::unpack8(xw[a][0], f);
#pragma unroll
                for (int j = 0; j < 8; ++j) v[j] = f[j];
                pg8::unpack8(xw[a][1], f);
#pragma unroll
                for (int j = 0; j < 8; ++j) v[8 + j] = f[j];
#pragma unroll
                for (int k = 0; k < 4; ++k) { const unsigned yv[4] = {yw[a][k].x, yw[a][k].y, yw[a][k].z, yw[a][k].w};
#pragma unroll
                    for (int j = 0; j < 4; ++j) { const f32x2v lo = __builtin_amdgcn_cvt_pk_f32_fp8((int)yv[j], false), hi = __builtin_amdgcn_cvt_pk_f32_fp8((int)yv[j], true);
                        v[4 * j] += lo[0] * (1.0f / pg8::F8_SY); v[4 * j + 1] += lo[1] * (1.0f / pg8::F8_SY); v[4 * j + 2] += hi[0] * (1.0f / pg8::F8_SY); v[4 * j + 3] += hi[1] * (1.0f / pg8::F8_SY); } }
                float ss = 0.f;
#pragma unroll
                for (int j = 0; j < 16; ++j) ss += v[j] * v[j];
                const float rstd = rsqrtf(wave_sum(ss) * (1.0f / D) + EPS);
                if (a == 0 || tt[1] != tt[0]) {
                    f32x4* orow = (f32x4*)(out + (size_t)tt[a] * D) + lane * 4; const f32x4* nw = (const f32x4*)NFIN + lane * 4;
#pragma unroll
                    for (int j = 0; j < 4; ++j) { const f32x4 w = nw[j]; orow[j] = (f32x4){v[4 * j] * rstd * w[0], v[4 * j + 1] * rstd * w[1], v[4 * j + 2] * rstd * w[2], v[4 * j + 3] * rstd * w[3]}; }
                }
            }
        }
    }
#undef IN
#undef BOTH
#undef GRID_BAR
}

extern "C" void kernel_launch(void* const* d_in, const int* in_sizes, int n_in, void* d_out, int out_size, void* d_ws, size_t ws_size, hipStream_t stream) {
    (void)in_sizes; (void)n_in; (void)out_size; (void)ws_size;
    unsigned char* ws = (unsigned char*)d_ws;
    static int grid = 0;
    if (grid == 0) {
        int dev = 0, cus = 0;
        (void)hipGetDevice(&dev); (void)hipDeviceGetAttribute(&cus, hipDeviceAttributeMultiprocessorCount, dev);
        (void)hipFuncSetAttribute((const void*)mega, hipFuncAttributeMaxDynamicSharedMemorySize, LDS_BYTES);
        grid = cus > 0 ? cus : 256;
    }
    (void)hipMemsetAsync(ws + WS_CTL, 0, CTL_ZERO_BYTES, stream);
    MArgs ma{};
    for (int i = 0; i < 23; ++i) ma.in[i] = (const float*)d_in[i];
    ma.out = (float*)d_out; ma.ws = ws; ma.ph_lo = 0; ma.ph_hi = 13;
    hipLaunchKernelGGL(mega, dim3(grid), dim3(512), LDS_BYTES, stream, ma);
}
```
